# Optimizing an MI355X kernel written in HIP

```python
import math
import jax, jax.numpy as jnp
from jax import lax
import numpy as np

D_MODEL = 2048
BATCH = 2
SEQ = 8192
DEPTH = 4

CHUNK = 64
GDN_HEAD_DIM = 128
GDN_WIDTH = D_MODEL // 2
GDN_HEADS = GDN_WIDTH // GDN_HEAD_DIM
SC_WIDTH = D_MODEL - GDN_WIDTH
GDN_CONV = 4
SC_CONV = 3
FFN_CONV = 3
N_MEM = 256
XATTN_HEADS = 4
XATTN_HEAD_DIM = D_MODEL // XATTN_HEADS
D_FF = ((8 * D_MODEL // 3 + 255) // 256) * 256
N_MIX_IN = 4 * GDN_WIDTH + 2 * GDN_HEADS + 3 * SC_WIDTH
EPS = 1e-6

kernel_name = 'hybrid_gdn_shortconv_memxattn_convffn'


def rmsnorm(x, w):
    xf = x.astype(jnp.float32)
    y = xf * lax.rsqrt(jnp.mean(xf * xf, axis=-1, keepdims=True) + EPS)
    return (y * w.astype(jnp.float32)).astype(x.dtype)


def l2norm(x):
    return x * lax.rsqrt(jnp.sum(x * x, axis=-1, keepdims=True) + EPS)


def causal_dwconv(x, w):
    K = w.shape[0]
    S = x.shape[1]
    w = w.astype(x.dtype)
    xp = jnp.pad(x, ((0, 0), (K - 1, 0), (0, 0)))
    y = xp[:, 0:S] * w[0]
    for j in range(1, K):
        y = y + xp[:, j:j + S] * w[j]
    return y


def gated_delta_rule(q, k, v, g, beta):
    Bsz, S, H, DK = q.shape
    DV = v.shape[-1]
    N = S // CHUNK

    def to_chunks(t):
        t = t.reshape((Bsz, N, CHUNK, H) + t.shape[3:])
        return jnp.moveaxis(t, 3, 1)

    q, k, v, g, beta = (to_chunks(t) for t in (q, k, v, g, beta))
    q = q * (DK ** -0.5)
    g = jnp.cumsum(g, axis=-1)
    causal = jnp.tril(jnp.ones((CHUNK, CHUNK), dtype=bool))
    strict = jnp.tril(jnp.ones((CHUNK, CHUNK), dtype=bool), k=-1)
    decay = jnp.exp(jnp.where(causal, g[..., :, None] - g[..., None, :], -jnp.inf))
    k_beta = k * beta[..., None]
    a_strict = jnp.where(strict, jnp.einsum('bhncd,bhnmd->bhncm', k_beta, k) * decay, 0.0)
    eye = jnp.eye(CHUNK, dtype=jnp.float32)
    rhs = jnp.concatenate([v * beta[..., None], k_beta * jnp.exp(g)[..., None]], axis=-1)
    sol = lax.linalg.triangular_solve(eye + a_strict, rhs, left_side=True, lower=True,
                                      unit_diagonal=True)
    u, w = sol[..., :DV], sol[..., DV:]
    attn = jnp.einsum('bhncd,bhnmd->bhncm', q, k) * decay
    q_dec = q * jnp.exp(g)[..., None]
    g_last = g[..., -1]
    k_dec = k * jnp.exp(g_last[..., None] - g)[..., None]

    def step(state, xs):
        q_i, k_i, u_i, w_i, attn_i, gl_i = xs
        v_new = u_i - jnp.einsum('bhcd,bhde->bhce', w_i, state)
        o_i = (jnp.einsum('bhcd,bhde->bhce', q_i, state)
               + jnp.einsum('bhcm,bhme->bhce', attn_i, v_new))
        state = (state * jnp.exp(gl_i)[..., None, None]
                 + jnp.einsum('bhcd,bhce->bhde', k_i, v_new))
        return state, o_i

    xs = tuple(jnp.moveaxis(t, 2, 0) for t in (q_dec, k_dec, u, w, attn, g_last))
    state0 = jnp.zeros((Bsz, H, DK, DV), jnp.float32)
    _, o = lax.scan(step, state0, xs)
    return jnp.transpose(o, (1, 0, 3, 2, 4)).reshape(Bsz, S, H, DV)


def gdn_group(proj, conv_w, a_log, dt_bias, out_gain):
    Bsz, S, _ = proj.shape
    W, H, Dh = GDN_WIDTH, GDN_HEADS, GDN_HEAD_DIM
    qkv = jax.nn.silu(causal_dwconv(proj[..., :3 * W], conv_w)).astype(jnp.float32)
    q = l2norm(qkv[..., :W].reshape(Bsz, S, H, Dh))
    k = l2norm(qkv[..., W:2 * W].reshape(Bsz, S, H, Dh))
    v = qkv[..., 2 * W:].reshape(Bsz, S, H, Dh)
    z = proj[..., 3 * W:4 * W].reshape(Bsz, S, H, Dh)
    b_raw = proj[..., 4 * W:4 * W + H].astype(jnp.float32)
    a_raw = proj[..., 4 * W + H:4 * W + 2 * H].astype(jnp.float32)
    beta = jax.nn.sigmoid(b_raw)
    g = -jnp.exp(a_log.astype(jnp.float32)) * jax.nn.softplus(a_raw + dt_bias.astype(jnp.float32))
    o = gated_delta_rule(q, k, v, g, beta)
    o = rmsnorm(o, out_gain).astype(proj.dtype) * jax.nn.silu(z)
    return o.reshape(Bsz, S, W)


def shortconv_group(proj, conv_w):
    off = 4 * GDN_WIDTH + 2 * GDN_HEADS
    b_gate = proj[..., off:off + SC_WIDTH]
    c_gate = proj[..., off + SC_WIDTH:off + 2 * SC_WIDTH]
    h = proj[..., off + 2 * SC_WIDTH:off + 3 * SC_WIDTH]
    return b_gate * causal_dwconv(c_gate * h, conv_w)


def memory_xattn(h, mem_n, w_q, w_k, w_v, w_o):
    Bsz, S, _ = h.shape
    q = (h @ w_q).reshape(Bsz, S, XATTN_HEADS, XATTN_HEAD_DIM)
    k = (mem_n @ w_k).reshape(Bsz, N_MEM, XATTN_HEADS, XATTN_HEAD_DIM)
    v = (mem_n @ w_v).reshape(Bsz, N_MEM, XATTN_HEADS, XATTN_HEAD_DIM)
    s = jnp.einsum('bshd,bmhd->bhsm', q, k).astype(jnp.float32) * (XATTN_HEAD_DIM ** -0.5)
    p = jax.nn.softmax(s, axis=-1).astype(v.dtype)
    o = jnp.einsum('bhsm,bmhd->bshd', p, v).reshape(Bsz, S, D_MODEL)
    return o @ w_o


def conv_ffn(h, w_up, conv_w, w_down):
    u = causal_dwconv(h @ w_up, conv_w)
    gate, up = u[..., :D_FF], u[..., D_FF:]
    return (jax.nn.silu(gate) * up) @ w_down


def setup_inputs(seed: int = 0) -> dict:
    key = jax.random.key(seed)
    ks = jax.random.split(key, 24)
    L, D = DEPTH, D_MODEL
    out_scale = (3 * DEPTH) ** -0.5

    def normal(k, shape, std):
        return jax.random.normal(k, shape, jnp.float32) * std

    def gain(k, shape):
        return 1.0 + normal(k, shape, 0.02)

    dt = jnp.exp(jax.random.uniform(ks[6], (L, GDN_HEADS), jnp.float32,
                                    math.log(1e-3), math.log(1e-1)))
    return {
        'x': normal(ks[0], (BATCH, SEQ, D), 1.0),
        'mem': normal(ks[1], (BATCH, N_MEM, D), 1.0),
        'mix_norm': gain(ks[2], (L, D)),
        'w_mix_in': normal(ks[3], (L, D, N_MIX_IN), D ** -0.5),
        'gdn_conv': normal(ks[4], (L, GDN_CONV, 3 * GDN_WIDTH), GDN_CONV ** -0.5),
        'gdn_a_log': jnp.log(jax.random.uniform(ks[5], (L, GDN_HEADS), jnp.float32, 1.0, 16.0)),
        'gdn_dt_bias': dt + jnp.log(-jnp.expm1(-dt)),
        'gdn_out_norm': gain(ks[7], (L, GDN_HEAD_DIM)),
        'sc_conv': normal(ks[8], (L, SC_CONV, SC_WIDTH), SC_CONV ** -0.5),
        'w_mix_out': normal(ks[9], (L, D, D), D ** -0.5 * out_scale),
        'xattn_norm': gain(ks[10], (L, D)),
        'mem_norm': gain(ks[11], (L, D)),
        'w_xq': normal(ks[12], (L, D, D), D ** -0.5),
        'w_xk': normal(ks[13], (L, D, D), D ** -0.5),
        'w_xv': normal(ks[14], (L, D, D), D ** -0.5),
        'w_xo': normal(ks[15], (L, D, D), D ** -0.5 * out_scale),
        'ffn_norm': gain(ks[16], (L, D)),
        'w_ffn_up': normal(ks[17], (L, D, 2 * D_FF), D ** -0.5),
        'ffn_conv': normal(ks[18], (L, FFN_CONV, 2 * D_FF), FFN_CONV ** -0.5),
        'w_ffn_down': normal(ks[19], (L, D_FF, D), D_FF ** -0.5 * out_scale),
        'final_norm': gain(ks[20], (D,)),
    }


def reference(x, mem, mix_norm, w_mix_in, gdn_conv, gdn_a_log, gdn_dt_bias, gdn_out_norm,
              sc_conv, w_mix_out, xattn_norm, mem_norm, w_xq, w_xk, w_xv, w_xo,
              ffn_norm, w_ffn_up, ffn_conv, w_ffn_down, final_norm):
    for l in range(DEPTH):
        h = rmsnorm(x, mix_norm[l])
        proj = h @ w_mix_in[l]
        y_gdn = gdn_group(proj, gdn_conv[l], gdn_a_log[l], gdn_dt_bias[l], gdn_out_norm[l])
        y_sc = shortconv_group(proj, sc_conv[l])
        x = x + jnp.concatenate([y_gdn, y_sc], axis=-1) @ w_mix_out[l]
        h = rmsnorm(x, xattn_norm[l])
        mem_n = rmsnorm(mem, mem_norm[l])
        x = x + memory_xattn(h, mem_n, w_xq[l], w_xk[l], w_xv[l], w_xo[l])
        h = rmsnorm(x, ffn_norm[l])
        x = x + conv_ffn(h, w_ffn_up[l], ffn_conv[l], w_ffn_down[l])
    return rmsnorm(x, final_norm)
```

```cpp
#define MK_ONE_LAUNCH 1
#include <hip/hip_runtime.h>
#include <cstdio>
#include <cstdint>

#ifndef MK_ONE_LAUNCH
#define MK_ONE_LAUNCH 1
#endif

namespace pg8 {
#define PG8_LAS __attribute__((address_space(3)))
typedef unsigned short bf16_t;
typedef short bf16x8 __attribute__((ext_vector_type(8)));
typedef float f32x4 __attribute__((ext_vector_type(4)));
typedef float f32x2 __attribute__((ext_vector_type(2)));
typedef unsigned u32x4 __attribute__((ext_vector_type(4)));
constexpr int BM = 256, BK = 64, HALF = 128, HTB = HALF * BK * 2  , STAGE_BYTES = 8 * HTB, NXCD = 8, WGM = 8;

__host__ __device__ __forceinline__ int lds_byte(int r, int c) { const int st = (r >> 4) * 2 + (c >> 5), rr = r & 15, cc = c & 31, ob = rr * 64 + cc * 2; return st * 1024 + (ob ^ (((ob >> 9) & 1) << 5)); }
__host__ __device__ __forceinline__ void stage_rc(int b, int& R, int& C) { const int st = b / 1024, sb = b % 1024, swz = sb ^ (((sb >> 9) & 1) << 5); R = (st >> 1) * 16 + swz / 64; C = (st & 1) * 32 + (swz % 64) / 2; }
__host__ __device__ __forceinline__ int perm32(int rho) { const int n = rho >> 4, i = rho & 15; return 8 * (i >> 2) + 4 * n + (i & 3); }

struct Unit { int pm, pn; };
struct Gemm { const bf16_t* A; const bf16_t* Bt; int lda, ldb, K; };

struct StaticOrder {
    int nM, nN, nwg, G, c;
    __host__ __device__ void init(int M, int N, int G_, int c_) { nM = M / BM; nN = N / BM; nwg = nM * nN; G = G_; c = c_; }
    __host__ __device__ bool next(int i, Unit& u) const {
        const long L = (long)i * G + c; if (L >= nwg) return false;
        int wgid = (int)L; { const int q = nwg / NXCD, r = nwg % NXCD, xcd = wgid % NXCD, off = wgid / NXCD; wgid = (xcd < r ? xcd * (q + 1) : r * (q + 1) + (xcd - r) * q) + off; }
        const int nig = WGM * nN, gid = wgid / nig, fm = gid * WGM, gsz = (nM - fm) < WGM ? (nM - fm) : WGM;
        u.pm = fm + ((wgid % nig) % gsz); u.pn = (wgid % nig) / gsz; return true;
    }
    __device__ __forceinline__ const char* pa(const Gemm& g, const Unit& u) const { return (const char*)g.A + (size_t)u.pm * BM * g.lda * 2; }
    __device__ __forceinline__ const char* pb(const Gemm& g, const Unit& u) const { return (const char*)g.Bt + (size_t)u.pn * BM * g.ldb * 2; }
};

__device__ __forceinline__ unsigned cvt_pk_bf16(float lo, float hi) { unsigned r; asm volatile("v_cvt_pk_bf16_f32 %0, %1, %2" : "=v"(r) : "v"(lo), "v"(hi)); return r; }


template <class Loc> struct EpiBf16 {
    static constexpr bool PERM = true, AFTER_DRAIN = false;
    Loc loc; float scale; const float* ssq;
    __device__ __forceinline__ void operator()(const f32x4 (&acc)[2][2][4][2], const Unit& u, int wr, int wc, int fr, int fq) const {
        bf16_t* base; int ldc; loc(u, base, ldc);
        const int row0 = wr * 64 + fr, col0 = wc * 32 + 8 * fq;
#pragma unroll
        for (int ai = 0; ai < 2; ++ai)
#pragma unroll
            for (int m = 0; m < 4; ++m) { bf16_t* rowp = base + (size_t)(row0 + ai * HALF + m * 16) * ldc + col0;
                float scale = this->scale; if (ssq) scale *= 1.0f / sqrtf(ssq[u.pm * BM + row0 + ai * HALF + m * 16] * (1.0f / 2048.0f) + 1e-6f);
#pragma unroll
                for (int bj = 0; bj < 2; ++bj) { f32x4 v0 = acc[ai][bj][m][0] * scale, v1 = acc[ai][bj][m][1] * scale;
                    u32x4 w; w.x = cvt_pk_bf16(v0[0], v0[1]); w.y = cvt_pk_bf16(v0[2], v0[3]); w.z = cvt_pk_bf16(v1[0], v1[1]); w.w = cvt_pk_bf16(v1[2], v1[3]);
                    __builtin_nontemporal_store(w, (u32x4*)(rowp + bj * HALF)); } }
    }
};
struct LocPlain { bf16_t* O; int ldc; __device__ __forceinline__ void operator()(const Unit& u, bf16_t*& base, int& ld) const { base = O + (size_t)u.pm * BM * ldc + (size_t)u.pn * BM; ld = ldc; } };

struct EpiResNorm {
    static constexpr bool PERM = true, AFTER_DRAIN = false;
    const float* res; float* out; int ldc; bf16_t* hn; const float* gain; float* ssq;
    __device__ __forceinline__ void operator()(const f32x4 (&acc)[2][2][4][2], const Unit& u, int wr, int wc, int fr, int fq) const {
        const int row0 = u.pm * BM + wr * 64 + fr, col0 = u.pn * BM + wc * 32 + 8 * fq;
        f32x4 g4[2][2];
        if (hn) {
#pragma unroll
            for (int bj = 0; bj < 2; ++bj)
#pragma unroll
                for (int n = 0; n < 2; ++n) g4[bj][n] = *(const f32x4*)(gain + col0 + bj * HALF + 4 * n); }
#pragma unroll
        for (int ai = 0; ai < 2; ++ai)
#pragma unroll
            for (int m = 0; m < 4; ++m) { const int row = row0 + ai * HALF + m * 16; const size_t off = (size_t)row * ldc + col0;
                f32x4 x[2][2];
#pragma unroll
                for (int bj = 0; bj < 2; ++bj)
#pragma unroll
                    for (int n = 0; n < 2; ++n) x[bj][n] = *(const f32x4*)(res + off + bj * HALF + 4 * n);
                float ss = 0.f;
#pragma unroll
                for (int bj = 0; bj < 2; ++bj)
#pragma unroll
                    for (int n = 0; n < 2; ++n) { x[bj][n] = x[bj][n] + acc[ai][bj][m][n]; __builtin_nontemporal_store(x[bj][n], (f32x4*)(out + off + bj * HALF + 4 * n));
                        ss += (x[bj][n][0] * x[bj][n][0] + x[bj][n][1] * x[bj][n][1]) + (x[bj][n][2] * x[bj][n][2] + x[bj][n][3] * x[bj][n][3]); }
                if (hn) {
#pragma unroll
                    for (int bj = 0; bj < 2; ++bj) { const f32x4 v0 = x[bj][0] * g4[bj][0], v1 = x[bj][1] * g4[bj][1];
                        u32x4 w; w.x = cvt_pk_bf16(v0[0], v0[1]); w.y = cvt_pk_bf16(v0[2], v0[3]); w.z = cvt_pk_bf16(v1[0], v1[1]); w.w = cvt_pk_bf16(v1[2], v1[3]);
                        __builtin_nontemporal_store(w, (u32x4*)(hn + off + bj * HALF)); }
                    ss += __shfl_xor(ss, 16); ss += __shfl_xor(ss, 32);
                    if (fq == 0) atomicAdd(ssq + row, ss);
                }
                asm volatile("" ::: "memory"); }
    }
};

struct EpiSoftmax {
    static constexpr bool PERM = true, AFTER_DRAIN = true;
    bf16_t* P; int ldc; float sl2e; const float* ssq;
    __device__ __forceinline__ void fused(f32x4 (&acc)[2][2][4][2], const Unit& u, int wr, int wc, int fr, int fq, PG8_LAS unsigned char* lds, int wid, int lane) const {
        PG8_LAS float* Pm = (PG8_LAS float*)lds;
        PG8_LAS float* Ps = (PG8_LAS float*)(lds + 4096);
#pragma unroll
        for (int ai = 0; ai < 2; ++ai)
#pragma unroll
            for (int m = 0; m < 4; ++m) {
                float mx = -3.0e38f;
#pragma unroll
                for (int bj = 0; bj < 2; ++bj)
#pragma unroll
                    for (int n = 0; n < 2; ++n) { const f32x4 x = acc[ai][bj][m][n]; mx = fmaxf(mx, fmaxf(fmaxf(x[0], x[1]), fmaxf(x[2], x[3]))); }
                mx = fmaxf(mx, __shfl_xor(mx, 16)); mx = fmaxf(mx, __shfl_xor(mx, 32));
                if (fq == 0) Pm[(ai * HALF + wr * 64 + m * 16 + fr) * 4 + wc] = mx;
            }
        asm volatile("s_waitcnt lgkmcnt(0)" ::: "memory"); __builtin_amdgcn_s_barrier(); asm volatile("" ::: "memory");
#pragma unroll
        for (int ai = 0; ai < 2; ++ai)
#pragma unroll
            for (int m = 0; m < 4; ++m) {
                const int row = ai * HALF + wr * 64 + m * 16 + fr;
                const f32x4 pm4 = *(const PG8_LAS f32x4*)(Pm + row * 4);
                const float gm = fmaxf(fmaxf(pm4[0], pm4[1]), fmaxf(pm4[2], pm4[3]));
                const float sl2e = this->sl2e * (1.0f / sqrtf(ssq[u.pm * BM + row] * (1.0f / 2048.0f) + 1e-6f));
                float s = 0.f;
#pragma unroll
                for (int bj = 0; bj < 2; ++bj)
#pragma unroll
                    for (int n = 0; n < 2; ++n) { f32x4 x = acc[ai][bj][m][n];
#pragma unroll
                        for (int j = 0; j < 4; ++j) { x[j] = __builtin_amdgcn_exp2f((x[j] - gm) * sl2e); s += x[j]; }
                        acc[ai][bj][m][n] = x; }
                s += __shfl_xor(s, 16); s += __shfl_xor(s, 32);
                if (fq == 0) Ps[row * 4 + wc] = s;
            }
        asm volatile("s_waitcnt lgkmcnt(0)" ::: "memory"); __builtin_amdgcn_s_barrier(); asm volatile("" ::: "memory");
        bf16_t* base = P + (size_t)u.pm * BM * ldc + (size_t)u.pn * BM;
#pragma unroll
        for (int ai = 0; ai < 2; ++ai)
#pragma unroll
            for (int m = 0; m < 4; ++m) {
                const int row = ai * HALF + wr * 64 + m * 16 + fr;
                const f32x4 ps4 = *(const PG8_LAS f32x4*)(Ps + row * 4);
                const float inv = 1.0f / ((ps4[0] + ps4[1]) + (ps4[2] + ps4[3]));
                bf16_t* rowp = base + (size_t)row * ldc + wc * 32 + 8 * fq;
#pragma unroll
                for (int bj = 0; bj < 2; ++bj) { const f32x4 v0 = acc[ai][bj][m][0] * inv, v1 = acc[ai][bj][m][1] * inv;
                    u32x4 w; w.x = cvt_pk_bf16(v0[0], v0[1]); w.y = cvt_pk_bf16(v0[2], v0[3]); w.z = cvt_pk_bf16(v1[0], v1[1]); w.w = cvt_pk_bf16(v1[2], v1[3]);
                    *(u32x4*)(rowp + bj * HALF) = w; }
            }
    }
};

__device__ __forceinline__ float dpp_ror1(float v) { return __builtin_bit_cast(float, __builtin_amdgcn_update_dpp(0, __builtin_bit_cast(int, v), 0x121, 0xf, 0xf, false)); }
__device__ __forceinline__ float dpp_ror2(float v) { return __builtin_bit_cast(float, __builtin_amdgcn_update_dpp(0, __builtin_bit_cast(int, v), 0x122, 0xf, 0xf, false)); }
struct EpiSwiglu {
    static constexpr bool PERM = true, AFTER_DRAIN = false;
    bf16_t* act; float* part; float* halo; const float* cw; const float* ssq; PG8_LAS float* xb; int dff;
    __device__ __forceinline__ void operator()(f32x4 (&acc)[2][2][4][2], const Unit& u, int wr, int wc, int fr, int fq) const {
        const int ccol = wc * 32 + 8 * fq;
#pragma unroll
        for (int ai = 0; ai < 2; ++ai)
#pragma unroll
            for (int m = 0; m < 4; ++m) { const float sc = 1.0f / sqrtf(ssq[u.pm * BM + ai * HALF + wr * 64 + m * 16 + fr] * (1.0f / 2048.0f) + 1e-6f);
#pragma unroll
                for (int bj = 0; bj < 2; ++bj)
#pragma unroll
                    for (int n = 0; n < 2; ++n) acc[ai][bj][m][n] = acc[ai][bj][m][n] * sc; }
        if (fr >= 14) {
#pragma unroll
            for (int ai = 0; ai < 2; ++ai)
#pragma unroll
                for (int bj = 0; bj < 2; ++bj)
#pragma unroll
                    for (int n = 0; n < 2; ++n) { *(PG8_LAS f32x4*)(xb + ((wr * 2 + ai) * 2 + (fr - 14)) * 256 + bj * HALF + ccol + 4 * n) = acc[ai][bj][3][n];
                        if (wr == 1 && ai == 1) *(f32x4*)(halo + ((size_t)(u.pm * 2 + (fr - 14)) * 2 + bj) * dff + u.pn * HALF + ccol + 4 * n) = acc[1][bj][3][n]; }
        }
        asm volatile("s_waitcnt lgkmcnt(0)" ::: "memory"); __builtin_amdgcn_s_barrier(); asm volatile("" ::: "memory");
#pragma unroll
        for (int n = 0; n < 2; ++n) {
            const int ch = u.pn * HALF + ccol + 4 * n;
            f32x4 wg[3], wu[3];
#pragma unroll
            for (int t = 0; t < 3; ++t) { wg[t] = *(const f32x4*)(cw + (size_t)t * 2 * dff + ch); wu[t] = *(const f32x4*)(cw + (size_t)t * 2 * dff + dff + ch); }
#pragma unroll
            for (int ai = 0; ai < 2; ++ai) {
                f32x4 c1g = {0.f, 0.f, 0.f, 0.f}, c2g = c1g, c1u = c1g, c2u = c1g;
                if (ai + wr > 0) { const int sw = wr ^ 1, sa = wr == 0 ? ai - 1 : ai; const PG8_LAS float* xp = xb + ((sw * 2 + sa) * 2) * 256 + ccol + 4 * n;
                    const f32x4 e0g = *(const PG8_LAS f32x4*)(xp), e1g = *(const PG8_LAS f32x4*)(xp + 256), e0u = *(const PG8_LAS f32x4*)(xp + HALF), e1u = *(const PG8_LAS f32x4*)(xp + 256 + HALF);
                    c1g = e1g; c1u = e1u;
#pragma unroll
                    for (int j = 0; j < 4; ++j) { c2g[j] = fr == 0 ? e0g[j] : e1g[j]; c2u[j] = fr == 0 ? e0u[j] : e1u[j]; } }
#pragma unroll
                for (int m = 0; m < 4; ++m) {
                    const f32x4 G = acc[ai][0][m][n], U = acc[ai][1][m][n];
                    f32x4 r1g, r2g, r1u, r2u, cg, cu;
#pragma unroll
                    for (int j = 0; j < 4; ++j) { r1g[j] = dpp_ror1(G[j]); r2g[j] = dpp_ror2(G[j]); r1u[j] = dpp_ror1(U[j]); r2u[j] = dpp_ror2(U[j]);
                        const float p1g = fr == 0 ? c1g[j] : r1g[j], p2g = fr < 2 ? c2g[j] : r2g[j], p1u = fr == 0 ? c1u[j] : r1u[j], p2u = fr < 2 ? c2u[j] : r2u[j];
                        cg[j] = wg[2][j] * G[j] + wg[1][j] * p1g + wg[0][j] * p2g; cu[j] = wu[2][j] * U[j] + wu[1][j] * p1u + wu[0][j] * p2u; }
                    c1g = r1g; c2g = r2g; c1u = r1u; c2u = r2u;
                    const int row = u.pm * BM + ai * HALF + wr * 64 + m * 16 + fr;
                    if (ai == 0 && m == 0 && wr == 0 && fr < 2) {
                        *(f32x4*)(part + ((size_t)(u.pm * 2 + fr) * 2 + 0) * dff + ch) = cg; *(f32x4*)(part + ((size_t)(u.pm * 2 + fr) * 2 + 1) * dff + ch) = cu;
                    } else {
                        f32x4 a;
#pragma unroll
                        for (int j = 0; j < 4; ++j) a[j] = cg[j] / (1.0f + __expf(-cg[j])) * cu[j];
                        typedef unsigned u32x2 __attribute__((ext_vector_type(2)));
                        u32x2 w; w.x = cvt_pk_bf16(a[0], a[1]); w.y = cvt_pk_bf16(a[2], a[3]);
                        __builtin_nontemporal_store(w, (u32x2*)(act + (size_t)row * dff + ch));
                    }
                }
            }
        }
    }
};

template <class Epi, class Sched, bool ALIGN_EPI = false>
__device__ __forceinline__ void gemm_phase(PG8_LAS unsigned char* lds, const Gemm g, const Sched& S, const Epi& E) {
    int tid_ = threadIdx.x; asm volatile("" : "+v"(tid_));
    const int tid = tid_, wid = __builtin_amdgcn_readfirstlane(tid >> 6), lane = tid & 63, wr = wid >> 2, wc = wid & 3, fr = lane & 15, fq = lane >> 4;
    const int K = g.K, nt = K / BK;
    unsigned voffA[2], voffB[2];
#pragma unroll
    for (int i = 0; i < 2; ++i) { int R, C; stage_rc(tid * 16 + i * 8192, R, C); const int Rb = Epi::PERM ? ((R & ~31) + perm32(R & 31)) : R;
        voffA[i] = (unsigned)(R * g.lda + C) * 2u; voffB[i] = (unsigned)(Rb * g.ldb + C) * 2u; }
    const size_t kstep = (size_t)(BK * 2);
    const size_t hstepA = (size_t)HALF * g.lda * 2, hstepB = (size_t)HALF * g.ldb * 2;
    const unsigned ldsw = (unsigned)wid * 1024u;
    const int aoff = lds_byte(wr * 64 + fr, fq * 8), boff = lds_byte(wc * 32 + fr, fq * 8);
#define PG8_SA(b, h) (((b) * 2 + (h)) * HTB)
#define PG8_SB(b, h) ((4 + (b) * 2 + (h)) * HTB)
#define PG8_STAGE(bufoff, gbase, voff) do { _Pragma("unroll") for (int _i = 0; _i < 2; ++_i) \
        __builtin_amdgcn_global_load_lds((const unsigned*)((const char*)(gbase) + (voff)[_i]), (PG8_LAS unsigned*)(lds + (bufoff) + ldsw + _i * 8192), 16, 0, 0); } while (0)
#define PG8_LDA(dst, b, h) do { _Pragma("unroll") for (int m = 0; m < 4; ++m) _Pragma("unroll") for (int k = 0; k < 2; ++k) dst[m][k] = *(const PG8_LAS bf16x8*)(lds + PG8_SA(b, h) + aoff + m * 2048 + k * 1024); } while (0)
#define PG8_LDB(dst, b, h) do { _Pragma("unroll") for (int n = 0; n < 2; ++n) _Pragma("unroll") for (int k = 0; k < 2; ++k) dst[n][k] = *(const PG8_LAS bf16x8*)(lds + PG8_SB(b, h) + boff + n * 2048 + k * 1024); } while (0)
#define PG8_MMA(ai, bj, At, Bt) do { __builtin_amdgcn_s_setprio(1); _Pragma("unroll") for (int m = 0; m < 4; ++m) _Pragma("unroll") for (int n = 0; n < 2; ++n) _Pragma("unroll") for (int k = 0; k < 2; ++k) \
        acc[ai][bj][m][n] = __builtin_amdgcn_mfma_f32_16x16x32_bf16(Bt[n][k], At[m][k], acc[ai][bj][m][n], 0, 0, 0); __builtin_amdgcn_s_setprio(0); } while (0)
#define PG8_WAIT_V(n) asm volatile("s_waitcnt vmcnt(" #n ")" ::: "memory")
#define PG8_WAIT_L(n) asm volatile("s_waitcnt lgkmcnt(" #n ")" ::: "memory")
#define PG8_BAR __builtin_amdgcn_s_barrier()
#define PG8_SCHED __builtin_amdgcn_sched_barrier(0)
    Unit cur, nxt; int ui = 0;
    if (!S.next(0, cur)) return;
    f32x4 acc[2][2][4][2];
#pragma unroll
    for (int a = 0; a < 2; ++a)
#pragma unroll
        for (int b = 0; b < 2; ++b)
#pragma unroll
            for (int m = 0; m < 4; ++m)
#pragma unroll
                for (int n = 0; n < 2; ++n) acc[a][b][m][n] = (f32x4){0.f, 0.f, 0.f, 0.f};
    bf16x8 At[4][2], B0[2][2], B1[2][2];
    const char* cA = S.pa(g, cur); const char* cB = S.pb(g, cur);
    PG8_STAGE(PG8_SB(0, 0), cB, voffB); PG8_STAGE(PG8_SB(0, 1), cB + hstepB, voffB); PG8_STAGE(PG8_SA(0, 0), cA, voffA); PG8_STAGE(PG8_SA(0, 1), cA + hstepA, voffA);
    if (wr == 1) PG8_BAR;
    PG8_WAIT_V(2); PG8_BAR;
    PG8_STAGE(PG8_SB(1, 0), cB + kstep, voffB); PG8_STAGE(PG8_SA(1, 0), cA + kstep, voffA); PG8_STAGE(PG8_SB(1, 1), cB + hstepB + kstep, voffB);
    PG8_WAIT_V(6); PG8_BAR;
    for (;;) {
        const bool has_next = S.next(ui + 1, nxt);
        const char* nA = has_next ? S.pa(g, nxt) : cA; const char* nB = has_next ? S.pb(g, nxt) : cB;
#pragma nounroll
        for (int t = 0; t < nt; t += 2) {
            const bool last = (t == nt - 2);
            const char* a1 = cA + (size_t)(t + 1) * kstep;
            const char* a2 = last ? nA : cA + (size_t)(t + 2) * kstep; const char* b2 = last ? nB : cB + (size_t)(t + 2) * kstep;
            const char* a3 = a2 + kstep; const char* b3 = b2 + kstep;
            PG8_LDB(B0, 0, 0); PG8_LDB(B1, 0, 1); PG8_SCHED; PG8_LDA(At, 0, 0); PG8_STAGE(PG8_SA(1, 1), a1 + hstepA, voffA);
            PG8_WAIT_V(8); PG8_WAIT_L(0); PG8_BAR; PG8_MMA(0, 0, At, B0); PG8_MMA(0, 1, At, B1); PG8_BAR; PG8_SCHED;
            PG8_LDA(At, 0, 1); PG8_STAGE(PG8_SB(0, 0), b2, voffB); PG8_STAGE(PG8_SB(0, 1), b2 + hstepB, voffB); PG8_STAGE(PG8_SA(0, 0), a2, voffA);
            PG8_WAIT_V(8); PG8_WAIT_L(0); PG8_BAR; PG8_MMA(1, 0, At, B0); PG8_MMA(1, 1, At, B1); PG8_BAR; PG8_SCHED;
            PG8_LDB(B0, 1, 0); PG8_LDB(B1, 1, 1); PG8_SCHED; PG8_LDA(At, 1, 0); PG8_STAGE(PG8_SA(0, 1), a2 + hstepA, voffA);
            PG8_WAIT_V(8); PG8_WAIT_L(0); PG8_BAR; PG8_MMA(0, 0, At, B0); PG8_MMA(0, 1, At, B1); PG8_BAR; PG8_SCHED;
            PG8_LDA(At, 1, 1); PG8_STAGE(PG8_SB(1, 0), b3, voffB); PG8_STAGE(PG8_SB(1, 1), b3 + hstepB, voffB); PG8_STAGE(PG8_SA(1, 0), a3, voffA);
            PG8_WAIT_V(8); PG8_WAIT_L(0); PG8_BAR; PG8_MMA(1, 0, At, B0); PG8_MMA(1, 1, At, B1); PG8_BAR; PG8_SCHED;
        }
        if constexpr (ALIGN_EPI) { if (wr == 0) PG8_BAR; }
        if constexpr (!Epi::AFTER_DRAIN) { E(acc, cur, wr, wc, fr, fq); }
        if (!has_next) break;
#pragma unroll
        for (int a = 0; a < 2; ++a)
#pragma unroll
            for (int b = 0; b < 2; ++b)
#pragma unroll
                for (int m = 0; m < 4; ++m)
#pragma unroll
                    for (int n = 0; n < 2; ++n) acc[a][b][m][n] = (f32x4){0.f, 0.f, 0.f, 0.f};
        cur = nxt; cA = nA; cB = nB; ++ui;
        if constexpr (ALIGN_EPI) { if (wr == 1) PG8_BAR; }
    }
    PG8_WAIT_V(0);
    if constexpr (!ALIGN_EPI) { if (wr == 0) PG8_BAR; }
    PG8_BAR;
    if constexpr (Epi::AFTER_DRAIN) { E.fused(acc, cur, wr, wc, fr, fq, lds, wid, lane); }
#undef PG8_SA
#undef PG8_SB
#undef PG8_STAGE
#undef PG8_LDA
#undef PG8_LDB
#undef PG8_MMA
#undef PG8_WAIT_V
#undef PG8_WAIT_L
#undef PG8_BAR
#undef PG8_SCHED
}
}

constexpr int BATCH = 2, SEQ = 8192, D = 2048, DEPTH = 4, M = BATCH * SEQ;
constexpr int GW = 1024, GH = 8, GD = 128, SCW = 1024, NMEM = 256, XH = 4, XD = 512, DFF = 5632;
constexpr int NMIX_SRC = 7184, NMIX = 7168;
constexpr int PC_Q = 0, PC_K = 1024, PC_V = 2048, PC_Z = 3072, PC_B = 4096, PC_C = 5120, PC_H = 6144;
constexpr float EPS = 1e-6f;
constexpr int NWAVES = 8, NTHREADS = 512;

constexpr size_t MiB = 1u << 20;
constexpr size_t WS_CTL = 0, CTL_ZERO_BYTES = 1 * MiB;
constexpr size_t WS_WMIX = 1 * MiB;
constexpr size_t WS_WOUT = WS_WMIX + 112 * MiB;
constexpr size_t WS_WXQ  = WS_WOUT + 32 * MiB;
constexpr size_t WS_WXK  = WS_WXQ + 32 * MiB;
constexpr size_t WS_WXV  = WS_WXK + 32 * MiB;
constexpr size_t WS_WXO  = WS_WXV + 32 * MiB;
constexpr size_t WS_WUP  = WS_WXO + 32 * MiB;
constexpr size_t WS_WDN  = WS_WUP + 176 * MiB;
constexpr size_t WS_MEMN = WS_WDN + 88 * MiB;
constexpr size_t WS_KX   = WS_MEMN + 8 * MiB;
constexpr size_t WS_VX   = WS_KX + 8 * MiB;
constexpr size_t WS_BETA = WS_VX + 8 * MiB;
constexpr size_t WS_WBA  = WS_BETA + 512 * 1024;
constexpr size_t WS_G    = WS_BETA + 1 * MiB;
constexpr size_t WS_H    = WS_G + 1 * MiB;
constexpr size_t WS_OG   = WS_H + 64 * MiB;
constexpr size_t WS_Y    = WS_OG + 64 * MiB;
constexpr size_t WS_PB   = WS_OG;
constexpr size_t WS_HB   = WS_Y + 64 * MiB;
constexpr size_t WS_BIG  = WS_HB + 64 * MiB;
constexpr size_t WS_PROJ = WS_BIG;
constexpr size_t WS_GS   = WS_BIG + 224 * MiB;
constexpr size_t WS_ACT  = WS_BIG;
constexpr size_t WS_HALO = WS_BIG + 192 * MiB;
constexpr size_t WS_PART = WS_BIG + 200 * MiB;
constexpr size_t WS_WQK  = WS_BIG + 416 * MiB;
constexpr size_t WS_VWO  = WS_WQK + 32 * MiB;
constexpr size_t WS_END  = WS_VWO + 32 * MiB;
constexpr size_t WS_SSQ  = 65536;
static_assert(WS_SSQ + (size_t)DEPTH * 3 * M * 4 <= CTL_ZERO_BYTES, "ssq arrays inside the zeroed region");
constexpr int CW_BAR = 4096;

constexpr int RING_OFF = 0, RING_BYTES = 131072;
constexpr int LDSCTL_OFF = RING_BYTES, MISC_OFF = LDSCTL_OFF + 320, XB_OFF = LDSCTL_OFF + 1024;
constexpr int LDS_BYTES = 147456;

#define GAS __attribute__((address_space(1)))
#define LAS __attribute__((address_space(3)))
typedef unsigned short bf16;
typedef unsigned v4u __attribute__((ext_vector_type(4)));
typedef unsigned v2u __attribute__((ext_vector_type(2)));
typedef float f32x4 __attribute__((ext_vector_type(4)));
typedef short bf16x8 __attribute__((ext_vector_type(8)));
#define LDS_WAIT() asm volatile("s_waitcnt lgkmcnt(0)" ::: "memory")
#define VM_WAIT() asm volatile("s_waitcnt vmcnt(0)" ::: "memory")
__device__ __forceinline__ unsigned pk2(float lo, float hi) { return pg8::cvt_pk_bf16(lo, hi); }
__device__ __forceinline__ float bf_lo(unsigned w) { return __uint_as_float(w << 16); }
__device__ __forceinline__ float bf_hi(unsigned w) { return __uint_as_float(w & 0xffff0000u); }
__device__ __forceinline__ float wave_sum(float v) {
#pragma unroll
    for (int o = 1; o < 64; o <<= 1) v += __shfl_xor(v, o);
    return v;
}
__device__ __forceinline__ float silu_f(float y) { return y / (1.0f + __expf(-y)); }
__device__ __forceinline__ float sigmoid_f(float y) { return 1.0f / (1.0f + __expf(-y)); }

#define XB_TMO      128
#define XB_XCNT(j)  (256  + 64 * (j))
#define XB_XSUB(j)  (1280 + 64 * (j))
#define XB_XGEN(j)  (2304 + 64 * (j))
#define XB_TOP      3328
#define XB_TOPGEN   3392
#define XCD_BAR_WORDS 3456
#define XB_SPIN_CAP (1u << 18)

__device__ __forceinline__ unsigned xb_ld(unsigned* p)              { return __hip_atomic_load(p, __ATOMIC_RELAXED, __HIP_MEMORY_SCOPE_AGENT); }
__device__ __forceinline__ unsigned xb_add(unsigned* p, unsigned v) { return __hip_atomic_fetch_add(p, v, __ATOMIC_RELAXED, __HIP_MEMORY_SCOPE_AGENT); }
__device__ __forceinline__ unsigned xb_xcc_id() { return (unsigned)__builtin_amdgcn_s_getreg((3 << 11) | 20) & 0xFu; }
#define XB_SPIN(cond, bar) do { unsigned _sp = 0; while (cond) { __builtin_amdgcn_s_sleep(1); \
    if ((++_sp & 255u) == 0u) { if (xb_ld(&(bar)[XB_TMO])) break; if (_sp > XB_SPIN_CAP) { atomicAdd(&(bar)[XB_TMO], 1u); break; } } } } while (0)

struct XcdBarrier {
    unsigned* bar; unsigned x;
    volatile LAS unsigned* st;
};

__device__ __forceinline__ XcdBarrier xcd_barrier_post(unsigned* bar, volatile LAS unsigned* st) {
    XcdBarrier b; b.bar = bar; b.x = xb_xcc_id(); b.st = st;
    if (threadIdx.x == 0) (void)xb_add(&bar[XB_XCNT(b.x)], 1u);
    return b;
}
__device__ __forceinline__ void xcd_barrier_complete(unsigned* bar, unsigned x, unsigned& nloc, unsigned& nx) {
    const unsigned G = gridDim.x * gridDim.y * gridDim.z;
    unsigned sum, cnt, mine, sp = 0u;
    for (;;) {
        sum = 0u; cnt = 0u; mine = 0u;
#pragma unroll
        for (unsigned j = 0; j < 16; ++j) { const unsigned c = xb_ld(&bar[XB_XCNT(j)]); sum += c; cnt += (c > 0u) ? 1u : 0u; mine = (j == x) ? c : mine; }
        if (sum == G) break;
        __builtin_amdgcn_s_sleep(1);
        if ((++sp & 255u) == 0u) { if (xb_ld(&bar[XB_TMO])) break; if (sp > XB_SPIN_CAP) { atomicAdd(&bar[XB_TMO], 1u); break; } }
    }
    nloc = mine > 0u ? mine : 1u; nx = cnt > 0u ? cnt : 1u;
}

__device__ __forceinline__ void xcd_barrier(const XcdBarrier& b) {
    asm volatile("s_waitcnt vmcnt(0)" ::: "memory");
    __syncthreads();
    if (threadIdx.x == 0) {
        unsigned* bar = b.bar;
        __builtin_amdgcn_s_waitcnt(0);
        unsigned nloc = b.st[0], nx = b.st[1];
        if (nloc == 0u) { xcd_barrier_complete(bar, b.x, nloc, nx); b.st[0] = nloc; b.st[1] = nx; }
        const unsigned old = xb_add(&bar[XB_XSUB(b.x)], 1u);
        const unsigned gen = old / nloc;
        if (old + 1u == (gen + 1u) * nloc) {
            __builtin_amdgcn_fence(__ATOMIC_RELEASE, "agent");
            asm volatile("s_waitcnt vmcnt(0)" ::: "memory");
            const unsigned og = xb_add(&bar[XB_TOP], 1u);
            const unsigned tg = og / nx;
            if (og + 1u == (tg + 1u) * nx) xb_add(&bar[XB_TOPGEN], 1u);
            else XB_SPIN(xb_ld(&bar[XB_TOPGEN]) == tg, bar);
            __builtin_amdgcn_fence(__ATOMIC_ACQUIRE, "agent");
            xb_add(&bar[XB_XGEN(b.x)], 1u);
            asm volatile("s_waitcnt vmcnt(0)" ::: "memory");
        } else {
            XB_SPIN(xb_ld(&bar[XB_XGEN(b.x)]) == gen, bar);
            __builtin_amdgcn_fence(__ATOMIC_ACQUIRE, "agent");
            asm volatile("s_waitcnt vmcnt(0)" ::: "memory");
        }
    }
    __syncthreads();
}


struct Frame {
    LAS unsigned char* lds;
    int tid, lane, wave, G, gw, NGW;
    unsigned char* ws;
};
#define IN_X 0
#define IN_MEM 1
#define IN_MIX_NORM 2
#define IN_W_MIX_IN 3
#define IN_GDN_CONV 4
#define IN_A_LOG 5
#define IN_DT_BIAS 6
#define IN_OUT_NORM 7
#define IN_SC_CONV 8
#define IN_W_MIX_OUT 9
#define IN_XATTN_NORM 10
#define IN_MEM_NORM 11
#define IN_W_XQ 12
#define IN_W_XK 13
#define IN_W_XV 14
#define IN_W_XO 15
#define IN_FFN_NORM 16
#define IN_W_UP 17
#define IN_FFN_CONV 18
#define IN_W_DOWN 19
#define IN_FINAL_NORM 20

__device__ __forceinline__ void xpose_item(const float* src  , size_t ld, bf16* dst  , size_t K, int lane, LAS unsigned char* T) {
    const int n4 = lane & 15, ksub = lane >> 4;
    const float* s = src + (size_t)(16 * ksub) * ld + 4 * n4;
    f32x4 v[16];
#pragma unroll
    for (int i = 0; i < 16; ++i) v[i] = *(const f32x4*)(s + (size_t)i * ld);
#pragma unroll
    for (int j = 0; j < 4; ++j) { v4u a, b; a.x = pk2(v[0][j], v[1][j]); a.y = pk2(v[2][j], v[3][j]); a.z = pk2(v[4][j], v[5][j]); a.w = pk2(v[6][j], v[7][j]);
        b.x = pk2(v[8][j], v[9][j]); b.y = pk2(v[10][j], v[11][j]); b.z = pk2(v[12][j], v[13][j]); b.w = pk2(v[14][j], v[15][j]);
        LAS v4u* t = (LAS v4u*)(T + (4 * n4 + j) * 144 + 32 * ksub); t[0] = a; t[1] = b; }
    LDS_WAIT(); asm volatile("" ::: "memory");
#pragma unroll
    for (int i = 0; i < 8; ++i) { const int n = 8 * i + (lane >> 3), c = lane & 7; *(v4u*)(dst + (size_t)n * K + 8 * c) = *(const LAS v4u*)(T + n * 144 + 16 * c); }
    LDS_WAIT(); asm volatile("" ::: "memory");
}
__device__ __forceinline__ void convert_item(const float* src, bf16* dst, int lane) {
#pragma unroll
    for (int k = 0; k < 8; ++k) { const f32x4 a = *(const f32x4*)(src + k * 512 + 8 * lane), b = *(const f32x4*)(src + k * 512 + 8 * lane + 4);
        v4u o; o.x = pk2(a[0], a[1]); o.y = pk2(a[2], a[3]); o.z = pk2(b[0], b[1]); o.w = pk2(b[2], b[3]); *(v4u*)(dst + k * 512 + 8 * lane) = o; }
}
__device__ __forceinline__ void p0_weights_x(Frame& F, const float* w_xq, const float* w_xk, const float* w_xv, const float* w_xo) {
    constexpr int I_SQ = 32 * 32, I_XQ = D * D / 4096, I_LAYER = 3 * I_SQ + I_XQ;
    LAS unsigned char* T = F.lds + RING_OFF + F.wave * 9216;
    for (int it = F.gw; it < DEPTH * I_LAYER; it += F.NGW) {
        const int l = it / I_LAYER; int r = it % I_LAYER;
        if (r < 3 * I_SQ) { const int f = r / I_SQ, rr = r % I_SQ, nb = rr >> 5, kb = rr & 31;
            const float* src = f == 0 ? w_xk : f == 1 ? w_xv : w_xo;
            const size_t dofs = f == 0 ? WS_WXK : f == 1 ? WS_WXV : WS_WXO;
            xpose_item(src + (size_t)l * D * D + (size_t)(kb * 64) * D + nb * 64, D, (bf16*)(F.ws + dofs) + (size_t)l * D * D + (size_t)(nb * 64) * D + kb * 64, D, F.lane, T); continue; }
        r -= 3 * I_SQ;
        convert_item(w_xq + (size_t)l * D * D + (size_t)r * 4096, (bf16*)(F.ws + WS_WXQ) + (size_t)l * D * D + (size_t)r * 4096, F.lane);
    }
}
__device__ __forceinline__ void p0_weights_main(Frame& F, int l, int gw, int ngw, const float* w_mix_in, const float* w_mix_out, const float* w_up, const float* w_down) {
    constexpr int I_MIX = 112 * 32, I_SQ = 32 * 32, I_UP = 176 * 32, I_DN = 32 * 88, I_LAYER = I_MIX + I_SQ + I_UP + I_DN;
    LAS unsigned char* T = F.lds + RING_OFF + F.wave * 9216;
    for (int it = gw; it < I_LAYER; it += ngw) {
        int r = it;
        if (r < I_MIX) { const int nb = r >> 5, kb = r & 31, n0 = nb * 64, sc = n0 < 4096 ? n0 : n0 + 16;
            xpose_item(w_mix_in + (size_t)l * D * NMIX_SRC + (size_t)(kb * 64) * NMIX_SRC + sc, NMIX_SRC, (bf16*)(F.ws + WS_WMIX) + (size_t)l * NMIX * D + (size_t)n0 * D + kb * 64, D, F.lane, T); continue; }
        r -= I_MIX;
        if (r < I_SQ) { const int nb = r >> 5, kb = r & 31;
            xpose_item(w_mix_out + (size_t)l * D * D + (size_t)(kb * 64) * D + nb * 64, D, (bf16*)(F.ws + WS_WOUT) + (size_t)l * D * D + (size_t)(nb * 64) * D + kb * 64, D, F.lane, T); continue; }
        r -= I_SQ;
        if (r < I_UP) { const int nb = r >> 5, kb = r & 31, n0 = nb * 64, c0 = n0 < DFF ? n0 : n0 - DFF, drow = (c0 >> 7) * 256 + (n0 < DFF ? 0 : 128) + (c0 & 127);
            xpose_item(w_up + (size_t)l * D * 2 * DFF + (size_t)(kb * 64) * 2 * DFF + n0, 2 * DFF, (bf16*)(F.ws + WS_WUP) + (size_t)l * 2 * DFF * D + (size_t)drow * D + kb * 64, D, F.lane, T); continue; }
        r -= I_UP;
        { const int nb = r / 88, kb = r % 88;
            xpose_item(w_down + (size_t)l * DFF * D + (size_t)(kb * 64) * D + nb * 64, D, (bf16*)(F.ws + WS_WDN) + (size_t)l * D * DFF + (size_t)(nb * 64) * DFF + kb * 64, DFF, F.lane, T); }
    }
    for (int i = gw * 64 + F.lane; i < 16 * D; i += ngw * 64) { const int n = i / D, k = i % D;
        ((bf16*)(F.ws + WS_WBA))[(size_t)l * 16 * D + i] = (bf16)(pk2(w_mix_in[(size_t)l * D * NMIX_SRC + (size_t)k * NMIX_SRC + 4096 + n], 0.f) & 0xffffu); }
}
__device__ __forceinline__ void p0_memn(Frame& F, const float* mem, const float* mem_norm) {
    for (int m = F.gw; m < BATCH * NMEM; m += F.NGW) {
        const f32x4* xr = (const f32x4*)(mem + (size_t)m * D) + F.lane;
        f32x4 v[8]; float s = 0.f;
#pragma unroll
        for (int j = 0; j < 8; ++j) { v[j] = xr[64 * j]; s += (v[j][0] * v[j][0] + v[j][1] * v[j][1]) + (v[j][2] * v[j][2] + v[j][3] * v[j][3]); }
        const float rstd = 1.0f / sqrtf(wave_sum(s) * (1.0f / D) + EPS);
        for (int l = 0; l < DEPTH; ++l) {
            const f32x4* gr = (const f32x4*)(mem_norm + (size_t)l * D) + F.lane;
            v2u* o8 = (v2u*)((bf16*)(F.ws + WS_MEMN) + ((size_t)l * 512 + m) * D) + F.lane;
#pragma unroll
            for (int j = 0; j < 8; ++j) { const f32x4 g4 = gr[64 * j]; const f32x4 h = v[j] * rstd * g4; v2u o; o.x = pk2(h[0], h[1]); o.y = pk2(h[2], h[3]); o8[64 * j] = o; }
        }
    }
}

__device__ __forceinline__ void prenorm_phase(Frame& F, const float* x, const float* gain, bf16* Hn, float* ssq) {
    f32x4 g4[8];
#pragma unroll
    for (int j = 0; j < 8; ++j) g4[j] = ((const f32x4*)gain)[64 * j + F.lane];
    for (int m = F.gw; m < M; m += F.NGW) {
        const f32x4* xr = (const f32x4*)(x + (size_t)m * D) + F.lane;
        f32x4 v[8]; float s = 0.f;
#pragma unroll
        for (int j = 0; j < 8; ++j) { v[j] = xr[64 * j]; s += (v[j][0] * v[j][0] + v[j][1] * v[j][1]) + (v[j][2] * v[j][2] + v[j][3] * v[j][3]); }
        s = wave_sum(s);
        if (F.lane == 0) ssq[m] = s;
        v2u* o8 = (v2u*)(Hn + (size_t)m * D) + F.lane;
#pragma unroll
        for (int j = 0; j < 8; ++j) { v[j] = v[j] * g4[j]; v2u o; o.x = pk2(v[j][0], v[j][1]); o.y = pk2(v[j][2], v[j][3]); o8[64 * j] = o; }
    }
}
__device__ __forceinline__ void ba_phase(Frame& F, const bf16* Hn, const float* ssq, const bf16* wba  , const float* alogp, const float* dtbp) {
    const int lane = F.lane, wave = F.wave, mtile = wave & 3, khalf = wave >> 2, fr = lane & 15, fq = lane >> 4;
    LAS f32x4* red = (LAS f32x4*)(F.lds);
    for (int rb = blockIdx.x; rb < M / 64; rb += F.G) {
        const int row0 = rb * 64 + 16 * mtile;
        const bf16* ap = Hn + (size_t)(row0 + fr) * D + khalf * 1024 + 8 * fq;
        const bf16* bp = wba + (size_t)fr * D + khalf * 1024 + 8 * fq;
        f32x4 acc = {0.f, 0.f, 0.f, 0.f};
#pragma unroll 8
        for (int s = 0; s < 32; ++s) { const bf16x8 a = __builtin_bit_cast(bf16x8, *(const v4u*)(ap + 32 * s)), b = __builtin_bit_cast(bf16x8, *(const v4u*)(bp + 32 * s));
            acc = __builtin_amdgcn_mfma_f32_16x16x32_bf16(a, b, acc, 0, 0, 0); }
        if (khalf == 1) red[mtile * 64 + lane] = acc;
        LDS_WAIT(); __syncthreads();
        if (khalf == 0) {
            const f32x4 o = red[mtile * 64 + lane]; acc = acc + o;
            const float al = fr >= 8 ? alogp[fr - 8] : 0.f, db = fr >= 8 ? dtbp[fr - 8] : 0.f;
#pragma unroll
            for (int i = 0; i < 4; ++i) { const int row = row0 + 4 * fq + i; const float v = acc[i] * (1.0f / sqrtf(ssq[row] * (1.0f / D) + EPS));
                if (fr < 8) ((float*)(F.ws + WS_BETA))[(size_t)row * GH + fr] = sigmoid_f(v);
                else { const float z = v + db; const float sp = fmaxf(z, 0.f) + log1pf(expf(-fabsf(z))); ((float*)(F.ws + WS_G))[(size_t)row * GH + fr - 8] = -expf(al) * sp; } }
        }
        LDS_WAIT(); __syncthreads();
    }
}
__device__ __forceinline__ void final_norm_phase(Frame& F, const float* x, const float* gain, float* out) {
    f32x4 g4[8];
#pragma unroll
    for (int j = 0; j < 8; ++j) g4[j] = ((const f32x4*)gain)[64 * j + F.lane];
    for (int m = F.gw; m < M; m += F.NGW) {
        const f32x4* xr = (const f32x4*)(x + (size_t)m * D) + F.lane;
        f32x4 v[8]; float s = 0.f;
#pragma unroll
        for (int j = 0; j < 8; ++j) { v[j] = xr[64 * j]; s += (v[j][0] * v[j][0] + v[j][1] * v[j][1]) + (v[j][2] * v[j][2] + v[j][3] * v[j][3]); }
        const float rstd = 1.0f / sqrtf(wave_sum(s) * (1.0f / D) + EPS);
        f32x4* o = (f32x4*)(out + (size_t)m * D) + F.lane;
#pragma unroll
        for (int j = 0; j < 8; ++j) o[64 * j] = v[j] * rstd * g4[j];
    }
}

__device__ __forceinline__ void unpack8(const v4u w, float (&f)[8]) {
    f[0] = bf_lo(w.x); f[1] = bf_hi(w.x); f[2] = bf_lo(w.y); f[3] = bf_hi(w.y); f[4] = bf_lo(w.z); f[5] = bf_hi(w.z); f[6] = bf_lo(w.w); f[7] = bf_hi(w.w);
}

__device__ __forceinline__ void shortconv_phase(Frame& F, const float* cw, int gw, int ngw) {
    const bf16* PROJ = (const bf16*)(F.ws + WS_PROJ);
    bf16* Y = (bf16*)(F.ws + WS_Y);
    for (int rb = gw; rb < M / 8; rb += ngw) {
        const int m0 = rb * 8, t0 = m0 % SEQ;
        for (int i = 0; i < 2; ++i) {
            const int ch0 = 8 * (F.lane + 64 * i);
            float w[3][8];
#pragma unroll
            for (int j = 0; j < 3; ++j) { const f32x4 a = *(const f32x4*)(cw + (size_t)j * SCW + ch0), b = *(const f32x4*)(cw + (size_t)j * SCW + ch0 + 4);
                w[j][0] = a[0]; w[j][1] = a[1]; w[j][2] = a[2]; w[j][3] = a[3]; w[j][4] = b[0]; w[j][5] = b[1]; w[j][6] = b[2]; w[j][7] = b[3]; }
            float x0[8], x1[8], x2[8], cg[8], hh[8], bg[8];
            const bf16* p = PROJ + (size_t)m0 * NMIX + ch0;
            if (t0 >= 2) {
                unpack8(*(const v4u*)(p - 2 * (size_t)NMIX + PC_C), cg); unpack8(*(const v4u*)(p - 2 * (size_t)NMIX + PC_H), hh);
#pragma unroll
                for (int e = 0; e < 8; ++e) x0[e] = cg[e] * hh[e];
                unpack8(*(const v4u*)(p - (size_t)NMIX + PC_C), cg); unpack8(*(const v4u*)(p - (size_t)NMIX + PC_H), hh);
#pragma unroll
                for (int e = 0; e < 8; ++e) x1[e] = cg[e] * hh[e];
            } else {
#pragma unroll
                for (int e = 0; e < 8; ++e) { x0[e] = 0.f; x1[e] = 0.f; } }
            for (int r = 0; r < 8; ++r) {
                unpack8(*(const v4u*)(p + (size_t)r * NMIX + PC_C), cg); unpack8(*(const v4u*)(p + (size_t)r * NMIX + PC_H), hh); unpack8(*(const v4u*)(p + (size_t)r * NMIX + PC_B), bg);
                float y[8];
#pragma unroll
                for (int e = 0; e < 8; ++e) { x2[e] = cg[e] * hh[e]; y[e] = bg[e] * (w[0][e] * x0[e] + w[1][e] * x1[e] + w[2][e] * x2[e]); x0[e] = x1[e]; x1[e] = x2[e]; }
                v4u o; o.x = pk2(y[0], y[1]); o.y = pk2(y[2], y[3]); o.z = pk2(y[4], y[5]); o.w = pk2(y[6], y[7]);
                *(v4u*)(Y + (size_t)(m0 + r) * D + GW + ch0) = o;
            }
        }
    }
}
__device__ __forceinline__ void swiglu_fix_phase(Frame& F, const float* cw) {
    bf16* ACT = (bf16*)(F.ws + WS_ACT); const float* PART = (const float*)(F.ws + WS_PART); const float* HALO = (const float*)(F.ws + WS_HALO);
    for (int idx = F.gw * 64 + F.lane; idx < (M / 256) * (DFF / 4); idx += F.NGW * 64) {
        const int pm = idx / (DFF / 4), ch = 4 * (idx % (DFF / 4));
        f32x4 wg[3], wu[3];
#pragma unroll
        for (int t = 0; t < 3; ++t) { wg[t] = *(const f32x4*)(cw + (size_t)t * 2 * DFF + ch); wu[t] = *(const f32x4*)(cw + (size_t)t * 2 * DFF + DFF + ch); }
        f32x4 g0 = *(const f32x4*)(PART + ((size_t)(pm * 2 + 0) * 2 + 0) * DFF + ch), u0 = *(const f32x4*)(PART + ((size_t)(pm * 2 + 0) * 2 + 1) * DFF + ch);
        f32x4 g1 = *(const f32x4*)(PART + ((size_t)(pm * 2 + 1) * 2 + 0) * DFF + ch), u1 = *(const f32x4*)(PART + ((size_t)(pm * 2 + 1) * 2 + 1) * DFF + ch);
        if (pm % (SEQ / 256) != 0) {
            const f32x4 hg0 = *(const f32x4*)(HALO + ((size_t)((pm - 1) * 2 + 0) * 2 + 0) * DFF + ch), hu0 = *(const f32x4*)(HALO + ((size_t)((pm - 1) * 2 + 0) * 2 + 1) * DFF + ch);
            const f32x4 hg1 = *(const f32x4*)(HALO + ((size_t)((pm - 1) * 2 + 1) * 2 + 0) * DFF + ch), hu1 = *(const f32x4*)(HALO + ((size_t)((pm - 1) * 2 + 1) * 2 + 1) * DFF + ch);
            g0 = g0 + wg[1] * hg1 + wg[0] * hg0; u0 = u0 + wu[1] * hu1 + wu[0] * hu0; g1 = g1 + wg[0] * hg1; u1 = u1 + wu[0] * hu1;
        }
        v2u w0, w1; w0.x = pk2(silu_f(g0[0]) * u0[0], silu_f(g0[1]) * u0[1]); w0.y = pk2(silu_f(g0[2]) * u0[2], silu_f(g0[3]) * u0[3]);
        w1.x = pk2(silu_f(g1[0]) * u1[0], silu_f(g1[1]) * u1[1]); w1.y = pk2(silu_f(g1[2]) * u1[2], silu_f(g1[3]) * u1[3]);
        *(v2u*)(ACT + (size_t)(pm * 256) * DFF + ch) = w0; *(v2u*)(ACT + (size_t)(pm * 256 + 1) * DFF + ch) = w1;
    }
}

struct KvOrder {
    int G, c; const bf16 *memn, *wxk, *wxv;
    __device__ __forceinline__ bool next(int i, pg8::Unit& u) const { const long L = (long)i * G + c; if (L >= 128) return false; u.pm = (int)L; u.pn = 0; return true; }
    __device__ __forceinline__ const char* pa(const pg8::Gemm&, const pg8::Unit& u) const { const int l = u.pm >> 5, r = u.pm & 15; return (const char*)(memn + ((size_t)l * 512 + (r >> 3) * 256) * D); }
    __device__ __forceinline__ const char* pb(const pg8::Gemm&, const pg8::Unit& u) const { const int l = u.pm >> 5, r = u.pm & 15;
        const bf16* wk = wxk + ((size_t)l * D + (r & 7) * 256) * D; const bf16* wv = wxv + ((size_t)l * D + (r & 7) * 256) * D; return (const char*)((u.pm & 16) ? wv : wk); }
};
struct LocKv { bf16 *kx, *vx;
    __device__ __forceinline__ void operator()(const pg8::Unit& u, bf16*& base, int& ld) const { const int l = u.pm >> 5, r = u.pm & 15;
        bf16* bk = kx + ((size_t)l * 512 + (r >> 3) * 256) * D + (r & 7) * 256; bf16* bv = vx + ((size_t)l * 512 + (r >> 3) * 256) * D + (r & 7) * 256; base = (u.pm & 16) ? bv : bk; ld = D; } };
struct PreOrder {
    int G, c; const bf16 *kx, *vx, *wxq, *wxo;
    __device__ __forceinline__ bool next(int i, pg8::Unit& u) const { const long L = (long)i * G + c; if (L >= 512) return false; u.pm = (int)L; u.pn = 0; return true; }
    __device__ __forceinline__ const char* pa(const pg8::Gemm&, const pg8::Unit& u) const { const int jj = u.pm & 255, l = jj >> 6, b = (jj >> 5) & 1, h = (jj >> 3) & 3, t = jj & 7;
        return (const char*)(u.pm < 256 ? kx + ((size_t)l * 512 + b * 256) * D + h * XD : wxo + ((size_t)l * D + t * 256) * D + h * XD); }
    __device__ __forceinline__ const char* pb(const pg8::Gemm&, const pg8::Unit& u) const { const int jj = u.pm & 255, l = jj >> 6, b = (jj >> 5) & 1, h = (jj >> 3) & 3, t = jj & 7;
        return (const char*)(u.pm < 256 ? wxq + ((size_t)l * D + t * 256) * D + h * XD : vx + ((size_t)l * 512 + b * 256) * D + h * XD); }
};
struct LocPre { bf16 *wqk, *vwo;
    __device__ __forceinline__ void operator()(const pg8::Unit& u, bf16*& base, int& ld) const { const int jj = u.pm & 255, l = jj >> 6, b = (jj >> 5) & 1, h = (jj >> 3) & 3, t = jj & 7;
        if (u.pm < 256) { base = wqk + ((size_t)(l * 2 + b) * (XH * NMEM) + h * NMEM) * D + t * 256; ld = D; }
        else { base = vwo + ((size_t)(l * 2 + b) * D + t * 256) * (XH * NMEM) + h * NMEM; ld = XH * NMEM; } } };
struct SOrder {
    int G, c;
    __device__ __forceinline__ bool next(int i, pg8::Unit& u) const { const long L = (long)i * G + c; if (L >= 256) return false; u.pm = (int)L & 63; u.pn = (int)L >> 6; return true; }
    __device__ __forceinline__ const char* pa(const pg8::Gemm& g, const pg8::Unit& u) const { return (const char*)(g.A + (size_t)u.pm * 256 * D); }
    __device__ __forceinline__ const char* pb(const pg8::Gemm& g, const pg8::Unit& u) const { return (const char*)(g.Bt + (size_t)(u.pm >> 5) * (XH * NMEM) * D + (size_t)u.pn * NMEM * D); }
};
struct BatchOrder : pg8::StaticOrder {
    size_t bstride;
    __device__ __forceinline__ const char* pb(const pg8::Gemm& g, const pg8::Unit& u) const { return (const char*)(g.Bt + (size_t)(u.pm >> 5) * bstride + (size_t)u.pn * pg8::BM * g.ldb); }
};

typedef float f32x16 __attribute__((ext_vector_type(16)));
typedef float f32x2n __attribute__((ext_vector_type(2)));
typedef __bf16 bf16x2n __attribute__((ext_vector_type(2)));
__device__ __forceinline__ unsigned pkn(float a, float b) { f32x2n v = {a, b}; bf16x2n r = __builtin_convertvector(v, bf16x2n); return __builtin_bit_cast(unsigned, r); }
__device__ __forceinline__ int kmap(int p) { const int pp = p & 15, hh = pp >> 3, jj = pp & 7; return (p & ~15) + 8 * (jj >> 2) + 4 * hh + (jj & 3); }
__device__ __forceinline__ int kpos(int d) { const int dd = d & 15; return (d & ~15) + 8 * ((dd >> 2) & 1) + 4 * (dd >> 3) + (dd & 3); }
__device__ __forceinline__ bf16x8 pack_step(const f32x16& x, int s) {
    v4u w; w.x = pkn(x[8 * s], x[8 * s + 1]); w.y = pkn(x[8 * s + 2], x[8 * s + 3]); w.z = pkn(x[8 * s + 4], x[8 * s + 5]); w.w = pkn(x[8 * s + 6], x[8 * s + 7]);
    return __builtin_bit_cast(bf16x8, w);
}
constexpr int REC_BYTES = 36864, WIMG_STRIDE = 272, KDIMG_OFF = 17408, KDIMG_STRIDE = 144, IMG_USED = 35840;
constexpr size_t WS_REC = WS_GS;
constexpr size_t WS_UT = WS_GS + 80 * MiB;
constexpr size_t WS_ATTN = WS_GS + 144 * MiB;
constexpr size_t WS_EGL = WS_GS + 160 * MiB;
constexpr size_t WS_SST = WS_H;
constexpr size_t WS_QD = WS_OG;
constexpr size_t WS_VST = WS_OG + 32 * MiB;

__device__ __forceinline__ void gdn_prep_phase(Frame& F, const float* cw  ) {
    const bf16* PROJ = (const bf16*)(F.ws + WS_PROJ);
    const float* BETA = (const float*)(F.ws + WS_BETA); const float* GG = (const float*)(F.ws + WS_G);
    unsigned o_vs = 32768, o_kb = 65536, o_qb = 82944, o_as = 101376, o_att = 117760, o_gc = 125952;
    asm volatile("" : "+v"(o_vs), "+v"(o_kb), "+v"(o_qb), "+v"(o_as), "+v"(o_att), "+v"(o_gc));
    LAS float* KS = (LAS float*)(F.lds);
    LAS float* VS = (LAS float*)(F.lds + o_vs);
    LAS unsigned char* KB16 = F.lds + o_kb;
    LAS unsigned char* QB16 = F.lds + o_qb;
    LAS unsigned char* IMG = KB16;
    LAS float* AS = (LAS float*)(F.lds + o_as);
    LAS unsigned short* ATT = (LAS unsigned short*)(F.lds + o_att);
    LAS float* GC = (LAS float*)(F.lds + o_gc);
    const int tid = F.tid, lane = F.lane, wave = F.wave;
#ifndef G1_REP
#define G1_REP 1
#endif
    for (int it = 0; it * F.G < 2048 * G1_REP; ++it) {
        const int u = blockIdx.x + F.G * (it / G1_REP);
        const int ch = u, n = ch & 127, bh = ch >> 7, b = bh >> 3, h = bh & 7;
        const int m0 = b * SEQ + n * 64;
        if (tid < 384) {
            const int rb = tid / 48, cgi = tid % 48, tensor = cgi >> 4, cg = cgi & 15;
            const int ch0 = tensor * GW + h * GD + 8 * cg, c0 = rb * 8;
            float w[4][8];
#pragma unroll
            for (int j = 0; j < 4; ++j) { const f32x4 a = *(const f32x4*)(cw + (size_t)j * 3 * GW + ch0), bq = *(const f32x4*)(cw + (size_t)j * 3 * GW + ch0 + 4);
                w[j][0] = a[0]; w[j][1] = a[1]; w[j][2] = a[2]; w[j][3] = a[3]; w[j][4] = bq[0]; w[j][5] = bq[1]; w[j][6] = bq[2]; w[j][7] = bq[3]; }
            float x0[8], x1[8], x2[8], x3[8];
            const bf16* p = PROJ + (size_t)(m0 + c0) * NMIX + ch0;
            if (n * 64 + c0 >= 3) { unpack8(*(const v4u*)(p - 3 * (size_t)NMIX), x0); unpack8(*(const v4u*)(p - 2 * (size_t)NMIX), x1); unpack8(*(const v4u*)(p - (size_t)NMIX), x2); }
            else {
#pragma unroll
                for (int e = 0; e < 8; ++e) { x0[e] = 0.f; x1[e] = 0.f; x2[e] = 0.f; } }
            for (int r = 0; r < 8; ++r) {
                unpack8(*(const v4u*)(p + (size_t)r * NMIX), x3);
                float y[8]; float ss = 0.f;
#pragma unroll
                for (int e = 0; e < 8; ++e) { const float c = w[0][e] * x0[e] + w[1][e] * x1[e] + w[2][e] * x2[e] + w[3][e] * x3[e]; y[e] = silu_f(c); ss += y[e] * y[e]; x0[e] = x1[e]; x1[e] = x2[e]; x2[e] = x3[e]; }
                const int c = c0 + r;
                if (tensor < 2) {
                    ss += __shfl_xor(ss, 1); ss += __shfl_xor(ss, 2); ss += __shfl_xor(ss, 4); ss += __shfl_xor(ss, 8);
                    float sc = 1.0f / sqrtf(ss + EPS); if (tensor == 0) sc *= 0.08838834764831845f;
#pragma unroll
                    for (int e = 0; e < 8; ++e) y[e] *= sc;
                    v4u o; o.x = pkn(y[0], y[1]); o.y = pkn(y[2], y[3]); o.z = pkn(y[4], y[5]); o.w = pkn(y[6], y[7]);
                    *(LAS v4u*)((tensor == 0 ? QB16 : KB16) + c * WIMG_STRIDE + 16 * cg) = o;
                    if (tensor == 1) { *(LAS f32x4*)(KS + c * 128 + 8 * cg) = (f32x4){y[0], y[1], y[2], y[3]}; *(LAS f32x4*)(KS + c * 128 + 8 * cg + 4) = (f32x4){y[4], y[5], y[6], y[7]}; }
                } else { *(LAS f32x4*)(VS + c * 128 + 8 * cg) = (f32x4){y[0], y[1], y[2], y[3]}; *(LAS f32x4*)(VS + c * 128 + 8 * cg + 4) = (f32x4){y[4], y[5], y[6], y[7]}; }
            }
        } else if (wave == 7) {
            const float g = GG[(size_t)(m0 + lane) * GH + h], be = BETA[(size_t)(m0 + lane) * GH + h];
            float x = g;
#pragma unroll
            for (int o = 1; o < 64; o <<= 1) { const float t = __shfl_up(x, o); if (lane >= o) x += t; }
            const float gl = __shfl(x, 63);
            GC[lane] = x; GC[64 + lane] = be; GC[128 + lane] = expf(x); GC[192 + lane] = expf(gl - x);
            if (lane == 0) ((float*)(F.ws + WS_EGL))[ch] = expf(gl);
        }
        LDS_WAIT(); __syncthreads();
        {
            const int mat = wave >> 2, mt = (wave >> 1) & 1, nt = wave & 1, r = lane & 31, hh = lane >> 5;
            const LAS unsigned char* Asrc = (mat ? QB16 : KB16) + (32 * mt + r) * WIMG_STRIDE + 16 * hh;
            const LAS unsigned char* Bsrc = KB16 + (32 * nt + r) * WIMG_STRIDE + 16 * hh;
            f32x16 acc;
#pragma unroll
            for (int i = 0; i < 16; ++i) acc[i] = 0.f;
#pragma unroll
            for (int ks = 0; ks < 8; ++ks) { const bf16x8 a = *(const LAS bf16x8*)(Asrc + 32 * ks), bb = *(const LAS bf16x8*)(Bsrc + 32 * ks); acc = __builtin_amdgcn_mfma_f32_32x32x16_bf16(a, bb, acc, 0, 0, 0); }
            const int m = 32 * nt + r; const float gcm = GC[m];
#pragma unroll
            for (int i = 0; i < 16; ++i) {
                const int c = 32 * mt + (i & 3) + 8 * (i >> 2) + 4 * hh;
                if (mat == 0) AS[c * 64 + m] = (m > c) ? GC[64 + m] * acc[i] * expf(fminf(gcm - GC[c], 0.f)) : 0.f;
                else { const float v = (m <= c) ? acc[i] * expf(fminf(GC[c] - gcm, 0.f)) : 0.f; ATT[c * 64 + kpos(m)] = (unsigned short)(pkn(v, 0.f) & 0xffffu); }
            }
            const int c = tid >> 3, p0 = (tid & 7) * 16; const float eg = GC[128 + c];
            const LAS unsigned short* qrow = (const LAS unsigned short*)(QB16 + c * WIMG_STRIDE);
            float qv[16];
#pragma unroll
            for (int pp = 0; pp < 16; ++pp) qv[pp] = __uint_as_float((unsigned)qrow[p0 + 8 * ((pp & 7) >> 2) + 4 * (pp >> 3) + (pp & 3)] << 16) * eg;
            v4u o0, o1; o0.x = pkn(qv[0], qv[1]); o0.y = pkn(qv[2], qv[3]); o0.z = pkn(qv[4], qv[5]); o0.w = pkn(qv[6], qv[7]); o1.x = pkn(qv[8], qv[9]); o1.y = pkn(qv[10], qv[11]); o1.z = pkn(qv[12], qv[13]); o1.w = pkn(qv[14], qv[15]);
            v4u* qd = (v4u*)((bf16*)(F.ws + WS_QD) + (size_t)ch * 64 * 128 + c * 128 + p0); qd[0] = o0; qd[1] = o1;
        }
        LDS_WAIT(); __syncthreads();
        if (tid < 256) {
            const int col = tid & 127; const bool isw = tid >= 128;
            const LAS float* src = (isw ? KS : VS) + col;
            f32x2n xp[32];
#pragma unroll
            for (int k = 0; k < 32; ++k) { float v0 = src[(2 * k) * 128] * GC[64 + 2 * k], v1 = src[(2 * k + 1) * 128] * GC[64 + 2 * k + 1]; if (isw) { v0 *= GC[128 + 2 * k]; v1 *= GC[128 + 2 * k + 1]; } xp[k] = (f32x2n){v0, v1}; }
            f32x4 acur[8], anxt[8];
#pragma unroll
            for (int g = 0; g < 8; ++g) acur[g] = *(const LAS f32x4*)(AS + 4 * g);
#pragma unroll
            for (int k = 0; k < 94; ++k) {
                const int m = k < 62 ? (k >> 1) : k - 31, hf = k < 62 ? (k & 1) : 1;
                if (k + 1 < 94) { const int m2 = (k + 1) < 62 ? ((k + 1) >> 1) : (k + 1) - 31, hf2 = (k + 1) < 62 ? ((k + 1) & 1) : 1; const int g0 = ((m2 + 1) >> 2) > 8 * hf2 ? ((m2 + 1) >> 2) : 8 * hf2;
#pragma unroll
                    for (int g = g0; g < 8 * hf2 + 8; ++g) anxt[g - 8 * hf2] = *(const LAS f32x4*)(AS + m2 * 64 + 4 * g); }
                __builtin_amdgcn_sched_barrier(0);
                { const int p0 = ((m + 1) >> 1) > 16 * hf ? ((m + 1) >> 1) : 16 * hf;
#pragma unroll
                    for (int pr = p0; pr < 16 * hf + 16; ++pr) { const f32x4 a4 = acur[(pr >> 1) - 8 * hf]; const f32x2n a2 = (pr & 1) ? (f32x2n){a4[2], a4[3]} : (f32x2n){a4[0], a4[1]};
                        if (m & 1) asm("v_pk_fma_f32 %0, %1, %2, %0 op_sel:[0,1,0] op_sel_hi:[1,1,1] neg_lo:[1,0,0] neg_hi:[1,0,0]" : "+v"(xp[pr]) : "v"(a2), "v"(xp[m >> 1]));
                        else       asm("v_pk_fma_f32 %0, %1, %2, %0 op_sel:[0,0,0] op_sel_hi:[1,0,1] neg_lo:[1,0,0] neg_hi:[1,0,0]" : "+v"(xp[pr]) : "v"(a2), "v"(xp[m >> 1])); } }
#pragma unroll
                for (int g = 0; g < 8; ++g) acur[g] = anxt[g];
                __builtin_amdgcn_sched_barrier(0);
            }
            float x[64];
#pragma unroll
            for (int k = 0; k < 32; ++k) { x[2 * k] = xp[k][0]; x[2 * k + 1] = xp[k][1]; }
            if (!isw) { f32x4* up = (f32x4*)((float*)(F.ws + WS_UT) + (size_t)ch * 128 * 64 + col * 64);
#pragma unroll
                for (int c4 = 0; c4 < 16; ++c4) up[c4] = (f32x4){x[4 * c4], x[4 * c4 + 1], x[4 * c4 + 2], x[4 * c4 + 3]}; }
            else { LAS unsigned short* wi = (LAS unsigned short*)(IMG) + kpos(col);
#pragma unroll
                for (int c = 0; c < 64; ++c) wi[c * (WIMG_STRIDE / 2)] = (unsigned short)(pkn(-x[c], 0.f) & 0xffffu); }
        } else {
            const int t = tid - 256, d = t & 127, ph = t >> 7;
#pragma unroll
            for (int q8 = 0; q8 < 4; ++q8) { const int p0 = 32 * ph + 8 * q8; float kv[8];
#pragma unroll
                for (int jj = 0; jj < 8; ++jj) { const int c = (p0 & ~15) + 8 * (jj >> 2) + 4 * ((p0 >> 3) & 1) + (jj & 3); kv[jj] = KS[c * 128 + d] * GC[192 + c]; }
                v4u o; o.x = pkn(kv[0], kv[1]); o.y = pkn(kv[2], kv[3]); o.z = pkn(kv[4], kv[5]); o.w = pkn(kv[6], kv[7]);
                *(LAS v4u*)(IMG + KDIMG_OFF + d * KDIMG_STRIDE + 2 * p0) = o; }
            const LAS v4u* as = (const LAS v4u*)ATT + 2 * t; v4u* ag = (v4u*)((bf16*)(F.ws + WS_ATTN) + (size_t)ch * 4096) + 2 * t; ag[0] = as[0]; ag[1] = as[1];
        }
        LDS_WAIT(); __syncthreads();
        { v4u* rec = (v4u*)(F.ws + WS_REC + (size_t)ch * REC_BYTES);
            for (int i = tid; i < IMG_USED / 16; i += NTHREADS) rec[i] = *(const LAS v4u*)(IMG + 16 * i); }
        LDS_WAIT(); __syncthreads();
    }
}

__device__ __forceinline__ void gdn_scan_phase(Frame& F) {
    const int j = blockIdx.x; if (j >= 64) return;
    const int bh = j & 15, quarter = j >> 4;
    const int lane = F.lane, wave = F.wave, r = lane & 31, hh = lane >> 5;
    const unsigned char* REC = F.ws + WS_REC + (size_t)bh * 128 * REC_BYTES;
#define SCAN_BAR() do { asm volatile("s_waitcnt lgkmcnt(0)" ::: "memory"); __builtin_amdgcn_s_barrier(); asm volatile("" ::: "memory"); } while (0)
#define SCAN_DMA(n_) do { _Pragma("unroll") for (int k_ = 0; k_ < 6; ++k_) { const int piece_ = (wave - 1) + 6 * k_; \
        __builtin_amdgcn_global_load_lds((const unsigned*)(REC + (size_t)(n_) * REC_BYTES + piece_ * 1024 + lane * 16), (PG8_LAS unsigned*)(F.lds + ((n_) % 3) * REC_BYTES + piece_ * 1024), 16, 0, 0); } } while (0)
    if (wave == 7) { for (int n = 0; n < 129; ++n) SCAN_BAR(); }
    else if (wave >= 1) {
        SCAN_DMA(0); SCAN_DMA(1); VM_WAIT(); SCAN_BAR();
        for (int n = 0; n < 128; ++n) {
            if (n + 2 < 128) { SCAN_DMA(n + 2); asm volatile("s_waitcnt vmcnt(6)" ::: "memory"); }
            else VM_WAIT();
            SCAN_BAR();
        }
    } else {
        const int cw = quarter;
        const float* UT = (const float*)(F.ws + WS_UT) + (size_t)bh * 128 * (128 * 64) + (size_t)(32 * cw + r) * 64 + 4 * hh;
        v4u* SST = (v4u*)(F.ws + WS_SST) + (size_t)bh * 128 * (4 * 8 * 64) + (size_t)cw * (8 * 64) + lane;
        v4u* VST = (v4u*)(F.ws + WS_VST) + (size_t)bh * 128 * (4 * 4 * 64) + (size_t)cw * (4 * 64) + lane;
        const float* EGLp = (const float*)(F.ws + WS_EGL) + bh * 128;
        f32x16 S[4];
#pragma unroll
        for (int t = 0; t < 4; ++t)
#pragma unroll
            for (int i = 0; i < 16; ++i) S[t][i] = 0.f;
        SCAN_BAR();
        for (int n = 0; n < 128; ++n) {
            const LAS unsigned char* buf = F.lds + (n % 3) * REC_BYTES;
            f32x4 un[4]; f32x16 acc[2];
            { const float* up = UT + (size_t)n * (128 * 64);
#pragma unroll
                for (int q = 0; q < 4; ++q) un[q] = *(const f32x4*)(up + 8 * q);
#pragma unroll
                for (int q = 0; q < 4; ++q) { const f32x4 v = *(const f32x4*)(up + 32 + 8 * q); acc[1][4 * q] = v[0]; acc[1][4 * q + 1] = v[1]; acc[1][4 * q + 2] = v[2]; acc[1][4 * q + 3] = v[3]; } }
            const float egl = EGLp[n];
            __builtin_amdgcn_sched_barrier(0);
            bf16x8 Sb[8];
#pragma unroll
            for (int t = 0; t < 4; ++t) { Sb[2 * t] = pack_step(S[t], 0); Sb[2 * t + 1] = pack_step(S[t], 1); }
#pragma unroll
            for (int ks = 0; ks < 8; ++ks) SST[(size_t)n * (4 * 8 * 64) + ks * 64] = __builtin_bit_cast(v4u, Sb[ks]);
            __builtin_amdgcn_sched_barrier(0);
            const LAS unsigned char* wb = buf + r * WIMG_STRIDE + 16 * hh;
            const LAS unsigned char* kb = buf + KDIMG_OFF + r * KDIMG_STRIDE + 16 * hh;
#define SCAN_FRAG(i_) ((i_) < 16 ? *(const LAS bf16x8*)(wb + ((i_) >> 3) * 32 * WIMG_STRIDE + 32 * ((i_) & 7)) : *(const LAS bf16x8*)(kb + (((i_) - 16) & 3) * 32 * KDIMG_STRIDE + 32 * (((i_) - 16) >> 2)))
            bf16x8 ring[6];
#pragma unroll
            for (int i = 0; i < 6; ++i) ring[i] = SCAN_FRAG(i);
#pragma unroll
            for (int i = 0; i < 16; ++i) acc[0][i] = 0.f;
            __builtin_amdgcn_sched_barrier(0);
#pragma unroll
            for (int i = 0; i < 16; ++i) {
                acc[i >> 3] = __builtin_amdgcn_mfma_f32_32x32x16_bf16(ring[i % 6], Sb[i & 7], acc[i >> 3], 0, 0, 0);
                ring[i % 6] = SCAN_FRAG(i + 6);
                __builtin_amdgcn_sched_barrier(0);
            }
#pragma unroll
            for (int q = 0; q < 4; ++q) { acc[0][4 * q] += un[q][0]; acc[0][4 * q + 1] += un[q][1]; acc[0][4 * q + 2] += un[q][2]; acc[0][4 * q + 3] += un[q][3]; }
            bf16x8 Vb[4];
#pragma unroll
            for (int mt = 0; mt < 2; ++mt) { Vb[2 * mt] = pack_step(acc[mt], 0); Vb[2 * mt + 1] = pack_step(acc[mt], 1); }
#pragma unroll
            for (int ks = 0; ks < 4; ++ks) VST[(size_t)n * (4 * 4 * 64) + ks * 64] = __builtin_bit_cast(v4u, Vb[ks]);
#pragma unroll
            for (int t = 0; t < 4; ++t)
#pragma unroll
                for (int i = 0; i < 16; ++i) S[t][i] *= egl;
            __builtin_amdgcn_sched_barrier(0);
#pragma unroll
            for (int i = 16; i < 32; ++i) {
                S[(i - 16) & 3] = __builtin_amdgcn_mfma_f32_32x32x16_bf16(ring[i % 6], Vb[(i - 16) >> 2], S[(i - 16) & 3], 0, 0, 0);
                if (i + 6 < 32) ring[i % 6] = SCAN_FRAG(i + 6);
                __builtin_amdgcn_sched_barrier(0);
            }
#undef SCAN_FRAG
            SCAN_BAR();
        }
    }
#undef SCAN_DMA
#undef SCAN_BAR
    VM_WAIT(); __syncthreads();
}

__device__ __forceinline__ void gdn_out_phase(Frame& F, const float* out_norm  ) {
    const bf16* PROJ = (const bf16*)(F.ws + WS_PROJ); bf16* Y = (bf16*)(F.ws + WS_Y);
    const int lane = F.lane, r = lane & 31, hh = lane >> 5;
    LAS float* ot = (LAS float*)(F.lds + F.wave * 16384);
    float gain[8];
    { const f32x4 a = *(const f32x4*)(out_norm + 8 * (lane & 15)), b = *(const f32x4*)(out_norm + 8 * (lane & 15) + 4);
        gain[0] = a[0]; gain[1] = a[1]; gain[2] = a[2]; gain[3] = a[3]; gain[4] = b[0]; gain[5] = b[1]; gain[6] = b[2]; gain[7] = b[3]; }
    for (int wu = F.gw; wu < 4096; wu += F.NGW) {
        const int ch = wu >> 1, mt = wu & 1, n = ch & 127, bh = ch >> 7, b = bh >> 3, h = bh & 7, m0 = b * SEQ + n * 64 + 32 * mt;
        const bf16* qd = (const bf16*)(F.ws + WS_QD) + (size_t)ch * 64 * 128 + (32 * mt + r) * 128 + 8 * hh;
        const bf16* at = (const bf16*)(F.ws + WS_ATTN) + (size_t)ch * 4096 + (32 * mt + r) * 64 + 8 * hh;
        const v4u* sst = (const v4u*)(F.ws + WS_SST) + (size_t)ch * (4 * 8 * 64) + lane;
        const v4u* vst = (const v4u*)(F.ws + WS_VST) + (size_t)ch * (4 * 4 * 64) + lane;
        bf16x8 qa[8], aa[4];
#pragma unroll
        for (int ks = 0; ks < 8; ++ks) qa[ks] = __builtin_bit_cast(bf16x8, *(const v4u*)(qd + 16 * ks));
#pragma unroll
        for (int ks = 0; ks < 4; ++ks) aa[ks] = __builtin_bit_cast(bf16x8, *(const v4u*)(at + 16 * ks));
#pragma unroll
        for (int nt = 0; nt < 4; ++nt) {
            f32x16 acc;
#pragma unroll
            for (int i = 0; i < 16; ++i) acc[i] = 0.f;
#pragma unroll
            for (int ks = 0; ks < 8; ++ks) acc = __builtin_amdgcn_mfma_f32_32x32x16_bf16(qa[ks], __builtin_bit_cast(bf16x8, sst[nt * (8 * 64) + ks * 64]), acc, 0, 0, 0);
#pragma unroll
            for (int ks = 0; ks < 4; ++ks) acc = __builtin_amdgcn_mfma_f32_32x32x16_bf16(aa[ks], __builtin_bit_cast(bf16x8, vst[nt * (4 * 64) + ks * 64]), acc, 0, 0, 0);
#pragma unroll
            for (int i = 0; i < 16; ++i) ot[((i & 3) + 8 * (i >> 2) + 4 * hh) * 128 + 32 * nt + r] = acc[i];
        }
        LDS_WAIT();
#pragma unroll 2
        for (int k = 0; k < 8; ++k) {
            const int row = 4 * k + (lane >> 4), chunk = lane & 15;
            const f32x4 o0 = *(const LAS f32x4*)(ot + row * 128 + 8 * chunk), o1 = *(const LAS f32x4*)(ot + row * 128 + 8 * chunk + 4);
            float zz[8]; unpack8(*(const v4u*)(PROJ + (size_t)(m0 + row) * NMIX + PC_Z + h * GD + 8 * chunk), zz);
            float ss = (o0[0] * o0[0] + o0[1] * o0[1]) + (o0[2] * o0[2] + o0[3] * o0[3]) + (o1[0] * o1[0] + o1[1] * o1[1]) + (o1[2] * o1[2] + o1[3] * o1[3]);
            ss += __shfl_xor(ss, 1); ss += __shfl_xor(ss, 2); ss += __shfl_xor(ss, 4); ss += __shfl_xor(ss, 8);
            const float rstd = 1.0f / sqrtf(ss * (1.0f / GD) + EPS);
            float y[8];
#pragma unroll
            for (int e = 0; e < 4; ++e) { y[e] = o0[e] * rstd * gain[e] * silu_f(zz[e]); y[4 + e] = o1[e] * rstd * gain[4 + e] * silu_f(zz[4 + e]); }
            v4u w; w.x = pkn(y[0], y[1]); w.y = pkn(y[2], y[3]); w.z = pkn(y[4], y[5]); w.w = pkn(y[6], y[7]);
            *(v4u*)(Y + (size_t)(m0 + row) * D + h * GD + 8 * chunk) = w;
        }
        LDS_WAIT();
    }
}

#ifndef GDN_REF
#define GDN_REF 0
#endif
#ifndef REPMASK
#define REPMASK 0u
#endif
__device__ __forceinline__ int nrep_opaque(int n) { asm volatile("" : "+s"(n)); return n; }
#define NREP(k) (((((REPMASK) >> (k)) & 1)) ? nrep_opaque(2) : 1)
#ifndef PHMASK
#define PHMASK 0xFFFFFFFFu
#endif
struct Args { const float* in[21]; float* out; unsigned char* ws; int pro_lo, pro_hi, l_lo, l_hi, ph_lo, ph_hi, one, fin; };
enum { PH_MIXIN = 3, PH_GDNPRE, PH_GDNSCAN, PH_OUTGATE, PH_MIXOUT, PH_SCORES, PH_ATTOUT, PH_UP, PH_SWIGLU, PH_DOWN, PH_END };

typedef const __attribute__((address_space(4))) Args* KArgP;
__device__ __forceinline__ KArgP kargs() { KArgP ap = (KArgP)__builtin_amdgcn_kernarg_segment_ptr(); asm volatile("" : "+s"(ap)); return ap; }
__device__ __forceinline__ Frame mkframe(KArgP ap, LAS unsigned char* lds) {
    Frame F; int t = threadIdx.x; asm volatile("" : "+v"(t));
    F.lds = lds; F.tid = t; F.lane = t & 63; F.wave = __builtin_amdgcn_readfirstlane(t >> 6);
    F.G = gridDim.x; F.gw = blockIdx.x * NWAVES + F.wave; F.NGW = F.G * NWAVES; F.ws = ap->ws;
    return F;
}
__global__ void __launch_bounds__(NTHREADS, 2) trunk_fwd(Args args) {
    extern __shared__ __attribute__((aligned(16))) unsigned char lds_raw[];
    LAS unsigned char* const lds = (LAS unsigned char*)lds_raw;
    for (int u = threadIdx.x; u < (LDS_BYTES - LDSCTL_OFF) / 4; u += NTHREADS) ((LAS unsigned*)(lds + LDSCTL_OFF))[u] = 0u;
    __syncthreads();
    XcdBarrier bar; bar.bar = (unsigned*)(args.ws + WS_CTL) + CW_BAR; bar.x = 0; bar.st = nullptr;
    const bool one = args.one != 0;
    if (one) bar = xcd_barrier_post((unsigned*)(args.ws + WS_CTL) + CW_BAR, (volatile LAS unsigned*)(lds + MISC_OFF) + 8);
#define SEAM() do { if (one) xcd_barrier(bar); } while (0)
#define PHASE_BEGIN() KArgP ap = kargs(); Frame F = mkframe(ap, lds); PG8_LAS unsigned char* ring = (PG8_LAS unsigned char*)(lds + RING_OFF); (void)ring; float* const XR = ap->out; (void)XR; \
    bf16* const HA = (bf16*)(F.ws + WS_H); (void)HA; bf16* const HB = (bf16*)(F.ws + WS_HB); (void)HB; float* const SSQ = (float*)(F.ws + WS_SSQ); (void)SSQ
#define PRO(k) ((((PHMASK) >> (k)) & 1) && args.pro_lo <= (k) && (k) < args.pro_hi)

    if (PRO(0)) {
        PHASE_BEGIN();
        for (int rep = 0; rep < NREP(0); ++rep) { if (rep) SEAM();
        p0_weights_x(F, ap->in[IN_W_XQ], ap->in[IN_W_XK], ap->in[IN_W_XV], ap->in[IN_W_XO]);
        p0_weights_main(F, 0, F.gw, F.NGW, ap->in[IN_W_MIX_IN], ap->in[IN_W_MIX_OUT], ap->in[IN_W_UP], ap->in[IN_W_DOWN]);
        p0_memn(F, ap->in[IN_MEM], ap->in[IN_MEM_NORM]);
        prenorm_phase(F, ap->in[IN_X], ap->in[IN_MIX_NORM], HB, SSQ); }
        SEAM();
    }
    if (PRO(1)) {
        PHASE_BEGIN();
        KvOrder S{F.G, (int)blockIdx.x, (const bf16*)(F.ws + WS_MEMN), (const bf16*)(F.ws + WS_WXK), (const bf16*)(F.ws + WS_WXV)};
        pg8::Gemm g{nullptr, nullptr, D, D, D};
        pg8::EpiBf16<LocKv> E{LocKv{(bf16*)(F.ws + WS_KX), (bf16*)(F.ws + WS_VX)}, 1.0f, nullptr};
        pg8::gemm_phase<pg8::EpiBf16<LocKv>, KvOrder, true>(ring, g, S, E);
        SEAM();
    }
    if (PRO(2)) {
        PHASE_BEGIN();
        PreOrder S{F.G, (int)blockIdx.x, (const bf16*)(F.ws + WS_KX), (const bf16*)(F.ws + WS_VX), (const bf16*)(F.ws + WS_WXQ), (const bf16*)(F.ws + WS_WXO)};
        pg8::Gemm g{nullptr, nullptr, D, D, XD};
        pg8::EpiBf16<LocPre> E{LocPre{(bf16*)(F.ws + WS_WQK), (bf16*)(F.ws + WS_VWO)}, 1.0f, nullptr};
        pg8::gemm_phase<pg8::EpiBf16<LocPre>, PreOrder, true>(ring, g, S, E);
        SEAM();
    }
    const int lo = args.ph_lo, hi = args.ph_hi;
#define IN(k) ((((PHMASK) >> (k)) & 1) && lo <= (k) && (k) < hi)
    for (int l = args.l_lo; l < args.l_hi; ++l) {
        if (IN(PH_MIXIN)) {
            PHASE_BEGIN();
            ba_phase(F, HB, SSQ + (size_t)(3 * l) * M, (const bf16*)(F.ws + WS_WBA) + (size_t)l * 16 * D, ap->in[IN_A_LOG] + l * GH, ap->in[IN_DT_BIAS] + l * GH);
            pg8::Gemm g{HB, (const bf16*)(F.ws + WS_WMIX) + (size_t)l * NMIX * D, D, D, D}; pg8::StaticOrder S; S.init(M, NMIX, F.G, (int)blockIdx.x);
            pg8::EpiBf16<pg8::LocPlain> E{pg8::LocPlain{(bf16*)(F.ws + WS_PROJ), NMIX}, 1.0f, SSQ + (size_t)(3 * l) * M};
            for (int rep = 0; rep < NREP(3); ++rep) { if (rep) SEAM();
            pg8::gemm_phase<pg8::EpiBf16<pg8::LocPlain>, pg8::StaticOrder, true>(ring, g, S, E); }
            SEAM();
        }
        if (IN(PH_GDNPRE)) { PHASE_BEGIN(); for (int rep = 0; rep < NREP(4); ++rep) { if (rep) SEAM(); gdn_prep_phase(F, ap->in[IN_GDN_CONV] + (size_t)l * 4 * 3 * GW); } SEAM(); }
        if (IN(PH_GDNSCAN)) {
            PHASE_BEGIN();
            if (blockIdx.x < 64 || F.G <= 64) { for (int rep = 0; rep < NREP(5); ++rep) { if (rep) SEAM(); gdn_scan_phase(F); } }
            if (F.G <= 64) shortconv_phase(F, ap->in[IN_SC_CONV] + (size_t)l * 3 * SCW, F.gw, F.NGW);
            else if (blockIdx.x >= 64) shortconv_phase(F, ap->in[IN_SC_CONV] + (size_t)l * 3 * SCW, F.gw - 64 * NWAVES, F.NGW - 64 * NWAVES);
            if (l + 1 < DEPTH) { if (F.G <= 64) p0_weights_main(F, l + 1, F.gw, F.NGW, ap->in[IN_W_MIX_IN], ap->in[IN_W_MIX_OUT], ap->in[IN_W_UP], ap->in[IN_W_DOWN]);
                else if (blockIdx.x >= 64) p0_weights_main(F, l + 1, F.gw - 64 * NWAVES, F.NGW - 64 * NWAVES, ap->in[IN_W_MIX_IN], ap->in[IN_W_MIX_OUT], ap->in[IN_W_UP], ap->in[IN_W_DOWN]); }
            SEAM(); }
        if (IN(PH_OUTGATE)) { PHASE_BEGIN(); for (int rep = 0; rep < NREP(6); ++rep) { if (rep) SEAM(); gdn_out_phase(F, ap->in[IN_OUT_NORM] + (size_t)l * GD); } SEAM(); }
        if (IN(PH_MIXOUT)) {
            PHASE_BEGIN();
            pg8::Gemm g{(const bf16*)(F.ws + WS_Y), (const bf16*)(F.ws + WS_WOUT) + (size_t)l * D * D, D, D, D}; pg8::StaticOrder S; S.init(M, D, F.G, (int)blockIdx.x);
            pg8::EpiResNorm E{l == 0 ? ap->in[IN_X] : XR, XR, D, HA, ap->in[IN_XATTN_NORM] + (size_t)l * D, SSQ + (size_t)(3 * l + 1) * M};
            if (NREP(7) > 1) { pg8::EpiResNorm E0 = E; E0.out = (float*)(F.ws + WS_BIG); E0.hn = (pg8::bf16_t*)(F.ws + WS_BIG + 160 * MiB); E0.ssq = (float*)(F.ws + WS_BIG + 256 * MiB);
            pg8::gemm_phase<pg8::EpiResNorm, pg8::StaticOrder, true>(ring, g, S, E0); SEAM(); }
            pg8::gemm_phase<pg8::EpiResNorm, pg8::StaticOrder, true>(ring, g, S, E);
            SEAM();
        }
        if (IN(PH_SCORES)) {
            PHASE_BEGIN();
            pg8::Gemm g{HA, (const bf16*)(F.ws + WS_WQK) + (size_t)l * 2 * (XH * NMEM) * D, D, D, D}; SOrder S{F.G, (int)blockIdx.x};
            pg8::EpiSoftmax E{(bf16*)(F.ws + WS_PB), XH * NMEM, 0.044194173824159216f * 1.4426950408889634f, SSQ + (size_t)(3 * l + 1) * M};
            for (int rep = 0; rep < NREP(8); ++rep) { if (rep) SEAM();
            pg8::gemm_phase<pg8::EpiSoftmax, SOrder, false>(ring, g, S, E); }
            SEAM();
        }
        if (IN(PH_ATTOUT)) {
            PHASE_BEGIN();
            pg8::Gemm g{(const bf16*)(F.ws + WS_PB), (const bf16*)(F.ws + WS_VWO) + (size_t)l * 2 * D * (XH * NMEM), XH * NMEM, XH * NMEM, XH * NMEM};
            BatchOrder S; S.init(M, D, F.G, (int)blockIdx.x); S.bstride = (size_t)D * (XH * NMEM);
            pg8::EpiResNorm E{XR, XR, D, HA, ap->in[IN_FFN_NORM] + (size_t)l * D, SSQ + (size_t)(3 * l + 2) * M};
            if (NREP(9) > 1) { pg8::EpiResNorm E0 = E; E0.out = (float*)(F.ws + WS_BIG); E0.hn = (pg8::bf16_t*)(F.ws + WS_BIG + 160 * MiB); E0.ssq = (float*)(F.ws + WS_BIG + 256 * MiB);
            pg8::gemm_phase<pg8::EpiResNorm, BatchOrder, true>(ring, g, S, E0); SEAM(); }
            pg8::gemm_phase<pg8::EpiResNorm, BatchOrder, true>(ring, g, S, E);
            SEAM();
        }
        if (IN(PH_UP)) {
            PHASE_BEGIN();
            pg8::Gemm g{HA, (const bf16*)(F.ws + WS_WUP) + (size_t)l * 2 * DFF * D, D, D, D}; pg8::StaticOrder S; S.init(M, 2 * DFF, F.G, (int)blockIdx.x);
            pg8::EpiSwiglu E{(bf16*)(F.ws + WS_ACT), (float*)(F.ws + WS_PART), (float*)(F.ws + WS_HALO), ap->in[IN_FFN_CONV] + (size_t)l * 3 * 2 * DFF, SSQ + (size_t)(3 * l + 2) * M, (PG8_LAS float*)(lds + XB_OFF), DFF};
            pg8::gemm_phase<pg8::EpiSwiglu, pg8::StaticOrder, true>(ring, g, S, E);
            SEAM();
        }
        if (IN(PH_SWIGLU)) { PHASE_BEGIN(); swiglu_fix_phase(F, ap->in[IN_FFN_CONV] + (size_t)l * 3 * 2 * DFF); SEAM(); }
        if (IN(PH_DOWN)) {
            PHASE_BEGIN();
            pg8::Gemm g{(const bf16*)(F.ws + WS_ACT), (const bf16*)(F.ws + WS_WDN) + (size_t)l * D * DFF, DFF, DFF, DFF}; pg8::StaticOrder S; S.init(M, D, F.G, (int)blockIdx.x);
            const bool last = l + 1 >= DEPTH;
            pg8::EpiResNorm E{XR, XR, D, last ? nullptr : HB, ap->in[IN_MIX_NORM] + (size_t)(last ? l : l + 1) * D, SSQ + (size_t)(last ? 0 : 3 * (l + 1)) * M};
            if (NREP(12) > 1) { pg8::EpiResNorm E0 = E; E0.out = (float*)(F.ws + WS_BIG); E0.hn = (pg8::bf16_t*)(F.ws + WS_BIG + 160 * MiB); E0.ssq = (float*)(F.ws + WS_BIG + 256 * MiB);
            pg8::gemm_phase<pg8::EpiResNorm, pg8::StaticOrder, true>(ring, g, S, E0); SEAM(); }
            pg8::gemm_phase<pg8::EpiResNorm, pg8::StaticOrder, true>(ring, g, S, E);
            SEAM();
        }
    }
    if ((((PHMASK) >> 30) & 1) && args.fin) { PHASE_BEGIN(); final_norm_phase(F, XR, ap->in[IN_FINAL_NORM], ap->out); }
#undef IN
#undef PRO
#undef SEAM
#undef PHASE_BEGIN
}

extern "C" void kernel_launch(void* const* d_in, const int* in_sizes, int n_in, void* d_out, int out_size, void* d_ws, size_t ws_size, hipStream_t stream) {
    static int grid = 0;
    if (grid == 0) {
        if (n_in != 21 || in_sizes[0] != M * D || out_size != M * D || ws_size < WS_END) { fprintf(stderr, "kernel_launch: unexpected shapes / workspace (n_in %d, in0 %d, out %d, ws %zu < %zu); nothing launched\n", n_in, n_in > 0 ? in_sizes[0] : -1, out_size, ws_size, (size_t)WS_END); grid = -1; return; }
        int dev = 0, cus = 0, per_cu = 0;
        if (hipGetDevice(&dev) != hipSuccess || hipDeviceGetAttribute(&cus, hipDeviceAttributeMultiprocessorCount, dev) != hipSuccess) { fprintf(stderr, "kernel_launch: device query failed\n"); grid = -1; return; }
        if (hipFuncSetAttribute((const void*)trunk_fwd, hipFuncAttributeMaxDynamicSharedMemorySize, LDS_BYTES) != hipSuccess) { fprintf(stderr, "kernel_launch: hipFuncSetAttribute failed\n"); grid = -1; return; }
        if (hipOccupancyMaxActiveBlocksPerMultiprocessor(&per_cu, (const void*)trunk_fwd, NTHREADS, LDS_BYTES) != hipSuccess || per_cu < 1)
            fprintf(stderr, "kernel_launch: note: occupancy query reports %d workgroups per CU\n", per_cu);
        (void)hipGetLastError();
        if (cus != 256) { fprintf(stderr, "kernel_launch: built for 256 CUs, device has %d; nothing launched\n", cus); grid = -1; return; }
        grid = cus;
    }
    if (grid < 0) return;
    if (hipMemsetAsync((char*)d_ws + WS_CTL, 0, CTL_ZERO_BYTES, stream) != hipSuccess) { fprintf(stderr, "kernel_launch: memset failed\n"); return; }
    Args a{};
    for (int i = 0; i < 21; ++i) a.in[i] = (const float*)d_in[i];
    a.out = (float*)d_out; a.ws = (unsigned char*)d_ws;
#if MK_ONE_LAUNCH
    a.pro_lo = 0; a.pro_hi = 3; a.l_lo = 0; a.l_hi = DEPTH; a.ph_lo = PH_MIXIN; a.ph_hi = PH_END; a.one = 1; a.fin = 1;
    hipLaunchKernelGGL(trunk_fwd, dim3(grid), dim3(NTHREADS), LDS_BYTES, stream, a);
#else
    a.one = 0; a.fin = 0; a.l_lo = 0; a.l_hi = 0; a.ph_lo = 0; a.ph_hi = 0;
    for (int p = 0; p < 3; ++p) { a.pro_lo = p; a.pro_hi = p + 1; hipLaunchKernelGGL(trunk_fwd, dim3(grid), dim3(NTHREADS), LDS_BYTES, stream, a); }
    a.pro_lo = 0; a.pro_hi = 0;
    for (int l = 0; l < DEPTH; ++l)
        for (int p = PH_MIXIN; p < PH_END; ++p) { a.l_lo = l; a.l_hi = l + 1; a.ph_lo = p; a.ph_hi = p + 1;
            hipLaunchKernelGGL(trunk_fwd, dim3(grid), dim3(NTHREADS), LDS_BYTES, stream, a); }
    a.l_lo = 0; a.l_hi = 0; a.fin = 1;
    hipLaunchKernelGGL(trunk_fwd, dim3(grid), dim3(NTHREADS), LDS_BYTES, stream, a);
#endif
    const hipError_t le = hipPeekAtLastError();
    if (le != hipSuccess) fprintf(stderr, "kernel_launch: launch failed: %s\n", hipGetErrorName(le));
}
```

```cpp
#define MK_ONE_LAUNCH 1
#include <hip/hip_runtime.h>
#include <cstdio>
#include <cstdint>

#ifndef MK_ONE_LAUNCH
#define MK_ONE_LAUNCH 1
#endif

namespace pg8 {
#define PG8_LAS __attribute__((address_space(3)))
typedef unsigned short bf16_t;
typedef short bf16x8 __attribute__((ext_vector_type(8)));
typedef float f32x4 __attribute__((ext_vector_type(4)));
typedef float f32x2 __attribute__((ext_vector_type(2)));
typedef unsigned u32x4 __attribute__((ext_vector_type(4)));
constexpr int BM = 256, BK = 64, HALF = 128, HTB = HALF * BK * 2  , STAGE_BYTES = 8 * HTB, NXCD = 8, WGM = 8;

__host__ __device__ __forceinline__ int lds_byte(int r, int c) { const int st = (r >> 4) * 2 + (c >> 5), rr = r & 15, cc = c & 31, ob = rr * 64 + cc * 2; return st * 1024 + (ob ^ (((ob >> 9) & 1) << 5)); }
__host__ __device__ __forceinline__ void stage_rc(int b, int& R, int& C) { const int st = b / 1024, sb = b % 1024, swz = sb ^ (((sb >> 9) & 1) << 5); R = (st >> 1) * 16 + swz / 64; C = (st & 1) * 32 + (swz % 64) / 2; }
__host__ __device__ __forceinline__ int perm32(int rho) { const int n = rho >> 4, i = rho & 15; return 8 * (i >> 2) + 4 * n + (i & 3); }

struct Unit { int pm, pn; };
struct Gemm { const bf16_t* A; const bf16_t* Bt; int lda, ldb, K; };

struct StaticOrder {
    int nM, nN, nwg, G, c;
    __host__ __device__ void init(int M, int N, int G_, int c_) { nM = M / BM; nN = N / BM; nwg = nM * nN; G = G_; c = c_; }
    __host__ __device__ bool next(int i, Unit& u) const {
        const long L = (long)i * G + c; if (L >= nwg) return false;
        int wgid = (int)L; { const int q = nwg / NXCD, r = nwg % NXCD, xcd = wgid % NXCD, off = wgid / NXCD; wgid = (xcd < r ? xcd * (q + 1) : r * (q + 1) + (xcd - r) * q) + off; }
        const int nig = WGM * nN, gid = wgid / nig, fm = gid * WGM, gsz = (nM - fm) < WGM ? (nM - fm) : WGM;
        u.pm = fm + ((wgid % nig) % gsz); u.pn = (wgid % nig) / gsz; return true;
    }
    __device__ __forceinline__ const char* pa(const Gemm& g, const Unit& u) const { return (const char*)g.A + (size_t)u.pm * BM * g.lda * 2; }
    __device__ __forceinline__ const char* pb(const Gemm& g, const Unit& u) const { return (const char*)g.Bt + (size_t)u.pn * BM * g.ldb * 2; }
};

__device__ __forceinline__ unsigned cvt_pk_bf16(float lo, float hi) { unsigned r; asm volatile("v_cvt_pk_bf16_f32 %0, %1, %2" : "=v"(r) : "v"(lo), "v"(hi)); return r; }


template <class Loc, bool RS  > struct EpiBf16 {
    static constexpr bool PERM = true, AFTER_DRAIN = false;
    Loc loc; float scale; const float* ssq;
    __device__ __forceinline__ void operator()(const f32x4 (&acc)[2][2][4][2], const Unit& u, int wr, int wc, int fr, int fq) const {
        bf16_t* base; int ldc; loc(u, base, ldc);
        const int row0 = wr * 64 + fr, col0 = wc * 32 + 8 * fq;
        float sc[2][4];
#pragma unroll
        for (int ai = 0; ai < 2; ++ai)
#pragma unroll
            for (int m = 0; m < 4; ++m) sc[ai][m] = RS ? ssq[u.pm * BM + row0 + ai * HALF + m * 16] : 0.f;
#pragma unroll
        for (int ai = 0; ai < 2; ++ai)
#pragma unroll
            for (int m = 0; m < 4; ++m) sc[ai][m] = RS ? this->scale * (1.0f / sqrtf(sc[ai][m] * (1.0f / 2048.0f) + 1e-6f)) : this->scale;
#pragma unroll
        for (int ai = 0; ai < 2; ++ai)
#pragma unroll
            for (int m = 0; m < 4; ++m) { bf16_t* rowp = base + (size_t)(row0 + ai * HALF + m * 16) * ldc + col0;
                const float scale = sc[ai][m];
#pragma unroll
                for (int bj = 0; bj < 2; ++bj) { f32x4 v0 = acc[ai][bj][m][0] * scale, v1 = acc[ai][bj][m][1] * scale;
                    u32x4 w; w.x = cvt_pk_bf16(v0[0], v0[1]); w.y = cvt_pk_bf16(v0[2], v0[3]); w.z = cvt_pk_bf16(v1[0], v1[1]); w.w = cvt_pk_bf16(v1[2], v1[3]);
                    *(u32x4*)(rowp + bj * HALF) = w; } }
    }
};
struct LocPlain { bf16_t* O; int ldc; __device__ __forceinline__ void operator()(const Unit& u, bf16_t*& base, int& ld) const { base = O + (size_t)u.pm * BM * ldc + (size_t)u.pn * BM; ld = ldc; } };

struct EpiResNorm {
    static constexpr bool PERM = true, AFTER_DRAIN = false;
    const float* res; float* out; int ldc; bf16_t* hn; const float* gain; float* ssq;
    __device__ __forceinline__ void operator()(const f32x4 (&acc)[2][2][4][2], const Unit& u, int wr, int wc, int fr, int fq) const {
        const int row0 = u.pm * BM + wr * 64 + fr, col0 = u.pn * BM + wc * 32 + 8 * fq;
        f32x4 g4[2][2];
        if (hn) {
#pragma unroll
            for (int bj = 0; bj < 2; ++bj)
#pragma unroll
                for (int n = 0; n < 2; ++n) g4[bj][n] = *(const f32x4*)(gain + col0 + bj * HALF + 4 * n); }
        f32x4 cur[2][2], nxt[2][2];
#pragma unroll
        for (int bj = 0; bj < 2; ++bj)
#pragma unroll
            for (int n = 0; n < 2; ++n) cur[bj][n] = *(const f32x4*)(res + (size_t)row0 * ldc + col0 + bj * HALF + 4 * n);
#pragma unroll
        for (int it = 0; it < 8; ++it) { const int ai = it >> 2, m = it & 3; const int row = row0 + ai * HALF + m * 16; const size_t off = (size_t)row * ldc + col0;
            if (it < 7) { const size_t off2 = (size_t)(row0 + ((it + 1) >> 2) * HALF + ((it + 1) & 3) * 16) * ldc + col0;
#pragma unroll
                for (int bj = 0; bj < 2; ++bj)
#pragma unroll
                    for (int n = 0; n < 2; ++n) nxt[bj][n] = *(const f32x4*)(res + off2 + bj * HALF + 4 * n); }
            __builtin_amdgcn_sched_barrier(0);
            f32x4 x[2][2]; float ss = 0.f;
#pragma unroll
            for (int bj = 0; bj < 2; ++bj)
#pragma unroll
                for (int n = 0; n < 2; ++n) { x[bj][n] = cur[bj][n] + acc[ai][bj][m][n]; *(f32x4*)(out + off + bj * HALF + 4 * n) = x[bj][n];
                    ss += (x[bj][n][0] * x[bj][n][0] + x[bj][n][1] * x[bj][n][1]) + (x[bj][n][2] * x[bj][n][2] + x[bj][n][3] * x[bj][n][3]); }
            if (hn) {
#pragma unroll
                for (int bj = 0; bj < 2; ++bj) { const f32x4 v0 = x[bj][0] * g4[bj][0], v1 = x[bj][1] * g4[bj][1];
                    u32x4 w; w.x = cvt_pk_bf16(v0[0], v0[1]); w.y = cvt_pk_bf16(v0[2], v0[3]); w.z = cvt_pk_bf16(v1[0], v1[1]); w.w = cvt_pk_bf16(v1[2], v1[3]);
                    *(u32x4*)(hn + off + bj * HALF) = w; }
                ss += __shfl_xor(ss, 16); ss += __shfl_xor(ss, 32);
                if (fq == 0) atomicAdd(ssq + row, ss);
            }
#pragma unroll
            for (int bj = 0; bj < 2; ++bj)
#pragma unroll
                for (int n = 0; n < 2; ++n) cur[bj][n] = nxt[bj][n];
            __builtin_amdgcn_sched_barrier(0);
        }
    }
};

struct EpiSoftmax {
    static constexpr bool PERM = true, AFTER_DRAIN = true;
    bf16_t* P; int ldc; float sl2e; const float* ssq;
    __device__ __forceinline__ void fused(f32x4 (&acc)[2][2][4][2], const Unit& u, int wr, int wc, int fr, int fq, PG8_LAS unsigned char* lds, int wid, int lane) const {
        PG8_LAS float* Pm = (PG8_LAS float*)lds;
        PG8_LAS float* Ps = (PG8_LAS float*)(lds + 4096);
        float rs[2][4];
#pragma unroll
        for (int ai = 0; ai < 2; ++ai)
#pragma unroll
            for (int m = 0; m < 4; ++m) rs[ai][m] = ssq[u.pm * BM + ai * HALF + wr * 64 + m * 16 + fr];
#pragma unroll
        for (int ai = 0; ai < 2; ++ai)
#pragma unroll
            for (int m = 0; m < 4; ++m) {
                float mx = -3.0e38f;
#pragma unroll
                for (int bj = 0; bj < 2; ++bj)
#pragma unroll
                    for (int n = 0; n < 2; ++n) { const f32x4 x = acc[ai][bj][m][n]; mx = fmaxf(mx, fmaxf(fmaxf(x[0], x[1]), fmaxf(x[2], x[3]))); }
                mx = fmaxf(mx, __shfl_xor(mx, 16)); mx = fmaxf(mx, __shfl_xor(mx, 32));
                if (fq == 0) Pm[(ai * HALF + wr * 64 + m * 16 + fr) * 4 + wc] = mx;
            }
        asm volatile("s_waitcnt lgkmcnt(0)" ::: "memory"); __builtin_amdgcn_s_barrier(); asm volatile("" ::: "memory");
#pragma unroll
        for (int ai = 0; ai < 2; ++ai)
#pragma unroll
            for (int m = 0; m < 4; ++m) {
                const int row = ai * HALF + wr * 64 + m * 16 + fr;
                const f32x4 pm4 = *(const PG8_LAS f32x4*)(Pm + row * 4);
                const float gm = fmaxf(fmaxf(pm4[0], pm4[1]), fmaxf(pm4[2], pm4[3]));
                const float sl2e = this->sl2e * (1.0f / sqrtf(rs[ai][m] * (1.0f / 2048.0f) + 1e-6f));
                float s = 0.f;
#pragma unroll
                for (int bj = 0; bj < 2; ++bj)
#pragma unroll
                    for (int n = 0; n < 2; ++n) { f32x4 x = acc[ai][bj][m][n];
#pragma unroll
                        for (int j = 0; j < 4; ++j) { x[j] = __builtin_amdgcn_exp2f((x[j] - gm) * sl2e); s += x[j]; }
                        acc[ai][bj][m][n] = x; }
                s += __shfl_xor(s, 16); s += __shfl_xor(s, 32);
                if (fq == 0) Ps[row * 4 + wc] = s;
            }
        asm volatile("s_waitcnt lgkmcnt(0)" ::: "memory"); __builtin_amdgcn_s_barrier(); asm volatile("" ::: "memory");
        bf16_t* base = P + (size_t)u.pm * BM * ldc + (size_t)u.pn * BM;
#pragma unroll
        for (int ai = 0; ai < 2; ++ai)
#pragma unroll
            for (int m = 0; m < 4; ++m) {
                const int row = ai * HALF + wr * 64 + m * 16 + fr;
                const f32x4 ps4 = *(const PG8_LAS f32x4*)(Ps + row * 4);
                const float inv = 1.0f / ((ps4[0] + ps4[1]) + (ps4[2] + ps4[3]));
                bf16_t* rowp = base + (size_t)row * ldc + wc * 32 + 8 * fq;
#pragma unroll
                for (int bj = 0; bj < 2; ++bj) { const f32x4 v0 = acc[ai][bj][m][0] * inv, v1 = acc[ai][bj][m][1] * inv;
                    u32x4 w; w.x = cvt_pk_bf16(v0[0], v0[1]); w.y = cvt_pk_bf16(v0[2], v0[3]); w.z = cvt_pk_bf16(v1[0], v1[1]); w.w = cvt_pk_bf16(v1[2], v1[3]);
                    *(u32x4*)(rowp + bj * HALF) = w; }
            }
    }
};

__device__ __forceinline__ float dpp_ror1(float v) { return __builtin_bit_cast(float, __builtin_amdgcn_update_dpp(0, __builtin_bit_cast(int, v), 0x121, 0xf, 0xf, false)); }
__device__ __forceinline__ float dpp_ror2(float v) { return __builtin_bit_cast(float, __builtin_amdgcn_update_dpp(0, __builtin_bit_cast(int, v), 0x122, 0xf, 0xf, false)); }
struct EpiSwiglu {
    static constexpr bool PERM = true, AFTER_DRAIN = false;
    bf16_t* act; float* part; float* halo; const float* cw; const float* ssq; PG8_LAS float* xb; int dff;
    __device__ __forceinline__ void operator()(f32x4 (&acc)[2][2][4][2], const Unit& u, int wr, int wc, int fr, int fq) const {
        const int ccol = wc * 32 + 8 * fq;
#pragma unroll
        for (int ai = 0; ai < 2; ++ai)
#pragma unroll
            for (int m = 0; m < 4; ++m) { const float sc = 1.0f / sqrtf(ssq[u.pm * BM + ai * HALF + wr * 64 + m * 16 + fr] * (1.0f / 2048.0f) + 1e-6f);
#pragma unroll
                for (int bj = 0; bj < 2; ++bj)
#pragma unroll
                    for (int n = 0; n < 2; ++n) acc[ai][bj][m][n] = acc[ai][bj][m][n] * sc; }
        if (fr >= 14) {
#pragma unroll
            for (int ai = 0; ai < 2; ++ai)
#pragma unroll
                for (int bj = 0; bj < 2; ++bj)
#pragma unroll
                    for (int n = 0; n < 2; ++n) { *(PG8_LAS f32x4*)(xb + ((wr * 2 + ai) * 2 + (fr - 14)) * 256 + bj * HALF + ccol + 4 * n) = acc[ai][bj][3][n];
                        if (wr == 1 && ai == 1) *(f32x4*)(halo + ((size_t)(u.pm * 2 + (fr - 14)) * 2 + bj) * dff + u.pn * HALF + ccol + 4 * n) = acc[1][bj][3][n]; }
        }
        asm volatile("s_waitcnt lgkmcnt(0)" ::: "memory"); __builtin_amdgcn_s_barrier(); asm volatile("" ::: "memory");
#pragma unroll
        for (int n = 0; n < 2; ++n) {
            const int ch = u.pn * HALF + ccol + 4 * n;
            f32x4 wg[3], wu[3];
#pragma unroll
            for (int t = 0; t < 3; ++t) { wg[t] = *(const f32x4*)(cw + (size_t)t * 2 * dff + ch); wu[t] = *(const f32x4*)(cw + (size_t)t * 2 * dff + dff + ch); }
#pragma unroll
            for (int ai = 0; ai < 2; ++ai) {
                f32x4 c1g = {0.f, 0.f, 0.f, 0.f}, c2g = c1g, c1u = c1g, c2u = c1g;
                if (ai + wr > 0) { const int sw = wr ^ 1, sa = wr == 0 ? ai - 1 : ai; const PG8_LAS float* xp = xb + ((sw * 2 + sa) * 2) * 256 + ccol + 4 * n;
                    const f32x4 e0g = *(const PG8_LAS f32x4*)(xp), e1g = *(const PG8_LAS f32x4*)(xp + 256), e0u = *(const PG8_LAS f32x4*)(xp + HALF), e1u = *(const PG8_LAS f32x4*)(xp + 256 + HALF);
                    c1g = e1g; c1u = e1u;
#pragma unroll
                    for (int j = 0; j < 4; ++j) { c2g[j] = fr == 0 ? e0g[j] : e1g[j]; c2u[j] = fr == 0 ? e0u[j] : e1u[j]; } }
#pragma unroll
                for (int m = 0; m < 4; ++m) {
                    const f32x4 G = acc[ai][0][m][n], U = acc[ai][1][m][n];
                    f32x4 r1g, r2g, r1u, r2u, cg, cu;
#pragma unroll
                    for (int j = 0; j < 4; ++j) { r1g[j] = dpp_ror1(G[j]); r2g[j] = dpp_ror2(G[j]); r1u[j] = dpp_ror1(U[j]); r2u[j] = dpp_ror2(U[j]);
                        const float p1g = fr == 0 ? c1g[j] : r1g[j], p2g = fr < 2 ? c2g[j] : r2g[j], p1u = fr == 0 ? c1u[j] : r1u[j], p2u = fr < 2 ? c2u[j] : r2u[j];
                        cg[j] = wg[2][j] * G[j] + wg[1][j] * p1g + wg[0][j] * p2g; cu[j] = wu[2][j] * U[j] + wu[1][j] * p1u + wu[0][j] * p2u; }
                    c1g = r1g; c2g = r2g; c1u = r1u; c2u = r2u;
                    const int row = u.pm * BM + ai * HALF + wr * 64 + m * 16 + fr;
                    if (ai == 0 && m == 0 && wr == 0 && fr < 2) {
                        *(f32x4*)(part + ((size_t)(u.pm * 2 + fr) * 2 + 0) * dff + ch) = cg; *(f32x4*)(part + ((size_t)(u.pm * 2 + fr) * 2 + 1) * dff + ch) = cu;
                    } else {
                        f32x4 a;
#pragma unroll
                        for (int j = 0; j < 4; ++j) a[j] = cg[j] / (1.0f + __expf(-cg[j])) * cu[j];
                        typedef unsigned u32x2 __attribute__((ext_vector_type(2)));
                        u32x2 w; w.x = cvt_pk_bf16(a[0], a[1]); w.y = cvt_pk_bf16(a[2], a[3]);
                        *(u32x2*)(act + (size_t)row * dff + ch) = w;
                    }
                }
            }
        }
    }
};

template <class Epi, class Sched, bool ALIGN_EPI = false>
__device__ __forceinline__ void gemm_phase(PG8_LAS unsigned char* lds, const Gemm g, const Sched& S, const Epi& E) {
    int tid_ = threadIdx.x; asm volatile("" : "+v"(tid_));
    const int tid = tid_, wid = __builtin_amdgcn_readfirstlane(tid >> 6), lane = tid & 63, wr = wid >> 2, wc = wid & 3, fr = lane & 15, fq = lane >> 4;
    const int K = g.K, nt = K / BK;
    unsigned voffA[2], voffB[2];
#pragma unroll
    for (int i = 0; i < 2; ++i) { int R, C; stage_rc(tid * 16 + i * 8192, R, C); const int Rb = Epi::PERM ? ((R & ~31) + perm32(R & 31)) : R;
        voffA[i] = (unsigned)(R * g.lda + C) * 2u; voffB[i] = (unsigned)(Rb * g.ldb + C) * 2u; }
    const size_t kstep = (size_t)(BK * 2);
    const size_t hstepA = (size_t)HALF * g.lda * 2, hstepB = (size_t)HALF * g.ldb * 2;
    const unsigned ldsw = (unsigned)wid * 1024u;
    const int aoff = lds_byte(wr * 64 + fr, fq * 8), boff = lds_byte(wc * 32 + fr, fq * 8);
#define PG8_SA(b, h) (((b) * 2 + (h)) * HTB)
#define PG8_SB(b, h) ((4 + (b) * 2 + (h)) * HTB)
#define PG8_STAGE(bufoff, gbase, voff) do { _Pragma("unroll") for (int _i = 0; _i < 2; ++_i) \
        __builtin_amdgcn_global_load_lds((const unsigned*)((const char*)(gbase) + (voff)[_i]), (PG8_LAS unsigned*)(lds + (bufoff) + ldsw + _i * 8192), 16, 0, 0); } while (0)
#define PG8_LDA(dst, b, h) do { _Pragma("unroll") for (int m = 0; m < 4; ++m) _Pragma("unroll") for (int k = 0; k < 2; ++k) dst[m][k] = *(const PG8_LAS bf16x8*)(lds + PG8_SA(b, h) + aoff + m * 2048 + k * 1024); } while (0)
#define PG8_LDB(dst, b, h) do { _Pragma("unroll") for (int n = 0; n < 2; ++n) _Pragma("unroll") for (int k = 0; k < 2; ++k) dst[n][k] = *(const PG8_LAS bf16x8*)(lds + PG8_SB(b, h) + boff + n * 2048 + k * 1024); } while (0)
#define PG8_MMA(ai, bj, At, Bt) do { __builtin_amdgcn_s_setprio(1); _Pragma("unroll") for (int m = 0; m < 4; ++m) _Pragma("unroll") for (int n = 0; n < 2; ++n) _Pragma("unroll") for (int k = 0; k < 2; ++k) \
        acc[ai][bj][m][n] = __builtin_amdgcn_mfma_f32_16x16x32_bf16(Bt[n][k], At[m][k], acc[ai][bj][m][n], 0, 0, 0); __builtin_amdgcn_s_setprio(0); } while (0)
#define PG8_WAIT_V(n) asm volatile("s_waitcnt vmcnt(" #n ")" ::: "memory")
#define PG8_WAIT_L(n) asm volatile("s_waitcnt lgkmcnt(" #n ")" ::: "memory")
#define PG8_BAR __builtin_amdgcn_s_barrier()
#define PG8_SCHED __builtin_amdgcn_sched_barrier(0)
    Unit cur, nxt; int ui = 0;
    if (!S.next(0, cur)) return;
    f32x4 acc[2][2][4][2];
#pragma unroll
    for (int a = 0; a < 2; ++a)
#pragma unroll
        for (int b = 0; b < 2; ++b)
#pragma unroll
            for (int m = 0; m < 4; ++m)
#pragma unroll
                for (int n = 0; n < 2; ++n) acc[a][b][m][n] = (f32x4){0.f, 0.f, 0.f, 0.f};
    bf16x8 At[4][2], B0[2][2], B1[2][2];
    const char* cA = S.pa(g, cur); const char* cB = S.pb(g, cur);
    PG8_STAGE(PG8_SB(0, 0), cB, voffB); PG8_STAGE(PG8_SB(0, 1), cB + hstepB, voffB); PG8_STAGE(PG8_SA(0, 0), cA, voffA); PG8_STAGE(PG8_SA(0, 1), cA + hstepA, voffA);
    if (wr == 1) PG8_BAR;
    PG8_WAIT_V(2); PG8_BAR;
    PG8_STAGE(PG8_SB(1, 0), cB + kstep, voffB); PG8_STAGE(PG8_SA(1, 0), cA + kstep, voffA); PG8_STAGE(PG8_SB(1, 1), cB + hstepB + kstep, voffB);
    PG8_WAIT_V(6); PG8_BAR;
    for (;;) {
        const bool has_next = S.next(ui + 1, nxt);
        const char* nA = has_next ? S.pa(g, nxt) : cA; const char* nB = has_next ? S.pb(g, nxt) : cB;
#pragma nounroll
        for (int t = 0; t < nt; t += 2) {
            const bool last = (t == nt - 2);
            const char* a1 = cA + (size_t)(t + 1) * kstep;
            const char* a2 = last ? nA : cA + (size_t)(t + 2) * kstep; const char* b2 = last ? nB : cB + (size_t)(t + 2) * kstep;
            const char* a3 = a2 + kstep; const char* b3 = b2 + kstep;
            PG8_LDB(B0, 0, 0); PG8_LDB(B1, 0, 1); PG8_SCHED; PG8_LDA(At, 0, 0); PG8_STAGE(PG8_SA(1, 1), a1 + hstepA, voffA);
            PG8_WAIT_V(8); PG8_WAIT_L(0); PG8_BAR; PG8_MMA(0, 0, At, B0); PG8_MMA(0, 1, At, B1); PG8_BAR; PG8_SCHED;
            PG8_LDA(At, 0, 1); PG8_STAGE(PG8_SB(0, 0), b2, voffB); PG8_STAGE(PG8_SB(0, 1), b2 + hstepB, voffB); PG8_STAGE(PG8_SA(0, 0), a2, voffA);
            PG8_WAIT_V(8); PG8_WAIT_L(0); PG8_BAR; PG8_MMA(1, 0, At, B0); PG8_MMA(1, 1, At, B1); PG8_BAR; PG8_SCHED;
            PG8_LDB(B0, 1, 0); PG8_LDB(B1, 1, 1); PG8_SCHED; PG8_LDA(At, 1, 0); PG8_STAGE(PG8_SA(0, 1), a2 + hstepA, voffA);
            PG8_WAIT_V(8); PG8_WAIT_L(0); PG8_BAR; PG8_MMA(0, 0, At, B0); PG8_MMA(0, 1, At, B1); PG8_BAR; PG8_SCHED;
            PG8_LDA(At, 1, 1); PG8_STAGE(PG8_SB(1, 0), b3, voffB); PG8_STAGE(PG8_SB(1, 1), b3 + hstepB, voffB); PG8_STAGE(PG8_SA(1, 0), a3, voffA);
            PG8_WAIT_V(8); PG8_WAIT_L(0); PG8_BAR; PG8_MMA(1, 0, At, B0); PG8_MMA(1, 1, At, B1); PG8_BAR; PG8_SCHED;
        }
        if constexpr (ALIGN_EPI) { if (wr == 0) PG8_BAR; }
        if constexpr (!Epi::AFTER_DRAIN) { E(acc, cur, wr, wc, fr, fq); }
        if (!has_next) break;
#pragma unroll
        for (int a = 0; a < 2; ++a)
#pragma unroll
            for (int b = 0; b < 2; ++b)
#pragma unroll
                for (int m = 0; m < 4; ++m)
#pragma unroll
                    for (int n = 0; n < 2; ++n) acc[a][b][m][n] = (f32x4){0.f, 0.f, 0.f, 0.f};
        cur = nxt; cA = nA; cB = nB; ++ui;
        if constexpr (ALIGN_EPI) { if (wr == 1) PG8_BAR; }
    }
    PG8_WAIT_V(0);
    if constexpr (!ALIGN_EPI) { if (wr == 0) PG8_BAR; }
    PG8_BAR;
    if constexpr (Epi::AFTER_DRAIN) { E.fused(acc, cur, wr, wc, fr, fq, lds, wid, lane); }
#undef PG8_SA
#undef PG8_SB
#undef PG8_STAGE
#undef PG8_LDA
#undef PG8_LDB
#undef PG8_MMA
#undef PG8_WAIT_V
#undef PG8_WAIT_L
#undef PG8_BAR
#undef PG8_SCHED
}
}

constexpr int BATCH = 2, SEQ = 8192, D = 2048, DEPTH = 4, M = BATCH * SEQ;
constexpr int GW = 1024, GH = 8, GD = 128, SCW = 1024, NMEM = 256, XH = 4, XD = 512, DFF = 5632;
constexpr int NMIX_SRC = 7184, NMIX = 7168;
constexpr int PC_Q = 0, PC_K = 1024, PC_V = 2048, PC_Z = 3072, PC_B = 4096, PC_C = 5120, PC_H = 6144;
constexpr float EPS = 1e-6f;
constexpr int NWAVES = 8, NTHREADS = 512;

constexpr size_t MiB = 1u << 20;
constexpr size_t WS_CTL = 0, CTL_ZERO_BYTES = 1 * MiB;
constexpr size_t WS_WMIX = 1 * MiB;
constexpr size_t WS_WOUT = WS_WMIX + 112 * MiB;
constexpr size_t WS_WXQ  = WS_WOUT + 32 * MiB;
constexpr size_t WS_WXK  = WS_WXQ + 32 * MiB;
constexpr size_t WS_WXV  = WS_WXK + 32 * MiB;
constexpr size_t WS_WXO  = WS_WXV + 32 * MiB;
constexpr size_t WS_WUP  = WS_WXO + 32 * MiB;
constexpr size_t WS_WDN  = WS_WUP + 176 * MiB;
constexpr size_t WS_MEMN = WS_WDN + 88 * MiB;
constexpr size_t WS_KX   = WS_MEMN + 8 * MiB;
constexpr size_t WS_VX   = WS_KX + 8 * MiB;
constexpr size_t WS_BETA = WS_VX + 8 * MiB;
constexpr size_t WS_WBA  = WS_BETA + 512 * 1024;
constexpr size_t WS_G    = WS_BETA + 1 * MiB;
constexpr size_t WS_H    = WS_G + 1 * MiB;
constexpr size_t WS_OG   = WS_H + 64 * MiB;
constexpr size_t WS_Y    = WS_OG + 64 * MiB;
constexpr size_t WS_PB   = WS_OG;
constexpr size_t WS_HB   = WS_Y + 64 * MiB;
constexpr size_t WS_BIG  = WS_HB + 64 * MiB;
constexpr size_t WS_PROJ = WS_BIG;
constexpr size_t WS_GS   = WS_BIG + 224 * MiB;
constexpr size_t WS_ACT  = WS_BIG;
constexpr size_t WS_HALO = WS_BIG + 192 * MiB;
constexpr size_t WS_PART = WS_BIG + 200 * MiB;
constexpr size_t WS_WQK  = WS_BIG + 416 * MiB;
constexpr size_t WS_VWO  = WS_WQK + 32 * MiB;
constexpr size_t WS_END  = WS_VWO + 32 * MiB;
constexpr size_t WS_SSQ  = 65536;
static_assert(WS_SSQ + (size_t)DEPTH * 3 * M * 4 <= CTL_ZERO_BYTES, "ssq arrays inside the zeroed region");
constexpr int CW_BAR = 4096;

constexpr int RING_OFF = 0, RING_BYTES = 131072;
constexpr int LDSCTL_OFF = RING_BYTES, MISC_OFF = LDSCTL_OFF + 320, XB_OFF = LDSCTL_OFF + 1024;
constexpr int LDS_BYTES = 147456;

#define GAS __attribute__((address_space(1)))
#define LAS __attribute__((address_space(3)))
typedef unsigned short bf16;
typedef unsigned v4u __attribute__((ext_vector_type(4)));
typedef unsigned v2u __attribute__((ext_vector_type(2)));
typedef float f32x4 __attribute__((ext_vector_type(4)));
typedef short bf16x8 __attribute__((ext_vector_type(8)));
#define LDS_WAIT() asm volatile("s_waitcnt lgkmcnt(0)" ::: "memory")
#define VM_WAIT() asm volatile("s_waitcnt vmcnt(0)" ::: "memory")
__device__ __forceinline__ unsigned pk2(float lo, float hi) { return pg8::cvt_pk_bf16(lo, hi); }
__device__ __forceinline__ float bf_lo(unsigned w) { return __uint_as_float(w << 16); }
__device__ __forceinline__ float bf_hi(unsigned w) { return __uint_as_float(w & 0xffff0000u); }
__device__ __forceinline__ float wave_sum(float v) {
#pragma unroll
    for (int o = 1; o < 64; o <<= 1) v += __shfl_xor(v, o);
    return v;
}
__device__ __forceinline__ float silu_f(float y) { return y / (1.0f + __expf(-y)); }
__device__ __forceinline__ float sigmoid_f(float y) { return 1.0f / (1.0f + __expf(-y)); }

#define XB_TMO      128
#define XB_XCNT(j)  (256  + 64 * (j))
#define XB_XSUB(j)  (1280 + 64 * (j))
#define XB_XGEN(j)  (2304 + 64 * (j))
#define XB_TOP      3328
#define XB_TOPGEN   3392
#define XCD_BAR_WORDS 3456
#define XB_SPIN_CAP (1u << 18)

__device__ __forceinline__ unsigned xb_ld(unsigned* p)              { return __hip_atomic_load(p, __ATOMIC_RELAXED, __HIP_MEMORY_SCOPE_AGENT); }
__device__ __forceinline__ unsigned xb_add(unsigned* p, unsigned v) { return __hip_atomic_fetch_add(p, v, __ATOMIC_RELAXED, __HIP_MEMORY_SCOPE_AGENT); }
__device__ __forceinline__ unsigned xb_xcc_id() { return (unsigned)__builtin_amdgcn_s_getreg((3 << 11) | 20) & 0xFu; }
#define XB_SPIN(cond, bar) do { unsigned _sp = 0; while (cond) { __builtin_amdgcn_s_sleep(1); \
    if ((++_sp & 255u) == 0u) { if (xb_ld(&(bar)[XB_TMO])) break; if (_sp > XB_SPIN_CAP) { atomicAdd(&(bar)[XB_TMO], 1u); break; } } } } while (0)

struct XcdBarrier {
    unsigned* bar; unsigned x;
    volatile LAS unsigned* st;
};

__device__ __forceinline__ XcdBarrier xcd_barrier_post(unsigned* bar, volatile LAS unsigned* st) {
    XcdBarrier b; b.bar = bar; b.x = xb_xcc_id(); b.st = st;
    if (threadIdx.x == 0) (void)xb_add(&bar[XB_XCNT(b.x)], 1u);
    return b;
}
__device__ __forceinline__ void xcd_barrier_complete(unsigned* bar, unsigned x, unsigned& nloc, unsigned& nx) {
    const unsigned G = gridDim.x * gridDim.y * gridDim.z;
    unsigned sum, cnt, mine, sp = 0u;
    for (;;) {
        sum = 0u; cnt = 0u; mine = 0u;
#pragma unroll
        for (unsigned j = 0; j < 16; ++j) { const unsigned c = xb_ld(&bar[XB_XCNT(j)]); sum += c; cnt += (c > 0u) ? 1u : 0u; mine = (j == x) ? c : mine; }
        if (sum == G) break;
        __builtin_amdgcn_s_sleep(1);
        if ((++sp & 255u) == 0u) { if (xb_ld(&bar[XB_TMO])) break; if (sp > XB_SPIN_CAP) { atomicAdd(&bar[XB_TMO], 1u); break; } }
    }
    nloc = mine > 0u ? mine : 1u; nx = cnt > 0u ? cnt : 1u;
}

__device__ __forceinline__ void xcd_barrier(const XcdBarrier& b) {
    asm volatile("s_waitcnt vmcnt(0)" ::: "memory");
    __syncthreads();
    if (threadIdx.x == 0) {
        unsigned* bar = b.bar;
        __builtin_amdgcn_s_waitcnt(0);
        unsigned nloc = b.st[0], nx = b.st[1];
        if (nloc == 0u) { xcd_barrier_complete(bar, b.x, nloc, nx); b.st[0] = nloc; b.st[1] = nx; }
        const unsigned old = xb_add(&bar[XB_XSUB(b.x)], 1u);
        const unsigned gen = old / nloc;
        if (old + 1u == (gen + 1u) * nloc) {
            __builtin_amdgcn_fence(__ATOMIC_RELEASE, "agent");
            asm volatile("s_waitcnt vmcnt(0)" ::: "memory");
            const unsigned og = xb_add(&bar[XB_TOP], 1u);
            const unsigned tg = og / nx;
            if (og + 1u == (tg + 1u) * nx) xb_add(&bar[XB_TOPGEN], 1u);
            else XB_SPIN(xb_ld(&bar[XB_TOPGEN]) == tg, bar);
            __builtin_amdgcn_fence(__ATOMIC_ACQUIRE, "agent");
            xb_add(&bar[XB_XGEN(b.x)], 1u);
            asm volatile("s_waitcnt vmcnt(0)" ::: "memory");
        } else {
            XB_SPIN(xb_ld(&bar[XB_XGEN(b.x)]) == gen, bar);
            __builtin_amdgcn_fence(__ATOMIC_ACQUIRE, "agent");
            asm volatile("s_waitcnt vmcnt(0)" ::: "memory");
        }
    }
    __syncthreads();
}


struct Frame {
    LAS unsigned char* lds;
    int tid, lane, wave, G, gw, NGW;
    unsigned char* ws;
};
#define IN_X 0
#define IN_MEM 1
#define IN_MIX_NORM 2
#define IN_W_MIX_IN 3
#define IN_GDN_CONV 4
#define IN_A_LOG 5
#define IN_DT_BIAS 6
#define IN_OUT_NORM 7
#define IN_SC_CONV 8
#define IN_W_MIX_OUT 9
#define IN_XATTN_NORM 10
#define IN_MEM_NORM 11
#define IN_W_XQ 12
#define IN_W_XK 13
#define IN_W_XV 14
#define IN_W_XO 15
#define IN_FFN_NORM 16
#define IN_W_UP 17
#define IN_FFN_CONV 18
#define IN_W_DOWN 19
#define IN_FINAL_NORM 20

__device__ __forceinline__ void xpose_item(const float* src  , size_t ld, bf16* dst  , size_t K, int lane, LAS unsigned char* T) {
    const int n4 = lane & 15, ksub = lane >> 4;
    const float* s = src + (size_t)(16 * ksub) * ld + 4 * n4;
    f32x4 v[16];
#pragma unroll
    for (int i = 0; i < 16; ++i) v[i] = *(const f32x4*)(s + (size_t)i * ld);
#pragma unroll
    for (int j = 0; j < 4; ++j) { v4u a, b; a.x = pk2(v[0][j], v[1][j]); a.y = pk2(v[2][j], v[3][j]); a.z = pk2(v[4][j], v[5][j]); a.w = pk2(v[6][j], v[7][j]);
        b.x = pk2(v[8][j], v[9][j]); b.y = pk2(v[10][j], v[11][j]); b.z = pk2(v[12][j], v[13][j]); b.w = pk2(v[14][j], v[15][j]);
        LAS v4u* t = (LAS v4u*)(T + (4 * n4 + j) * 144 + 32 * ksub); t[0] = a; t[1] = b; }
    LDS_WAIT(); asm volatile("" ::: "memory");
#pragma unroll
    for (int i = 0; i < 8; ++i) { const int n = 8 * i + (lane >> 3), c = lane & 7; *(v4u*)(dst + (size_t)n * K + 8 * c) = *(const LAS v4u*)(T + n * 144 + 16 * c); }
    LDS_WAIT(); asm volatile("" ::: "memory");
}
__device__ __forceinline__ void convert_item(const float* src, bf16* dst, int lane) {
#pragma unroll
    for (int k = 0; k < 8; ++k) { const f32x4 a = *(const f32x4*)(src + k * 512 + 8 * lane), b = *(const f32x4*)(src + k * 512 + 8 * lane + 4);
        v4u o; o.x = pk2(a[0], a[1]); o.y = pk2(a[2], a[3]); o.z = pk2(b[0], b[1]); o.w = pk2(b[2], b[3]); *(v4u*)(dst + k * 512 + 8 * lane) = o; }
}
__device__ __forceinline__ void p0_weights_x(Frame& F, const float* w_xq, const float* w_xk, const float* w_xv, const float* w_xo) {
    constexpr int I_SQ = 32 * 32, I_XQ = D * D / 4096, I_LAYER = 3 * I_SQ + I_XQ;
    LAS unsigned char* T = F.lds + RING_OFF + F.wave * 9216;
    for (int it = F.gw; it < DEPTH * I_LAYER; it += F.NGW) {
        const int l = it / I_LAYER; int r = it % I_LAYER;
        if (r < 3 * I_SQ) { const int f = r / I_SQ, rr = r % I_SQ, nb = rr >> 5, kb = rr & 31;
            const float* src = f == 0 ? w_xk : f == 1 ? w_xv : w_xo;
            const size_t dofs = f == 0 ? WS_WXK : f == 1 ? WS_WXV : WS_WXO;
            xpose_item(src + (size_t)l * D * D + (size_t)(kb * 64) * D + nb * 64, D, (bf16*)(F.ws + dofs) + (size_t)l * D * D + (size_t)(nb * 64) * D + kb * 64, D, F.lane, T); continue; }
        r -= 3 * I_SQ;
        convert_item(w_xq + (size_t)l * D * D + (size_t)r * 4096, (bf16*)(F.ws + WS_WXQ) + (size_t)l * D * D + (size_t)r * 4096, F.lane);
    }
}
__device__ __forceinline__ void p0_weights_main(Frame& F, int l, int gw, int ngw, const float* w_mix_in, const float* w_mix_out, const float* w_up, const float* w_down) {
    constexpr int I_MIX = 112 * 32, I_SQ = 32 * 32, I_UP = 176 * 32, I_DN = 32 * 88, I_LAYER = I_MIX + I_SQ + I_UP + I_DN;
    LAS unsigned char* T = F.lds + RING_OFF + F.wave * 9216;
    for (int it = gw; it < I_LAYER; it += ngw) {
        int r = it;
        if (r < I_MIX) { const int nb = r >> 5, kb = r & 31, n0 = nb * 64, sc = n0 < 4096 ? n0 : n0 + 16;
            xpose_item(w_mix_in + (size_t)l * D * NMIX_SRC + (size_t)(kb * 64) * NMIX_SRC + sc, NMIX_SRC, (bf16*)(F.ws + WS_WMIX) + (size_t)l * NMIX * D + (size_t)n0 * D + kb * 64, D, F.lane, T); continue; }
        r -= I_MIX;
        if (r < I_SQ) { const int nb = r >> 5, kb = r & 31;
            xpose_item(w_mix_out + (size_t)l * D * D + (size_t)(kb * 64) * D + nb * 64, D, (bf16*)(F.ws + WS_WOUT) + (size_t)l * D * D + (size_t)(nb * 64) * D + kb * 64, D, F.lane, T); continue; }
        r -= I_SQ;
        if (r < I_UP) { const int nb = r >> 5, kb = r & 31, n0 = nb * 64, c0 = n0 < DFF ? n0 : n0 - DFF, drow = (c0 >> 7) * 256 + (n0 < DFF ? 0 : 128) + (c0 & 127);
            xpose_item(w_up + (size_t)l * D * 2 * DFF + (size_t)(kb * 64) * 2 * DFF + n0, 2 * DFF, (bf16*)(F.ws + WS_WUP) + (size_t)l * 2 * DFF * D + (size_t)drow * D + kb * 64, D, F.lane, T); continue; }
        r -= I_UP;
        { const int nb = r / 88, kb = r % 88;
            xpose_item(w_down + (size_t)l * DFF * D + (size_t)(kb * 64) * D + nb * 64, D, (bf16*)(F.ws + WS_WDN) + (size_t)l * D * DFF + (size_t)(nb * 64) * DFF + kb * 64, DFF, F.lane, T); }
    }
    for (int i = gw * 64 + F.lane; i < 16 * D; i += ngw * 64) { const int n = i / D, k = i % D;
        ((bf16*)(F.ws + WS_WBA))[(size_t)l * 16 * D + i] = (bf16)(pk2(w_mix_in[(size_t)l * D * NMIX_SRC + (size_t)k * NMIX_SRC + 4096 + n], 0.f) & 0xffffu); }
}
__device__ __forceinline__ void p0_memn(Frame& F, const float* mem, const float* mem_norm) {
    for (int m = F.gw; m < BATCH * NMEM; m += F.NGW) {
        const f32x4* xr = (const f32x4*)(mem + (size_t)m * D) + F.lane;
        f32x4 v[8]; float s = 0.f;
#pragma unroll
        for (int j = 0; j < 8; ++j) { v[j] = xr[64 * j]; s += (v[j][0] * v[j][0] + v[j][1] * v[j][1]) + (v[j][2] * v[j][2] + v[j][3] * v[j][3]); }
        const float rstd = 1.0f / sqrtf(wave_sum(s) * (1.0f / D) + EPS);
        for (int l = 0; l < DEPTH; ++l) {
            const f32x4* gr = (const f32x4*)(mem_norm + (size_t)l * D) + F.lane;
            v2u* o8 = (v2u*)((bf16*)(F.ws + WS_MEMN) + ((size_t)l * 512 + m) * D) + F.lane;
#pragma unroll
            for (int j = 0; j < 8; ++j) { const f32x4 g4 = gr[64 * j]; const f32x4 h = v[j] * rstd * g4; v2u o; o.x = pk2(h[0], h[1]); o.y = pk2(h[2], h[3]); o8[64 * j] = o; }
        }
    }
}

__device__ __forceinline__ void prenorm_phase(Frame& F, const float* x, const float* gain, bf16* Hn, float* ssq) {
    f32x4 g4[8];
#pragma unroll
    for (int j = 0; j < 8; ++j) g4[j] = ((const f32x4*)gain)[64 * j + F.lane];
    for (int m = F.gw; m < M; m += F.NGW) {
        const f32x4* xr = (const f32x4*)(x + (size_t)m * D) + F.lane;
        f32x4 v[8]; float s = 0.f;
#pragma unroll
        for (int j = 0; j < 8; ++j) { v[j] = xr[64 * j]; s += (v[j][0] * v[j][0] + v[j][1] * v[j][1]) + (v[j][2] * v[j][2] + v[j][3] * v[j][3]); }
        s = wave_sum(s);
        if (F.lane == 0) ssq[m] = s;
        v2u* o8 = (v2u*)(Hn + (size_t)m * D) + F.lane;
#pragma unroll
        for (int j = 0; j < 8; ++j) { v[j] = v[j] * g4[j]; v2u o; o.x = pk2(v[j][0], v[j][1]); o.y = pk2(v[j][2], v[j][3]); o8[64 * j] = o; }
    }
}
__device__ __forceinline__ void ba_phase(Frame& F, const bf16* Hn, const float* ssq, const bf16* wba  , const float* alogp, const float* dtbp) {
    const int lane = F.lane, wave = F.wave, mtile = wave & 3, khalf = wave >> 2, fr = lane & 15, fq = lane >> 4;
    LAS f32x4* red = (LAS f32x4*)(F.lds);
    for (int rb = blockIdx.x; rb < M / 64; rb += F.G) {
        const int row0 = rb * 64 + 16 * mtile;
        const bf16* ap = Hn + (size_t)(row0 + fr) * D + khalf * 1024 + 8 * fq;
        const bf16* bp = wba + (size_t)fr * D + khalf * 1024 + 8 * fq;
        f32x4 acc = {0.f, 0.f, 0.f, 0.f};
#pragma unroll 8
        for (int s = 0; s < 32; ++s) { const bf16x8 a = __builtin_bit_cast(bf16x8, *(const v4u*)(ap + 32 * s)), b = __builtin_bit_cast(bf16x8, *(const v4u*)(bp + 32 * s));
            acc = __builtin_amdgcn_mfma_f32_16x16x32_bf16(a, b, acc, 0, 0, 0); }
        if (khalf == 1) red[mtile * 64 + lane] = acc;
        LDS_WAIT(); __syncthreads();
        if (khalf == 0) {
            const f32x4 o = red[mtile * 64 + lane]; acc = acc + o;
            const float al = fr >= 8 ? alogp[fr - 8] : 0.f, db = fr >= 8 ? dtbp[fr - 8] : 0.f;
#pragma unroll
            for (int i = 0; i < 4; ++i) { const int row = row0 + 4 * fq + i; const float v = acc[i] * (1.0f / sqrtf(ssq[row] * (1.0f / D) + EPS));
                if (fr < 8) ((float*)(F.ws + WS_BETA))[(size_t)row * GH + fr] = sigmoid_f(v);
                else { const float z = v + db; const float sp = fmaxf(z, 0.f) + log1pf(expf(-fabsf(z))); ((float*)(F.ws + WS_G))[(size_t)row * GH + fr - 8] = -expf(al) * sp; } }
        }
        LDS_WAIT(); __syncthreads();
    }
}
__device__ __forceinline__ void final_norm_phase(Frame& F, const float* x, const float* gain, float* out) {
    f32x4 g4[8];
#pragma unroll
    for (int j = 0; j < 8; ++j) g4[j] = ((const f32x4*)gain)[64 * j + F.lane];
    for (int m = F.gw; m < M; m += F.NGW) {
        const f32x4* xr = (const f32x4*)(x + (size_t)m * D) + F.lane;
        f32x4 v[8]; float s = 0.f;
#pragma unroll
        for (int j = 0; j < 8; ++j) { v[j] = xr[64 * j]; s += (v[j][0] * v[j][0] + v[j][1] * v[j][1]) + (v[j][2] * v[j][2] + v[j][3] * v[j][3]); }
        const float rstd = 1.0f / sqrtf(wave_sum(s) * (1.0f / D) + EPS);
        f32x4* o = (f32x4*)(out + (size_t)m * D) + F.lane;
#pragma unroll
        for (int j = 0; j < 8; ++j) o[64 * j] = v[j] * rstd * g4[j];
    }
}

__device__ __forceinline__ void unpack8(const v4u w, float (&f)[8]) {
    f[0] = bf_lo(w.x); f[1] = bf_hi(w.x); f[2] = bf_lo(w.y); f[3] = bf_hi(w.y); f[4] = bf_lo(w.z); f[5] = bf_hi(w.z); f[6] = bf_lo(w.w); f[7] = bf_hi(w.w);
}

__device__ __forceinline__ void shortconv_phase(Frame& F, const float* cw, int gw, int ngw) {
    const bf16* PROJ = (const bf16*)(F.ws + WS_PROJ);
    bf16* Y = (bf16*)(F.ws + WS_Y);
    for (int rb = gw; rb < M / 8; rb += ngw) {
        const int m0 = rb * 8, t0 = m0 % SEQ;
        for (int i = 0; i < 2; ++i) {
            const int ch0 = 8 * (F.lane + 64 * i);
            float w[3][8];
#pragma unroll
            for (int j = 0; j < 3; ++j) { const f32x4 a = *(const f32x4*)(cw + (size_t)j * SCW + ch0), b = *(const f32x4*)(cw + (size_t)j * SCW + ch0 + 4);
                w[j][0] = a[0]; w[j][1] = a[1]; w[j][2] = a[2]; w[j][3] = a[3]; w[j][4] = b[0]; w[j][5] = b[1]; w[j][6] = b[2]; w[j][7] = b[3]; }
            float x0[8], x1[8], x2[8], cg[8], hh[8], bg[8];
            const bf16* p = PROJ + (size_t)m0 * NMIX + ch0;
            if (t0 >= 2) {
                unpack8(*(const v4u*)(p - 2 * (size_t)NMIX + PC_C), cg); unpack8(*(const v4u*)(p - 2 * (size_t)NMIX + PC_H), hh);
#pragma unroll
                for (int e = 0; e < 8; ++e) x0[e] = cg[e] * hh[e];
                unpack8(*(const v4u*)(p - (size_t)NMIX + PC_C), cg); unpack8(*(const v4u*)(p - (size_t)NMIX + PC_H), hh);
#pragma unroll
                for (int e = 0; e < 8; ++e) x1[e] = cg[e] * hh[e];
            } else {
#pragma unroll
                for (int e = 0; e < 8; ++e) { x0[e] = 0.f; x1[e] = 0.f; } }
            for (int r = 0; r < 8; ++r) {
                unpack8(*(const v4u*)(p + (size_t)r * NMIX + PC_C), cg); unpack8(*(const v4u*)(p + (size_t)r * NMIX + PC_H), hh); unpack8(*(const v4u*)(p + (size_t)r * NMIX + PC_B), bg);
                float y[8];
#pragma unroll
                for (int e = 0; e < 8; ++e) { x2[e] = cg[e] * hh[e]; y[e] = bg[e] * (w[0][e] * x0[e] + w[1][e] * x1[e] + w[2][e] * x2[e]); x0[e] = x1[e]; x1[e] = x2[e]; }
                v4u o; o.x = pk2(y[0], y[1]); o.y = pk2(y[2], y[3]); o.z = pk2(y[4], y[5]); o.w = pk2(y[6], y[7]);
                *(v4u*)(Y + (size_t)(m0 + r) * D + GW + ch0) = o;
            }
        }
    }
}
__device__ __forceinline__ void swiglu_fix_phase(Frame& F, const float* cw) {
    bf16* ACT = (bf16*)(F.ws + WS_ACT); const float* PART = (const float*)(F.ws + WS_PART); const float* HALO = (const float*)(F.ws + WS_HALO);
    for (int idx = F.gw * 64 + F.lane; idx < (M / 256) * (DFF / 4); idx += F.NGW * 64) {
        const int pm = idx / (DFF / 4), ch = 4 * (idx % (DFF / 4));
        f32x4 wg[3], wu[3];
#pragma unroll
        for (int t = 0; t < 3; ++t) { wg[t] = *(const f32x4*)(cw + (size_t)t * 2 * DFF + ch); wu[t] = *(const f32x4*)(cw + (size_t)t * 2 * DFF + DFF + ch); }
        f32x4 g0 = *(const f32x4*)(PART + ((size_t)(pm * 2 + 0) * 2 + 0) * DFF + ch), u0 = *(const f32x4*)(PART + ((size_t)(pm * 2 + 0) * 2 + 1) * DFF + ch);
        f32x4 g1 = *(const f32x4*)(PART + ((size_t)(pm * 2 + 1) * 2 + 0) * DFF + ch), u1 = *(const f32x4*)(PART + ((size_t)(pm * 2 + 1) * 2 + 1) * DFF + ch);
        if (pm % (SEQ / 256) != 0) {
            const f32x4 hg0 = *(const f32x4*)(HALO + ((size_t)((pm - 1) * 2 + 0) * 2 + 0) * DFF + ch), hu0 = *(const f32x4*)(HALO + ((size_t)((pm - 1) * 2 + 0) * 2 + 1) * DFF + ch);
            const f32x4 hg1 = *(const f32x4*)(HALO + ((size_t)((pm - 1) * 2 + 1) * 2 + 0) * DFF + ch), hu1 = *(const f32x4*)(HALO + ((size_t)((pm - 1) * 2 + 1) * 2 + 1) * DFF + ch);
            g0 = g0 + wg[1] * hg1 + wg[0] * hg0; u0 = u0 + wu[1] * hu1 + wu[0] * hu0; g1 = g1 + wg[0] * hg1; u1 = u1 + wu[0] * hu1;
        }
        v2u w0, w1; w0.x = pk2(silu_f(g0[0]) * u0[0], silu_f(g0[1]) * u0[1]); w0.y = pk2(silu_f(g0[2]) * u0[2], silu_f(g0[3]) * u0[3]);
        w1.x = pk2(silu_f(g1[0]) * u1[0], silu_f(g1[1]) * u1[1]); w1.y = pk2(silu_f(g1[2]) * u1[2], silu_f(g1[3]) * u1[3]);
        *(v2u*)(ACT + (size_t)(pm * 256) * DFF + ch) = w0; *(v2u*)(ACT + (size_t)(pm * 256 + 1) * DFF + ch) = w1;
    }
}

struct KvOrder {
    int G, c; const bf16 *memn, *wxk, *wxv;
    __device__ __forceinline__ bool next(int i, pg8::Unit& u) const { const long L = (long)i * G + c; if (L >= 128) return false; u.pm = (int)L; u.pn = 0; return true; }
    __device__ __forceinline__ const char* pa(const pg8::Gemm&, const pg8::Unit& u) const { const int l = u.pm >> 5, r = u.pm & 15; return (const char*)(memn + ((size_t)l * 512 + (r >> 3) * 256) * D); }
    __device__ __forceinline__ const char* pb(const pg8::Gemm&, const pg8::Unit& u) const { const int l = u.pm >> 5, r = u.pm & 15;
        const bf16* wk = wxk + ((size_t)l * D + (r & 7) * 256) * D; const bf16* wv = wxv + ((size_t)l * D + (r & 7) * 256) * D; return (const char*)((u.pm & 16) ? wv : wk); }
};
struct LocKv { bf16 *kx, *vx;
    __device__ __forceinline__ void operator()(const pg8::Unit& u, bf16*& base, int& ld) const { const int l = u.pm >> 5, r = u.pm & 15;
        bf16* bk = kx + ((size_t)l * 512 + (r >> 3) * 256) * D + (r & 7) * 256; bf16* bv = vx + ((size_t)l * 512 + (r >> 3) * 256) * D + (r & 7) * 256; base = (u.pm & 16) ? bv : bk; ld = D; } };
struct PreOrder {
    int G, c; const bf16 *kx, *vx, *wxq, *wxo;
    __device__ __forceinline__ bool next(int i, pg8::Unit& u) const { const long L = (long)i * G + c; if (L >= 512) return false; u.pm = (int)L; u.pn = 0; return true; }
    __device__ __forceinline__ const char* pa(const pg8::Gemm&, const pg8::Unit& u) const { const int jj = u.pm & 255, l = jj >> 6, b = (jj >> 5) & 1, h = (jj >> 3) & 3, t = jj & 7;
        return (const char*)(u.pm < 256 ? kx + ((size_t)l * 512 + b * 256) * D + h * XD : wxo + ((size_t)l * D + t * 256) * D + h * XD); }
    __device__ __forceinline__ const char* pb(const pg8::Gemm&, const pg8::Unit& u) const { const int jj = u.pm & 255, l = jj >> 6, b = (jj >> 5) & 1, h = (jj >> 3) & 3, t = jj & 7;
        return (const char*)(u.pm < 256 ? wxq + ((size_t)l * D + t * 256) * D + h * XD : vx + ((size_t)l * 512 + b * 256) * D + h * XD); }
};
struct LocPre { bf16 *wqk, *vwo;
    __device__ __forceinline__ void operator()(const pg8::Unit& u, bf16*& base, int& ld) const { const int jj = u.pm & 255, l = jj >> 6, b = (jj >> 5) & 1, h = (jj >> 3) & 3, t = jj & 7;
        if (u.pm < 256) { base = wqk + ((size_t)(l * 2 + b) * (XH * NMEM) + h * NMEM) * D + t * 256; ld = D; }
        else { base = vwo + ((size_t)(l * 2 + b) * D + t * 256) * (XH * NMEM) + h * NMEM; ld = XH * NMEM; } } };
struct SOrder {
    int G, c;
    __device__ __forceinline__ bool next(int i, pg8::Unit& u) const { const long L = (long)i * G + c; if (L >= 256) return false; u.pm = (int)L & 63; u.pn = (int)L >> 6; return true; }
    __device__ __forceinline__ const char* pa(const pg8::Gemm& g, const pg8::Unit& u) const { return (const char*)(g.A + (size_t)u.pm * 256 * D); }
    __device__ __forceinline__ const char* pb(const pg8::Gemm& g, const pg8::Unit& u) const { return (const char*)(g.Bt + (size_t)(u.pm >> 5) * (XH * NMEM) * D + (size_t)u.pn * NMEM * D); }
};
struct BatchOrder : pg8::StaticOrder {
    size_t bstride;
    __device__ __forceinline__ const char* pb(const pg8::Gemm& g, const pg8::Unit& u) const { return (const char*)(g.Bt + (size_t)(u.pm >> 5) * bstride + (size_t)u.pn * pg8::BM * g.ldb); }
};

typedef float f32x16 __attribute__((ext_vector_type(16)));
typedef float f32x2n __attribute__((ext_vector_type(2)));
typedef __bf16 bf16x2n __attribute__((ext_vector_type(2)));
__device__ __forceinline__ unsigned pkn(float a, float b) { f32x2n v = {a, b}; bf16x2n r = __builtin_convertvector(v, bf16x2n); return __builtin_bit_cast(unsigned, r); }
__device__ __forceinline__ int kmap(int p) { const int pp = p & 15, hh = pp >> 3, jj = pp & 7; return (p & ~15) + 8 * (jj >> 2) + 4 * hh + (jj & 3); }
__device__ __forceinline__ int kpos(int d) { const int dd = d & 15; return (d & ~15) + 8 * ((dd >> 2) & 1) + 4 * (dd >> 3) + (dd & 3); }
__device__ __forceinline__ bf16x8 pack_step(const f32x16& x, int s) {
    v4u w; w.x = pkn(x[8 * s], x[8 * s + 1]); w.y = pkn(x[8 * s + 2], x[8 * s + 3]); w.z = pkn(x[8 * s + 4], x[8 * s + 5]); w.w = pkn(x[8 * s + 6], x[8 * s + 7]);
    return __builtin_bit_cast(bf16x8, w);
}
constexpr int REC_BYTES = 36864, WIMG_STRIDE = 272, KDIMG_OFF = 17408, KDIMG_STRIDE = 144, IMG_USED = 35840;
constexpr size_t WS_REC = WS_GS;
constexpr size_t WS_UT = WS_GS + 80 * MiB;
constexpr size_t WS_ATTN = WS_GS + 144 * MiB;
constexpr size_t WS_EGL = WS_GS + 160 * MiB;
constexpr size_t WS_SST = WS_H;
constexpr size_t WS_QD = WS_OG;
constexpr size_t WS_VST = WS_OG + 32 * MiB;

__device__ __forceinline__ void gdn_prep_phase(Frame& F, const float* cw  ) {
    const bf16* PROJ = (const bf16*)(F.ws + WS_PROJ);
    const float* BETA = (const float*)(F.ws + WS_BETA); const float* GG = (const float*)(F.ws + WS_G);
    unsigned o_vs = 32768, o_kb = 65536, o_qb = 82944, o_as = 101376, o_att = 117760, o_gc = 125952;
    asm volatile("" : "+v"(o_vs), "+v"(o_kb), "+v"(o_qb), "+v"(o_as), "+v"(o_att), "+v"(o_gc));
    LAS float* KS = (LAS float*)(F.lds);
    LAS float* VS = (LAS float*)(F.lds + o_vs);
    LAS unsigned char* KB16 = F.lds + o_kb;
    LAS unsigned char* QB16 = F.lds + o_qb;
    LAS unsigned char* IMG = KB16;
    LAS float* AS = (LAS float*)(F.lds + o_as);
    LAS unsigned short* ATT = (LAS unsigned short*)(F.lds + o_att);
    LAS float* GC = (LAS float*)(F.lds + o_gc);
    const int tid = F.tid, lane = F.lane, wave = F.wave;
#ifndef G1_REP
#define G1_REP 1
#endif
    for (int it = 0; it * F.G < 2048 * G1_REP; ++it) {
        const int u = blockIdx.x + F.G * (it / G1_REP);
        const int ch = u, n = ch & 127, bh = ch >> 7, b = bh >> 3, h = bh & 7;
        const int m0 = b * SEQ + n * 64;
        if (tid < 384) {
            const int rb = tid / 48, cgi = tid % 48, tensor = cgi >> 4, cg = cgi & 15;
            const int ch0 = tensor * GW + h * GD + 8 * cg, c0 = rb * 8;
            float w[4][8];
#pragma unroll
            for (int j = 0; j < 4; ++j) { const f32x4 a = *(const f32x4*)(cw + (size_t)j * 3 * GW + ch0), bq = *(const f32x4*)(cw + (size_t)j * 3 * GW + ch0 + 4);
                w[j][0] = a[0]; w[j][1] = a[1]; w[j][2] = a[2]; w[j][3] = a[3]; w[j][4] = bq[0]; w[j][5] = bq[1]; w[j][6] = bq[2]; w[j][7] = bq[3]; }
            float x0[8], x1[8], x2[8], x3[8];
            const bf16* p = PROJ + (size_t)(m0 + c0) * NMIX + ch0;
            const bool hist = n * 64 + c0 >= 3;
            v4u raw[11];
#pragma unroll
            for (int q = 0; q < 3; ++q) raw[q] = *(const v4u*)(hist ? p - (size_t)(3 - q) * NMIX : p);
#pragma unroll
            for (int q = 0; q < 8; ++q) raw[3 + q] = *(const v4u*)(p + (size_t)q * NMIX);
            if (!hist) { raw[0] = (v4u){0u, 0u, 0u, 0u}; raw[1] = raw[0]; raw[2] = raw[0]; }
            unpack8(raw[0], x0); unpack8(raw[1], x1); unpack8(raw[2], x2);
#pragma unroll
            for (int r = 0; r < 8; ++r) {
                unpack8(raw[3 + r], x3);
                float y[8]; float ss = 0.f;
#pragma unroll
                for (int e = 0; e < 8; ++e) { const float c = w[0][e] * x0[e] + w[1][e] * x1[e] + w[2][e] * x2[e] + w[3][e] * x3[e]; y[e] = silu_f(c); ss += y[e] * y[e]; x0[e] = x1[e]; x1[e] = x2[e]; x2[e] = x3[e]; }
                const int c = c0 + r;
                if (tensor < 2) {
                    ss += __shfl_xor(ss, 1); ss += __shfl_xor(ss, 2); ss += __shfl_xor(ss, 4); ss += __shfl_xor(ss, 8);
                    float sc = 1.0f / sqrtf(ss + EPS); if (tensor == 0) sc *= 0.08838834764831845f;
#pragma unroll
                    for (int e = 0; e < 8; ++e) y[e] *= sc;
                    v4u o; o.x = pkn(y[0], y[1]); o.y = pkn(y[2], y[3]); o.z = pkn(y[4], y[5]); o.w = pkn(y[6], y[7]);
                    *(LAS v4u*)((tensor == 0 ? QB16 : KB16) + c * WIMG_STRIDE + 16 * cg) = o;
                    if (tensor == 1) { *(LAS f32x4*)(KS + c * 128 + 8 * cg) = (f32x4){y[0], y[1], y[2], y[3]}; *(LAS f32x4*)(KS + c * 128 + 8 * cg + 4) = (f32x4){y[4], y[5], y[6], y[7]}; }
                } else { *(LAS f32x4*)(VS + c * 128 + 8 * cg) = (f32x4){y[0], y[1], y[2], y[3]}; *(LAS f32x4*)(VS + c * 128 + 8 * cg + 4) = (f32x4){y[4], y[5], y[6], y[7]}; }
            }
        } else if (wave == 7) {
            const float g = GG[(size_t)(m0 + lane) * GH + h], be = BETA[(size_t)(m0 + lane) * GH + h];
            float x = g;
#pragma unroll
            for (int o = 1; o < 64; o <<= 1) { const float t = __shfl_up(x, o); if (lane >= o) x += t; }
            const float gl = __shfl(x, 63);
            GC[lane] = x; GC[64 + lane] = be; GC[128 + lane] = expf(x); GC[192 + lane] = expf(gl - x);
            if (lane == 0) ((float*)(F.ws + WS_EGL))[ch] = expf(gl);
        }
        LDS_WAIT(); __syncthreads();
        {
            const int mat = wave >> 2, mt = (wave >> 1) & 1, nt = wave & 1, r = lane & 31, hh = lane >> 5;
            const LAS unsigned char* Asrc = (mat ? QB16 : KB16) + (32 * mt + r) * WIMG_STRIDE + 16 * hh;
            const LAS unsigned char* Bsrc = KB16 + (32 * nt + r) * WIMG_STRIDE + 16 * hh;
            f32x16 acc;
#pragma unroll
            for (int i = 0; i < 16; ++i) acc[i] = 0.f;
#pragma unroll
            for (int ks = 0; ks < 8; ++ks) { const bf16x8 a = *(const LAS bf16x8*)(Asrc + 32 * ks), bb = *(const LAS bf16x8*)(Bsrc + 32 * ks); acc = __builtin_amdgcn_mfma_f32_32x32x16_bf16(a, bb, acc, 0, 0, 0); }
            const int m = 32 * nt + r; const float gcm = GC[m];
#pragma unroll
            for (int i = 0; i < 16; ++i) {
                const int c = 32 * mt + (i & 3) + 8 * (i >> 2) + 4 * hh;
                if (mat == 0) AS[c * 64 + m] = (m > c) ? GC[64 + m] * acc[i] * expf(fminf(gcm - GC[c], 0.f)) : 0.f;
                else { const float v = (m <= c) ? acc[i] * expf(fminf(GC[c] - gcm, 0.f)) : 0.f; ATT[c * 64 + kpos(m)] = (unsigned short)(pkn(v, 0.f) & 0xffffu); }
            }
            const int c = tid >> 3, p0 = (tid & 7) * 16; const float eg = GC[128 + c];
            const LAS unsigned short* qrow = (const LAS unsigned short*)(QB16 + c * WIMG_STRIDE);
            float qv[16];
#pragma unroll
            for (int pp = 0; pp < 16; ++pp) qv[pp] = __uint_as_float((unsigned)qrow[p0 + 8 * ((pp & 7) >> 2) + 4 * (pp >> 3) + (pp & 3)] << 16) * eg;
            v4u o0, o1; o0.x = pkn(qv[0], qv[1]); o0.y = pkn(qv[2], qv[3]); o0.z = pkn(qv[4], qv[5]); o0.w = pkn(qv[6], qv[7]); o1.x = pkn(qv[8], qv[9]); o1.y = pkn(qv[10], qv[11]); o1.z = pkn(qv[12], qv[13]); o1.w = pkn(qv[14], qv[15]);
            v4u* qd = (v4u*)((bf16*)(F.ws + WS_QD) + (size_t)ch * 64 * 128 + c * 128 + p0); qd[0] = o0; qd[1] = o1;
        }
        LDS_WAIT(); __syncthreads();
        if (tid < 256) {
            const int col = tid & 127; const bool isw = tid >= 128;
            const LAS float* src = (isw ? KS : VS) + col;
            f32x2n xp[32];
#pragma unroll
            for (int k = 0; k < 32; ++k) { float v0 = src[(2 * k) * 128] * GC[64 + 2 * k], v1 = src[(2 * k + 1) * 128] * GC[64 + 2 * k + 1]; if (isw) { v0 *= GC[128 + 2 * k]; v1 *= GC[128 + 2 * k + 1]; } xp[k] = (f32x2n){v0, v1}; }
            f32x4 acur[8], anxt[8];
#pragma unroll
            for (int g = 0; g < 8; ++g) acur[g] = *(const LAS f32x4*)(AS + 4 * g);
#pragma unroll
            for (int k = 0; k < 94; ++k) {
                const int m = k < 62 ? (k >> 1) : k - 31, hf = k < 62 ? (k & 1) : 1;
                if (k + 1 < 94) { const int m2 = (k + 1) < 62 ? ((k + 1) >> 1) : (k + 1) - 31, hf2 = (k + 1) < 62 ? ((k + 1) & 1) : 1; const int g0 = ((m2 + 1) >> 2) > 8 * hf2 ? ((m2 + 1) >> 2) : 8 * hf2;
#pragma unroll
                    for (int g = g0; g < 8 * hf2 + 8; ++g) anxt[g - 8 * hf2] = *(const LAS f32x4*)(AS + m2 * 64 + 4 * g); }
                __builtin_amdgcn_sched_barrier(0);
                { const int p0 = ((m + 1) >> 1) > 16 * hf ? ((m + 1) >> 1) : 16 * hf;
#pragma unroll
                    for (int pr = p0; pr < 16 * hf + 16; ++pr) { const f32x4 a4 = acur[(pr >> 1) - 8 * hf]; const f32x2n a2 = (pr & 1) ? (f32x2n){a4[2], a4[3]} : (f32x2n){a4[0], a4[1]};
                        if (m & 1) asm("v_pk_fma_f32 %0, %1, %2, %0 op_sel:[0,1,0] op_sel_hi:[1,1,1] neg_lo:[1,0,0] neg_hi:[1,0,0]" : "+v"(xp[pr]) : "v"(a2), "v"(xp[m >> 1]));
                        else       asm("v_pk_fma_f32 %0, %1, %2, %0 op_sel:[0,0,0] op_sel_hi:[1,0,1] neg_lo:[1,0,0] neg_hi:[1,0,0]" : "+v"(xp[pr]) : "v"(a2), "v"(xp[m >> 1])); } }
#pragma unroll
                for (int g = 0; g < 8; ++g) acur[g] = anxt[g];
                __builtin_amdgcn_sched_barrier(0);
            }
            float x[64];
#pragma unroll
            for (int k = 0; k < 32; ++k) { x[2 * k] = xp[k][0]; x[2 * k + 1] = xp[k][1]; }
            if (!isw) { f32x4* up = (f32x4*)((float*)(F.ws + WS_UT) + (size_t)ch * 128 * 64 + col * 64);
#pragma unroll
                for (int c4 = 0; c4 < 16; ++c4) up[c4] = (f32x4){x[4 * c4], x[4 * c4 + 1], x[4 * c4 + 2], x[4 * c4 + 3]}; }
            else { LAS unsigned short* wi = (LAS unsigned short*)(IMG) + kpos(col);
#pragma unroll
                for (int c = 0; c < 64; ++c) wi[c * (WIMG_STRIDE / 2)] = (unsigned short)(pkn(-x[c], 0.f) & 0xffffu); }
        } else {
            const int t = tid - 256, d = t & 127, ph = t >> 7;
#pragma unroll
            for (int q8 = 0; q8 < 4; ++q8) { const int p0 = 32 * ph + 8 * q8; float kv[8];
#pragma unroll
                for (int jj = 0; jj < 8; ++jj) { const int c = (p0 & ~15) + 8 * (jj >> 2) + 4 * ((p0 >> 3) & 1) + (jj & 3); kv[jj] = KS[c * 128 + d] * GC[192 + c]; }
                v4u o; o.x = pkn(kv[0], kv[1]); o.y = pkn(kv[2], kv[3]); o.z = pkn(kv[4], kv[5]); o.w = pkn(kv[6], kv[7]);
                *(LAS v4u*)(IMG + KDIMG_OFF + d * KDIMG_STRIDE + 2 * p0) = o; }
            const LAS v4u* as = (const LAS v4u*)ATT + 2 * t; v4u* ag = (v4u*)((bf16*)(F.ws + WS_ATTN) + (size_t)ch * 4096) + 2 * t; ag[0] = as[0]; ag[1] = as[1];
        }
        LDS_WAIT(); __syncthreads();
        { v4u* rec = (v4u*)(F.ws + WS_REC + (size_t)ch * REC_BYTES);
            for (int i = tid; i < IMG_USED / 16; i += NTHREADS) rec[i] = *(const LAS v4u*)(IMG + 16 * i); }
        LDS_WAIT(); __syncthreads();
    }
}

__device__ __forceinline__ void gdn_scan_phase(Frame& F) {
    const int j = blockIdx.x; if (j >= 64) return;
    const int bh = j & 15, quarter = j >> 4;
    const int lane = F.lane, wave = F.wave, r = lane & 31, hh = lane >> 5;
    const unsigned char* REC = F.ws + WS_REC + (size_t)bh * 128 * REC_BYTES;
#define SCAN_BAR() do { asm volatile("s_waitcnt lgkmcnt(0)" ::: "memory"); __builtin_amdgcn_s_barrier(); asm volatile("" ::: "memory"); } while (0)
#define SCAN_DMA(n_) do { _Pragma("unroll") for (int k_ = 0; k_ < 6; ++k_) { const int piece_ = (wave - 1) + 6 * k_; \
        __builtin_amdgcn_global_load_lds((const unsigned*)(REC + (size_t)(n_) * REC_BYTES + piece_ * 1024 + lane * 16), (PG8_LAS unsigned*)(F.lds + ((n_) % 3) * REC_BYTES + piece_ * 1024), 16, 0, 0); } } while (0)
    if (wave == 7) { for (int n = 0; n < 129; ++n) SCAN_BAR(); }
    else if (wave >= 1) {
        SCAN_DMA(0); SCAN_DMA(1); VM_WAIT(); SCAN_BAR();
        for (int n = 0; n < 128; ++n) {
            if (n + 2 < 128) { SCAN_DMA(n + 2); asm volatile("s_waitcnt vmcnt(6)" ::: "memory"); }
            else VM_WAIT();
            SCAN_BAR();
        }
    } else {
        const int cw = quarter;
        const float* UT = (const float*)(F.ws + WS_UT) + (size_t)bh * 128 * (128 * 64) + (size_t)(32 * cw + r) * 64 + 4 * hh;
        v4u* SST = (v4u*)(F.ws + WS_SST) + (size_t)bh * 128 * (4 * 8 * 64) + (size_t)cw * (8 * 64) + lane;
        v4u* VST = (v4u*)(F.ws + WS_VST) + (size_t)bh * 128 * (4 * 4 * 64) + (size_t)cw * (4 * 64) + lane;
        const float* EGLp = (const float*)(F.ws + WS_EGL) + bh * 128;
        f32x16 S[4];
#pragma unroll
        for (int t = 0; t < 4; ++t)
#pragma unroll
            for (int i = 0; i < 16; ++i) S[t][i] = 0.f;
        SCAN_BAR();
        for (int n = 0; n < 128; ++n) {
            const LAS unsigned char* buf = F.lds + (n % 3) * REC_BYTES;
            f32x4 un[4]; f32x16 acc[2];
            { const float* up = UT + (size_t)n * (128 * 64);
#pragma unroll
                for (int q = 0; q < 4; ++q) un[q] = *(const f32x4*)(up + 8 * q);
#pragma unroll
                for (int q = 0; q < 4; ++q) { const f32x4 v = *(const f32x4*)(up + 32 + 8 * q); acc[1][4 * q] = v[0]; acc[1][4 * q + 1] = v[1]; acc[1][4 * q + 2] = v[2]; acc[1][4 * q + 3] = v[3]; } }
            const float egl = EGLp[n];
            __builtin_amdgcn_sched_barrier(0);
            bf16x8 Sb[8];
#pragma unroll
            for (int t = 0; t < 4; ++t) { Sb[2 * t] = pack_step(S[t], 0); Sb[2 * t + 1] = pack_step(S[t], 1); }
#pragma unroll
            for (int ks = 0; ks < 8; ++ks) SST[(size_t)n * (4 * 8 * 64) + ks * 64] = __builtin_bit_cast(v4u, Sb[ks]);
            __builtin_amdgcn_sched_barrier(0);
            const LAS unsigned char* wb = buf + r * WIMG_STRIDE + 16 * hh;
            const LAS unsigned char* kb = buf + KDIMG_OFF + r * KDIMG_STRIDE + 16 * hh;
#define SCAN_FRAG(i_) ((i_) < 16 ? *(const LAS bf16x8*)(wb + ((i_) >> 3) * 32 * WIMG_STRIDE + 32 * ((i_) & 7)) : *(const LAS bf16x8*)(kb + (((i_) - 16) & 3) * 32 * KDIMG_STRIDE + 32 * (((i_) - 16) >> 2)))
            bf16x8 ring[6];
#pragma unroll
            for (int i = 0; i < 6; ++i) ring[i] = SCAN_FRAG(i);
#pragma unroll
            for (int i = 0; i < 16; ++i) acc[0][i] = 0.f;
            __builtin_amdgcn_sched_barrier(0);
#pragma unroll
            for (int i = 0; i < 16; ++i) {
                acc[i >> 3] = __builtin_amdgcn_mfma_f32_32x32x16_bf16(ring[i % 6], Sb[i & 7], acc[i >> 3], 0, 0, 0);
                ring[i % 6] = SCAN_FRAG(i + 6);
                __builtin_amdgcn_sched_barrier(0);
            }
#pragma unroll
            for (int q = 0; q < 4; ++q) { acc[0][4 * q] += un[q][0]; acc[0][4 * q + 1] += un[q][1]; acc[0][4 * q + 2] += un[q][2]; acc[0][4 * q + 3] += un[q][3]; }
            bf16x8 Vb[4];
#pragma unroll
            for (int mt = 0; mt < 2; ++mt) { Vb[2 * mt] = pack_step(acc[mt], 0); Vb[2 * mt + 1] = pack_step(acc[mt], 1); }
#pragma unroll
            for (int ks = 0; ks < 4; ++ks) VST[(size_t)n * (4 * 4 * 64) + ks * 64] = __builtin_bit_cast(v4u, Vb[ks]);
#pragma unroll
            for (int t = 0; t < 4; ++t)
#pragma unroll
                for (int i = 0; i < 16; ++i) S[t][i] *= egl;
            __builtin_amdgcn_sched_barrier(0);
#pragma unroll
            for (int i = 16; i < 32; ++i) {
                S[(i - 16) & 3] = __builtin_amdgcn_mfma_f32_32x32x16_bf16(ring[i % 6], Vb[(i - 16) >> 2], S[(i - 16) & 3], 0, 0, 0);
                if (i + 6 < 32) ring[i % 6] = SCAN_FRAG(i + 6);
                __builtin_amdgcn_sched_barrier(0);
            }
#undef SCAN_FRAG
            SCAN_BAR();
        }
    }
#undef SCAN_DMA
#undef SCAN_BAR
    VM_WAIT(); __syncthreads();
}

__device__ __forceinline__ void gdn_out_phase(Frame& F, const float* out_norm  ) {
    const bf16* PROJ = (const bf16*)(F.ws + WS_PROJ); bf16* Y = (bf16*)(F.ws + WS_Y);
    const int lane = F.lane, r = lane & 31, hh = lane >> 5;
    LAS float* ot = (LAS float*)(F.lds + F.wave * 16384);
    float gain[8];
    { const f32x4 a = *(const f32x4*)(out_norm + 8 * (lane & 15)), b = *(const f32x4*)(out_norm + 8 * (lane & 15) + 4);
        gain[0] = a[0]; gain[1] = a[1]; gain[2] = a[2]; gain[3] = a[3]; gain[4] = b[0]; gain[5] = b[1]; gain[6] = b[2]; gain[7] = b[3]; }
    for (int wu = F.gw; wu < 4096; wu += F.NGW) {
        const int ch = wu >> 1, mt = wu & 1, n = ch & 127, bh = ch >> 7, b = bh >> 3, h = bh & 7, m0 = b * SEQ + n * 64 + 32 * mt;
        const bf16* qd = (const bf16*)(F.ws + WS_QD) + (size_t)ch * 64 * 128 + (32 * mt + r) * 128 + 8 * hh;
        const bf16* at = (const bf16*)(F.ws + WS_ATTN) + (size_t)ch * 4096 + (32 * mt + r) * 64 + 8 * hh;
        const v4u* sst = (const v4u*)(F.ws + WS_SST) + (size_t)ch * (4 * 8 * 64) + lane;
        const v4u* vst = (const v4u*)(F.ws + WS_VST) + (size_t)ch * (4 * 4 * 64) + lane;
        bf16x8 qa[8], aa[4];
#pragma unroll
        for (int ks = 0; ks < 8; ++ks) qa[ks] = __builtin_bit_cast(bf16x8, *(const v4u*)(qd + 16 * ks));
#pragma unroll
        for (int ks = 0; ks < 4; ++ks) aa[ks] = __builtin_bit_cast(bf16x8, *(const v4u*)(at + 16 * ks));
#pragma unroll
        for (int nt = 0; nt < 4; ++nt) {
            f32x16 acc;
#pragma unroll
            for (int i = 0; i < 16; ++i) acc[i] = 0.f;
#pragma unroll
            for (int ks = 0; ks < 8; ++ks) acc = __builtin_amdgcn_mfma_f32_32x32x16_bf16(qa[ks], __builtin_bit_cast(bf16x8, sst[nt * (8 * 64) + ks * 64]), acc, 0, 0, 0);
#pragma unroll
            for (int ks = 0; ks < 4; ++ks) acc = __builtin_amdgcn_mfma_f32_32x32x16_bf16(aa[ks], __builtin_bit_cast(bf16x8, vst[nt * (4 * 64) + ks * 64]), acc, 0, 0, 0);
#pragma unroll
            for (int i = 0; i < 16; ++i) ot[((i & 3) + 8 * (i >> 2) + 4 * hh) * 128 + 32 * nt + r] = acc[i];
        }
        LDS_WAIT();
#pragma unroll 2
        for (int k = 0; k < 8; ++k) {
            const int row = 4 * k + (lane >> 4), chunk = lane & 15;
            const f32x4 o0 = *(const LAS f32x4*)(ot + row * 128 + 8 * chunk), o1 = *(const LAS f32x4*)(ot + row * 128 + 8 * chunk + 4);
            float zz[8]; unpack8(*(const v4u*)(PROJ + (size_t)(m0 + row) * NMIX + PC_Z + h * GD + 8 * chunk), zz);
            float ss = (o0[0] * o0[0] + o0[1] * o0[1]) + (o0[2] * o0[2] + o0[3] * o0[3]) + (o1[0] * o1[0] + o1[1] * o1[1]) + (o1[2] * o1[2] + o1[3] * o1[3]);
            ss += __shfl_xor(ss, 1); ss += __shfl_xor(ss, 2); ss += __shfl_xor(ss, 4); ss += __shfl_xor(ss, 8);
            const float rstd = 1.0f / sqrtf(ss * (1.0f / GD) + EPS);
            float y[8];
#pragma unroll
            for (int e = 0; e < 4; ++e) { y[e] = o0[e] * rstd * gain[e] * silu_f(zz[e]); y[4 + e] = o1[e] * rstd * gain[4 + e] * silu_f(zz[4 + e]); }
            v4u w; w.x = pkn(y[0], y[1]); w.y = pkn(y[2], y[3]); w.z = pkn(y[4], y[5]); w.w = pkn(y[6], y[7]);
            *(v4u*)(Y + (size_t)(m0 + row) * D + h * GD + 8 * chunk) = w;
        }
        LDS_WAIT();
    }
}

#ifndef GDN_REF
#define GDN_REF 0
#endif
#ifndef REPMASK
#define REPMASK 0u
#endif
__device__ __forceinline__ int nrep_opaque(int n) { asm volatile("" : "+s"(n)); return n; }
#define NREP(k) (((((REPMASK) >> (k)) & 1)) ? nrep_opaque(2) : 1)
#ifndef PHMASK
#define PHMASK 0xFFFFFFFFu
#endif
struct Args { const float* in[21]; float* out; unsigned char* ws; int pro_lo, pro_hi, l_lo, l_hi, ph_lo, ph_hi, one, fin; };
enum { PH_MIXIN = 3, PH_GDNPRE, PH_GDNSCAN, PH_OUTGATE, PH_MIXOUT, PH_SCORES, PH_ATTOUT, PH_UP, PH_SWIGLU, PH_DOWN, PH_END };

typedef const __attribute__((address_space(4))) Args* KArgP;
__device__ __forceinline__ KArgP kargs() { KArgP ap = (KArgP)__builtin_amdgcn_kernarg_segment_ptr(); asm volatile("" : "+s"(ap)); return ap; }
__device__ __forceinline__ Frame mkframe(KArgP ap, LAS unsigned char* lds) {
    Frame F; int t = threadIdx.x; asm volatile("" : "+v"(t));
    F.lds = lds; F.tid = t; F.lane = t & 63; F.wave = __builtin_amdgcn_readfirstlane(t >> 6);
    F.G = gridDim.x; F.gw = blockIdx.x * NWAVES + F.wave; F.NGW = F.G * NWAVES; F.ws = ap->ws;
    return F;
}
__global__ void __launch_bounds__(NTHREADS, 2) trunk_fwd(Args args) {
    extern __shared__ __attribute__((aligned(16))) unsigned char lds_raw[];
    LAS unsigned char* const lds = (LAS unsigned char*)lds_raw;
    for (int u = threadIdx.x; u < (LDS_BYTES - LDSCTL_OFF) / 4; u += NTHREADS) ((LAS unsigned*)(lds + LDSCTL_OFF))[u] = 0u;
    __syncthreads();
    XcdBarrier bar; bar.bar = (unsigned*)(args.ws + WS_CTL) + CW_BAR; bar.x = 0; bar.st = nullptr;
    const bool one = args.one != 0;
    if (one) bar = xcd_barrier_post((unsigned*)(args.ws + WS_CTL) + CW_BAR, (volatile LAS unsigned*)(lds + MISC_OFF) + 8);
#define SEAM() do { if (one) xcd_barrier(bar); } while (0)
#define PHASE_BEGIN() KArgP ap = kargs(); Frame F = mkframe(ap, lds); PG8_LAS unsigned char* ring = (PG8_LAS unsigned char*)(lds + RING_OFF); (void)ring; float* const XR = ap->out; (void)XR; \
    bf16* const HA = (bf16*)(F.ws + WS_H); (void)HA; bf16* const HB = (bf16*)(F.ws + WS_HB); (void)HB; float* const SSQ = (float*)(F.ws + WS_SSQ); (void)SSQ
#define PRO(k) ((((PHMASK) >> (k)) & 1) && args.pro_lo <= (k) && (k) < args.pro_hi)

    if (PRO(0)) {
        PHASE_BEGIN();
        for (int rep = 0; rep < NREP(0); ++rep) { if (rep) SEAM();
        p0_weights_x(F, ap->in[IN_W_XQ], ap->in[IN_W_XK], ap->in[IN_W_XV], ap->in[IN_W_XO]);
        p0_weights_main(F, 0, F.gw, F.NGW, ap->in[IN_W_MIX_IN], ap->in[IN_W_MIX_OUT], ap->in[IN_W_UP], ap->in[IN_W_DOWN]);
        p0_memn(F, ap->in[IN_MEM], ap->in[IN_MEM_NORM]);
        prenorm_phase(F, ap->in[IN_X], ap->in[IN_MIX_NORM], HB, SSQ); }
        SEAM();
    }
    if (PRO(1)) {
        PHASE_BEGIN();
        KvOrder S{F.G, (int)blockIdx.x, (const bf16*)(F.ws + WS_MEMN), (const bf16*)(F.ws + WS_WXK), (const bf16*)(F.ws + WS_WXV)};
        pg8::Gemm g{nullptr, nullptr, D, D, D};
        pg8::EpiBf16<LocKv, false> E{LocKv{(bf16*)(F.ws + WS_KX), (bf16*)(F.ws + WS_VX)}, 1.0f, nullptr};
        pg8::gemm_phase<pg8::EpiBf16<LocKv, false>, KvOrder, true>(ring, g, S, E);
        SEAM();
    }
    if (PRO(2)) {
        PHASE_BEGIN();
        PreOrder S{F.G, (int)blockIdx.x, (const bf16*)(F.ws + WS_KX), (const bf16*)(F.ws + WS_VX), (const bf16*)(F.ws + WS_WXQ), (const bf16*)(F.ws + WS_WXO)};
        pg8::Gemm g{nullptr, nullptr, D, D, XD};
        pg8::EpiBf16<LocPre, false> E{LocPre{(bf16*)(F.ws + WS_WQK), (bf16*)(F.ws + WS_VWO)}, 1.0f, nullptr};
        pg8::gemm_phase<pg8::EpiBf16<LocPre, false>, PreOrder, true>(ring, g, S, E);
        SEAM();
    }
    const int lo = args.ph_lo, hi = args.ph_hi;
#define IN(k) ((((PHMASK) >> (k)) & 1) && lo <= (k) && (k) < hi)
    for (int l = args.l_lo; l < args.l_hi; ++l) {
        if (IN(PH_MIXIN)) {
            PHASE_BEGIN();
            ba_phase(F, HB, SSQ + (size_t)(3 * l) * M, (const bf16*)(F.ws + WS_WBA) + (size_t)l * 16 * D, ap->in[IN_A_LOG] + l * GH, ap->in[IN_DT_BIAS] + l * GH);
            pg8::Gemm g{HB, (const bf16*)(F.ws + WS_WMIX) + (size_t)l * NMIX * D, D, D, D}; pg8::StaticOrder S; S.init(M, NMIX, F.G, (int)blockIdx.x);
            pg8::EpiBf16<pg8::LocPlain, true> E{pg8::LocPlain{(bf16*)(F.ws + WS_PROJ), NMIX}, 1.0f, SSQ + (size_t)(3 * l) * M};
            for (int rep = 0; rep < NREP(3); ++rep) { if (rep) SEAM();
            pg8::gemm_phase<pg8::EpiBf16<pg8::LocPlain, true>, pg8::StaticOrder, true>(ring, g, S, E); }
            SEAM();
        }
        if (IN(PH_GDNPRE)) { PHASE_BEGIN(); for (int rep = 0; rep < NREP(4); ++rep) { if (rep) SEAM(); gdn_prep_phase(F, ap->in[IN_GDN_CONV] + (size_t)l * 4 * 3 * GW); } SEAM(); }
        if (IN(PH_GDNSCAN)) {
            PHASE_BEGIN();
            if (blockIdx.x < 64 || F.G <= 64) { for (int rep = 0; rep < NREP(5); ++rep) { if (rep) SEAM(); gdn_scan_phase(F); } }
            if (F.G <= 64) shortconv_phase(F, ap->in[IN_SC_CONV] + (size_t)l * 3 * SCW, F.gw, F.NGW);
            else if (blockIdx.x >= 64) shortconv_phase(F, ap->in[IN_SC_CONV] + (size_t)l * 3 * SCW, F.gw - 64 * NWAVES, F.NGW - 64 * NWAVES);
            if (l + 1 < DEPTH) { if (F.G <= 64) p0_weights_main(F, l + 1, F.gw, F.NGW, ap->in[IN_W_MIX_IN], ap->in[IN_W_MIX_OUT], ap->in[IN_W_UP], ap->in[IN_W_DOWN]);
                else if (blockIdx.x >= 64) p0_weights_main(F, l + 1, F.gw - 64 * NWAVES, F.NGW - 64 * NWAVES, ap->in[IN_W_MIX_IN], ap->in[IN_W_MIX_OUT], ap->in[IN_W_UP], ap->in[IN_W_DOWN]); }
            SEAM(); }
        if (IN(PH_OUTGATE)) { PHASE_BEGIN(); for (int rep = 0; rep < NREP(6); ++rep) { if (rep) SEAM(); gdn_out_phase(F, ap->in[IN_OUT_NORM] + (size_t)l * GD); } SEAM(); }
        if (IN(PH_MIXOUT)) {
            PHASE_BEGIN();
            pg8::Gemm g{(const bf16*)(F.ws + WS_Y), (const bf16*)(F.ws + WS_WOUT) + (size_t)l * D * D, D, D, D}; pg8::StaticOrder S; S.init(M, D, F.G, (int)blockIdx.x);
            pg8::EpiResNorm E{l == 0 ? ap->in[IN_X] : XR, XR, D, HA, ap->in[IN_XATTN_NORM] + (size_t)l * D, SSQ + (size_t)(3 * l + 1) * M};
            if (NREP(7) > 1) { pg8::EpiResNorm E0 = E; E0.out = (float*)(F.ws + WS_BIG); E0.hn = (pg8::bf16_t*)(F.ws + WS_BIG + 160 * MiB); E0.ssq = (float*)(F.ws + WS_BIG + 256 * MiB);
            pg8::gemm_phase<pg8::EpiResNorm, pg8::StaticOrder, true>(ring, g, S, E0); SEAM(); }
            pg8::gemm_phase<pg8::EpiResNorm, pg8::StaticOrder, true>(ring, g, S, E);
            SEAM();
        }
        if (IN(PH_SCORES)) {
            PHASE_BEGIN();
            pg8::Gemm g{HA, (const bf16*)(F.ws + WS_WQK) + (size_t)l * 2 * (XH * NMEM) * D, D, D, D}; SOrder S{F.G, (int)blockIdx.x};
            pg8::EpiSoftmax E{(bf16*)(F.ws + WS_PB), XH * NMEM, 0.044194173824159216f * 1.4426950408889634f, SSQ + (size_t)(3 * l + 1) * M};
            for (int rep = 0; rep < NREP(8); ++rep) { if (rep) SEAM();
            pg8::gemm_phase<pg8::EpiSoftmax, SOrder, false>(ring, g, S, E); }
            SEAM();
        }
        if (IN(PH_ATTOUT)) {
            PHASE_BEGIN();
            pg8::Gemm g{(const bf16*)(F.ws + WS_PB), (const bf16*)(F.ws + WS_VWO) + (size_t)l * 2 * D * (XH * NMEM), XH * NMEM, XH * NMEM, XH * NMEM};
            BatchOrder S; S.init(M, D, F.G, (int)blockIdx.x); S.bstride = (size_t)D * (XH * NMEM);
            pg8::EpiResNorm E{XR, XR, D, HA, ap->in[IN_FFN_NORM] + (size_t)l * D, SSQ + (size_t)(3 * l + 2) * M};
            if (NREP(9) > 1) { pg8::EpiResNorm E0 = E; E0.out = (float*)(F.ws + WS_BIG); E0.hn = (pg8::bf16_t*)(F.ws + WS_BIG + 160 * MiB); E0.ssq = (float*)(F.ws + WS_BIG + 256 * MiB);
            pg8::gemm_phase<pg8::EpiResNorm, BatchOrder, true>(ring, g, S, E0); SEAM(); }
            pg8::gemm_phase<pg8::EpiResNorm, BatchOrder, true>(ring, g, S, E);
            SEAM();
        }
        if (IN(PH_UP)) {
            PHASE_BEGIN();
            pg8::Gemm g{HA, (const bf16*)(F.ws + WS_WUP) + (size_t)l * 2 * DFF * D, D, D, D}; pg8::StaticOrder S; S.init(M, 2 * DFF, F.G, (int)blockIdx.x);
            pg8::EpiSwiglu E{(bf16*)(F.ws + WS_ACT), (float*)(F.ws + WS_PART), (float*)(F.ws + WS_HALO), ap->in[IN_FFN_CONV] + (size_t)l * 3 * 2 * DFF, SSQ + (size_t)(3 * l + 2) * M, (PG8_LAS float*)(lds + XB_OFF), DFF};
            pg8::gemm_phase<pg8::EpiSwiglu, pg8::StaticOrder, true>(ring, g, S, E);
            SEAM();
        }
        if (IN(PH_SWIGLU)) { PHASE_BEGIN(); swiglu_fix_phase(F, ap->in[IN_FFN_CONV] + (size_t)l * 3 * 2 * DFF); SEAM(); }
        if (IN(PH_DOWN)) {
            PHASE_BEGIN();
            pg8::Gemm g{(const bf16*)(F.ws + WS_ACT), (const bf16*)(F.ws + WS_WDN) + (size_t)l * D * DFF, DFF, DFF, DFF}; pg8::StaticOrder S; S.init(M, D, F.G, (int)blockIdx.x);
            const bool last = l + 1 >= DEPTH;
            pg8::EpiResNorm E{XR, XR, D, last ? nullptr : HB, ap->in[IN_MIX_NORM] + (size_t)(last ? l : l + 1) * D, SSQ + (size_t)(last ? 0 : 3 * (l + 1)) * M};
            if (NREP(12) > 1) { pg8::EpiResNorm E0 = E; E0.out = (float*)(F.ws + WS_BIG); E0.hn = (pg8::bf16_t*)(F.ws + WS_BIG + 160 * MiB); E0.ssq = (float*)(F.ws + WS_BIG + 256 * MiB);
            pg8::gemm_phase<pg8::EpiResNorm, pg8::StaticOrder, true>(ring, g, S, E0); SEAM(); }
            pg8::gemm_phase<pg8::EpiResNorm, pg8::StaticOrder, true>(ring, g, S, E);
            SEAM();
        }
    }
    if ((((PHMASK) >> 30) & 1) && args.fin) { PHASE_BEGIN(); final_norm_phase(F, XR, ap->in[IN_FINAL_NORM], ap->out); }
#undef IN
#undef PRO
#undef SEAM
#undef PHASE_BEGIN
}

extern "C" void kernel_launch(void* const* d_in, const int* in_sizes, int n_in, void* d_out, int out_size, void* d_ws, size_t ws_size, hipStream_t stream) {
    static int grid = 0;
    if (grid == 0) {
        if (n_in != 21 || in_sizes[0] != M * D || out_size != M * D || ws_size < WS_END) { fprintf(stderr, "kernel_launch: unexpected shapes / workspace (n_in %d, in0 %d, out %d, ws %zu < %zu); nothing launched\n", n_in, n_in > 0 ? in_sizes[0] : -1, out_size, ws_size, (size_t)WS_END); grid = -1; return; }
        int dev = 0, cus = 0, per_cu = 0;
        if (hipGetDevice(&dev) != hipSuccess || hipDeviceGetAttribute(&cus, hipDeviceAttributeMultiprocessorCount, dev) != hipSuccess) { fprintf(stderr, "kernel_launch: device query failed\n"); grid = -1; return; }
        if (hipFuncSetAttribute((const void*)trunk_fwd, hipFuncAttributeMaxDynamicSharedMemorySize, LDS_BYTES) != hipSuccess) { fprintf(stderr, "kernel_launch: hipFuncSetAttribute failed\n"); grid = -1; return; }
        if (hipOccupancyMaxActiveBlocksPerMultiprocessor(&per_cu, (const void*)trunk_fwd, NTHREADS, LDS_BYTES) != hipSuccess || per_cu < 1)
            fprintf(stderr, "kernel_launch: note: occupancy query reports %d workgroups per CU\n", per_cu);
        (void)hipGetLastError();
        if (cus != 256) { fprintf(stderr, "kernel_launch: built for 256 CUs, device has %d; nothing launched\n", cus); grid = -1; return; }
        grid = cus;
    }
    if (grid < 0) return;
    if (hipMemsetAsync((char*)d_ws + WS_CTL, 0, CTL_ZERO_BYTES, stream) != hipSuccess) { fprintf(stderr, "kernel_launch: memset failed\n"); return; }
    Args a{};
    for (int i = 0; i < 21; ++i) a.in[i] = (const float*)d_in[i];
    a.out = (float*)d_out; a.ws = (unsigned char*)d_ws;
#if MK_ONE_LAUNCH
    a.pro_lo = 0; a.pro_hi = 3; a.l_lo = 0; a.l_hi = DEPTH; a.ph_lo = PH_MIXIN; a.ph_hi = PH_END; a.one = 1; a.fin = 1;
    hipLaunchKernelGGL(trunk_fwd, dim3(grid), dim3(NTHREADS), LDS_BYTES, stream, a);
#else
    a.one = 0; a.fin = 0; a.l_lo = 0; a.l_hi = 0; a.ph_lo = 0; a.ph_hi = 0;
    for (int p = 0; p < 3; ++p) { a.pro_lo = p; a.pro_hi = p + 1; hipLaunchKernelGGL(trunk_fwd, dim3(grid), dim3(NTHREADS), LDS_BYTES, stream, a); }
    a.pro_lo = 0; a.pro_hi = 0;
    for (int l = 0; l < DEPTH; ++l)
        for (int p = PH_MIXIN; p < PH_END; ++p) { a.l_lo = l; a.l_hi = l + 1; a.ph_lo = p; a.ph_hi = p + 1;
            hipLaunchKernelGGL(trunk_fwd, dim3(grid), dim3(NTHREADS), LDS_BYTES, stream, a); }
    a.l_lo = 0; a.l_hi = 0; a.fin = 1;
    hipLaunchKernelGGL(trunk_fwd, dim3(grid), dim3(NTHREADS), LDS_BYTES, stream, a);
#endif
    const hipError_t le = hipPeekAtLastError();
    if (le != hipSuccess) fprintf(stderr, "kernel_launch: launch failed: %s\n", hipGetErrorName(le));
}
```

```cpp
#define MK_ONE_LAUNCH 1
#include <hip/hip_runtime.h>
#include <cstdio>
#include <cstdint>

#ifndef MK_ONE_LAUNCH
#define MK_ONE_LAUNCH 1
#endif

namespace pg8 {
#define PG8_LAS __attribute__((address_space(3)))
typedef unsigned short bf16_t;
typedef short bf16x8 __attribute__((ext_vector_type(8)));
typedef float f32x4 __attribute__((ext_vector_type(4)));
typedef float f32x2 __attribute__((ext_vector_type(2)));
typedef unsigned u32x4 __attribute__((ext_vector_type(4)));
constexpr int BM = 256, BK = 64, HALF = 128, HTB = HALF * BK * 2  , STAGE_BYTES = 8 * HTB, NXCD = 8, WGM = 8;

__host__ __device__ __forceinline__ int lds_byte(int r, int c) { const int st = (r >> 4) * 2 + (c >> 5), rr = r & 15, cc = c & 31, ob = rr * 64 + cc * 2; return st * 1024 + (ob ^ (((ob >> 9) & 1) << 5)); }
__host__ __device__ __forceinline__ void stage_rc(int b, int& R, int& C) { const int st = b / 1024, sb = b % 1024, swz = sb ^ (((sb >> 9) & 1) << 5); R = (st >> 1) * 16 + swz / 64; C = (st & 1) * 32 + (swz % 64) / 2; }
__host__ __device__ __forceinline__ int perm32(int rho) { const int n = rho >> 4, i = rho & 15; return 8 * (i >> 2) + 4 * n + (i & 3); }

struct Unit { int pm, pn; };
struct Gemm { const bf16_t* A; const bf16_t* Bt; int lda, ldb, K; };

struct StaticOrder {
    int nM, nN, nwg, G, c;
    __host__ __device__ void init(int M, int N, int G_, int c_) { nM = M / BM; nN = N / BM; nwg = nM * nN; G = G_; c = c_; }
    __host__ __device__ bool next(int i, Unit& u) const {
        const long L = (long)i * G + c; if (L >= nwg) return false;
        int wgid = (int)L; { const int q = nwg / NXCD, r = nwg % NXCD, xcd = wgid % NXCD, off = wgid / NXCD; wgid = (xcd < r ? xcd * (q + 1) : r * (q + 1) + (xcd - r) * q) + off; }
        const int nig = WGM * nN, gid = wgid / nig, fm = gid * WGM, gsz = (nM - fm) < WGM ? (nM - fm) : WGM;
        u.pm = fm + ((wgid % nig) % gsz); u.pn = (wgid % nig) / gsz; return true;
    }
    __device__ __forceinline__ const char* pa(const Gemm& g, const Unit& u) const { return (const char*)g.A + (size_t)u.pm * BM * g.lda * 2; }
    __device__ __forceinline__ const char* pb(const Gemm& g, const Unit& u) const { return (const char*)g.Bt + (size_t)u.pn * BM * g.ldb * 2; }
};

__device__ __forceinline__ unsigned cvt_pk_bf16(float lo, float hi) { unsigned r; asm volatile("v_cvt_pk_bf16_f32 %0, %1, %2" : "=v"(r) : "v"(lo), "v"(hi)); return r; }


template <class Loc, bool RS  > struct EpiBf16 {
    static constexpr bool PERM = true, AFTER_DRAIN = false;
    Loc loc; float scale; const float* ssq;
    __device__ __forceinline__ void operator()(const f32x4 (&acc)[2][2][4][2], const Unit& u, int wr, int wc, int fr, int fq) const {
        bf16_t* base; int ldc; loc(u, base, ldc);
        const int row0 = wr * 64 + fr, col0 = wc * 32 + 8 * fq;
        float sc[2][4];
#pragma unroll
        for (int ai = 0; ai < 2; ++ai)
#pragma unroll
            for (int m = 0; m < 4; ++m) sc[ai][m] = RS ? ssq[u.pm * BM + row0 + ai * HALF + m * 16] : 0.f;
#pragma unroll
        for (int ai = 0; ai < 2; ++ai)
#pragma unroll
            for (int m = 0; m < 4; ++m) sc[ai][m] = RS ? this->scale * (1.0f / sqrtf(sc[ai][m] * (1.0f / 2048.0f) + 1e-6f)) : this->scale;
#pragma unroll
        for (int ai = 0; ai < 2; ++ai)
#pragma unroll
            for (int m = 0; m < 4; ++m) { bf16_t* rowp = base + (size_t)(row0 + ai * HALF + m * 16) * ldc + col0;
                const float scale = sc[ai][m];
#pragma unroll
                for (int bj = 0; bj < 2; ++bj) { f32x4 v0 = acc[ai][bj][m][0] * scale, v1 = acc[ai][bj][m][1] * scale;
                    u32x4 w; w.x = cvt_pk_bf16(v0[0], v0[1]); w.y = cvt_pk_bf16(v0[2], v0[3]); w.z = cvt_pk_bf16(v1[0], v1[1]); w.w = cvt_pk_bf16(v1[2], v1[3]);
                    *(u32x4*)(rowp + bj * HALF) = w; } }
    }
};
struct EpiNull { static constexpr bool PERM = true, AFTER_DRAIN = false;
    __device__ __forceinline__ void operator()(const f32x4 (&acc)[2][2][4][2], const Unit&, int, int, int, int) const {
#pragma unroll
        for (int ai = 0; ai < 2; ++ai)
#pragma unroll
            for (int bj = 0; bj < 2; ++bj)
#pragma unroll
                for (int m = 0; m < 4; ++m)
#pragma unroll
                    for (int n = 0; n < 2; ++n) asm volatile("" :: "v"(acc[ai][bj][m][n])); } };
struct LocPlain { bf16_t* O; int ldc; __device__ __forceinline__ void operator()(const Unit& u, bf16_t*& base, int& ld) const { base = O + (size_t)u.pm * BM * ldc + (size_t)u.pn * BM; ld = ldc; } };

struct EpiResNorm {
    static constexpr bool PERM = true, AFTER_DRAIN = false;
    const float* res; float* out; int ldc; bf16_t* hn; const float* gain; float* ssq;
    __device__ __forceinline__ void operator()(const f32x4 (&acc)[2][2][4][2], const Unit& u, int wr, int wc, int fr, int fq) const {
        const int row0 = u.pm * BM + wr * 64 + fr, col0 = u.pn * BM + wc * 32 + 8 * fq;
        f32x4 g4[2][2];
        if (hn) {
#pragma unroll
            for (int bj = 0; bj < 2; ++bj)
#pragma unroll
                for (int n = 0; n < 2; ++n) g4[bj][n] = *(const f32x4*)(gain + col0 + bj * HALF + 4 * n); }
        f32x4 cur[2][2], nxt[2][2];
#pragma unroll
        for (int bj = 0; bj < 2; ++bj)
#pragma unroll
            for (int n = 0; n < 2; ++n) cur[bj][n] = *(const f32x4*)(res + (size_t)row0 * ldc + col0 + bj * HALF + 4 * n);
#pragma unroll
        for (int it = 0; it < 8; ++it) { const int ai = it >> 2, m = it & 3; const int row = row0 + ai * HALF + m * 16; const size_t off = (size_t)row * ldc + col0;
            if (it < 7) { const size_t off2 = (size_t)(row0 + ((it + 1) >> 2) * HALF + ((it + 1) & 3) * 16) * ldc + col0;
#pragma unroll
                for (int bj = 0; bj < 2; ++bj)
#pragma unroll
                    for (int n = 0; n < 2; ++n) nxt[bj][n] = *(const f32x4*)(res + off2 + bj * HALF + 4 * n); }
            __builtin_amdgcn_sched_barrier(0);
            f32x4 x[2][2]; float ss = 0.f;
#pragma unroll
            for (int bj = 0; bj < 2; ++bj)
#pragma unroll
                for (int n = 0; n < 2; ++n) { x[bj][n] = cur[bj][n] + acc[ai][bj][m][n]; *(f32x4*)(out + off + bj * HALF + 4 * n) = x[bj][n];
                    ss += (x[bj][n][0] * x[bj][n][0] + x[bj][n][1] * x[bj][n][1]) + (x[bj][n][2] * x[bj][n][2] + x[bj][n][3] * x[bj][n][3]); }
            if (hn) {
#pragma unroll
                for (int bj = 0; bj < 2; ++bj) { const f32x4 v0 = x[bj][0] * g4[bj][0], v1 = x[bj][1] * g4[bj][1];
                    u32x4 w; w.x = cvt_pk_bf16(v0[0], v0[1]); w.y = cvt_pk_bf16(v0[2], v0[3]); w.z = cvt_pk_bf16(v1[0], v1[1]); w.w = cvt_pk_bf16(v1[2], v1[3]);
                    *(u32x4*)(hn + off + bj * HALF) = w; }
                ss += __shfl_xor(ss, 16); ss += __shfl_xor(ss, 32);
                if (fq == 0) atomicAdd(ssq + row, ss);
            }
#pragma unroll
            for (int bj = 0; bj < 2; ++bj)
#pragma unroll
                for (int n = 0; n < 2; ++n) cur[bj][n] = nxt[bj][n];
            __builtin_amdgcn_sched_barrier(0);
        }
    }
};

struct EpiSoftmax {
    static constexpr bool PERM = true, AFTER_DRAIN = true;
    bf16_t* P; int ldc; float sl2e; const float* ssq;
    __device__ __forceinline__ void fused(f32x4 (&acc)[2][2][4][2], const Unit& u, int wr, int wc, int fr, int fq, PG8_LAS unsigned char* lds, int wid, int lane) const {
        PG8_LAS float* Pm = (PG8_LAS float*)lds;
        PG8_LAS float* Ps = (PG8_LAS float*)(lds + 4096);
        float rs[2][4];
#pragma unroll
        for (int ai = 0; ai < 2; ++ai)
#pragma unroll
            for (int m = 0; m < 4; ++m) rs[ai][m] = ssq[u.pm * BM + ai * HALF + wr * 64 + m * 16 + fr];
#pragma unroll
        for (int ai = 0; ai < 2; ++ai)
#pragma unroll
            for (int m = 0; m < 4; ++m) {
                float mx = -3.0e38f;
#pragma unroll
                for (int bj = 0; bj < 2; ++bj)
#pragma unroll
                    for (int n = 0; n < 2; ++n) { const f32x4 x = acc[ai][bj][m][n]; mx = fmaxf(mx, fmaxf(fmaxf(x[0], x[1]), fmaxf(x[2], x[3]))); }
                mx = fmaxf(mx, __shfl_xor(mx, 16)); mx = fmaxf(mx, __shfl_xor(mx, 32));
                if (fq == 0) Pm[(ai * HALF + wr * 64 + m * 16 + fr) * 4 + wc] = mx;
            }
        asm volatile("s_waitcnt lgkmcnt(0)" ::: "memory"); __builtin_amdgcn_s_barrier(); asm volatile("" ::: "memory");
#pragma unroll
        for (int ai = 0; ai < 2; ++ai)
#pragma unroll
            for (int m = 0; m < 4; ++m) {
                const int row = ai * HALF + wr * 64 + m * 16 + fr;
                const f32x4 pm4 = *(const PG8_LAS f32x4*)(Pm + row * 4);
                const float gm = fmaxf(fmaxf(pm4[0], pm4[1]), fmaxf(pm4[2], pm4[3]));
                const float sl2e = this->sl2e * (1.0f / sqrtf(rs[ai][m] * (1.0f / 2048.0f) + 1e-6f));
                float s = 0.f;
#pragma unroll
                for (int bj = 0; bj < 2; ++bj)
#pragma unroll
                    for (int n = 0; n < 2; ++n) { f32x4 x = acc[ai][bj][m][n];
#pragma unroll
                        for (int j = 0; j < 4; ++j) { x[j] = __builtin_amdgcn_exp2f((x[j] - gm) * sl2e); s += x[j]; }
                        acc[ai][bj][m][n] = x; }
                s += __shfl_xor(s, 16); s += __shfl_xor(s, 32);
                if (fq == 0) Ps[row * 4 + wc] = s;
            }
        asm volatile("s_waitcnt lgkmcnt(0)" ::: "memory"); __builtin_amdgcn_s_barrier(); asm volatile("" ::: "memory");
        bf16_t* base = P + (size_t)u.pm * BM * ldc + (size_t)u.pn * BM;
#pragma unroll
        for (int ai = 0; ai < 2; ++ai)
#pragma unroll
            for (int m = 0; m < 4; ++m) {
                const int row = ai * HALF + wr * 64 + m * 16 + fr;
                const f32x4 ps4 = *(const PG8_LAS f32x4*)(Ps + row * 4);
                const float inv = 1.0f / ((ps4[0] + ps4[1]) + (ps4[2] + ps4[3]));
                bf16_t* rowp = base + (size_t)row * ldc + wc * 32 + 8 * fq;
#pragma unroll
                for (int bj = 0; bj < 2; ++bj) { const f32x4 v0 = acc[ai][bj][m][0] * inv, v1 = acc[ai][bj][m][1] * inv;
                    u32x4 w; w.x = cvt_pk_bf16(v0[0], v0[1]); w.y = cvt_pk_bf16(v0[2], v0[3]); w.z = cvt_pk_bf16(v1[0], v1[1]); w.w = cvt_pk_bf16(v1[2], v1[3]);
                    *(u32x4*)(rowp + bj * HALF) = w; }
            }
    }
};

__device__ __forceinline__ float dpp_ror1(float v) { return __builtin_bit_cast(float, __builtin_amdgcn_update_dpp(0, __builtin_bit_cast(int, v), 0x121, 0xf, 0xf, false)); }
__device__ __forceinline__ float dpp_ror2(float v) { return __builtin_bit_cast(float, __builtin_amdgcn_update_dpp(0, __builtin_bit_cast(int, v), 0x122, 0xf, 0xf, false)); }
struct EpiSwiglu {
    static constexpr bool PERM = true, AFTER_DRAIN = false;
    bf16_t* act; float* part; float* halo; const float* cw; const float* ssq; PG8_LAS float* xb; int dff;
    __device__ __forceinline__ void operator()(f32x4 (&acc)[2][2][4][2], const Unit& u, int wr, int wc, int fr, int fq) const {
        const int ccol = wc * 32 + 8 * fq;
#pragma unroll
        for (int ai = 0; ai < 2; ++ai)
#pragma unroll
            for (int m = 0; m < 4; ++m) { const float sc = 1.0f / sqrtf(ssq[u.pm * BM + ai * HALF + wr * 64 + m * 16 + fr] * (1.0f / 2048.0f) + 1e-6f);
#pragma unroll
                for (int bj = 0; bj < 2; ++bj)
#pragma unroll
                    for (int n = 0; n < 2; ++n) acc[ai][bj][m][n] = acc[ai][bj][m][n] * sc; }
        if (fr >= 14) {
#pragma unroll
            for (int ai = 0; ai < 2; ++ai)
#pragma unroll
                for (int bj = 0; bj < 2; ++bj)
#pragma unroll
                    for (int n = 0; n < 2; ++n) { *(PG8_LAS f32x4*)(xb + ((wr * 2 + ai) * 2 + (fr - 14)) * 256 + bj * HALF + ccol + 4 * n) = acc[ai][bj][3][n];
                        if (wr == 1 && ai == 1) *(f32x4*)(halo + ((size_t)(u.pm * 2 + (fr - 14)) * 2 + bj) * dff + u.pn * HALF + ccol + 4 * n) = acc[1][bj][3][n]; }
        }
        asm volatile("s_waitcnt lgkmcnt(0)" ::: "memory"); __builtin_amdgcn_s_barrier(); asm volatile("" ::: "memory");
#pragma unroll
        for (int n = 0; n < 2; ++n) {
            const int ch = u.pn * HALF + ccol + 4 * n;
            f32x4 wg[3], wu[3];
#pragma unroll
            for (int t = 0; t < 3; ++t) { wg[t] = *(const f32x4*)(cw + (size_t)t * 2 * dff + ch); wu[t] = *(const f32x4*)(cw + (size_t)t * 2 * dff + dff + ch); }
#pragma unroll
            for (int ai = 0; ai < 2; ++ai) {
                f32x4 c1g = {0.f, 0.f, 0.f, 0.f}, c2g = c1g, c1u = c1g, c2u = c1g;
                if (ai + wr > 0) { const int sw = wr ^ 1, sa = wr == 0 ? ai - 1 : ai; const PG8_LAS float* xp = xb + ((sw * 2 + sa) * 2) * 256 + ccol + 4 * n;
                    const f32x4 e0g = *(const PG8_LAS f32x4*)(xp), e1g = *(const PG8_LAS f32x4*)(xp + 256), e0u = *(const PG8_LAS f32x4*)(xp + HALF), e1u = *(const PG8_LAS f32x4*)(xp + 256 + HALF);
                    c1g = e1g; c1u = e1u;
#pragma unroll
                    for (int j = 0; j < 4; ++j) { c2g[j] = fr == 0 ? e0g[j] : e1g[j]; c2u[j] = fr == 0 ? e0u[j] : e1u[j]; } }
#pragma unroll
                for (int m = 0; m < 4; ++m) {
                    const f32x4 G = acc[ai][0][m][n], U = acc[ai][1][m][n];
                    f32x4 r1g, r2g, r1u, r2u, cg, cu;
#pragma unroll
                    for (int j = 0; j < 4; ++j) { r1g[j] = dpp_ror1(G[j]); r2g[j] = dpp_ror2(G[j]); r1u[j] = dpp_ror1(U[j]); r2u[j] = dpp_ror2(U[j]);
                        const float p1g = fr == 0 ? c1g[j] : r1g[j], p2g = fr < 2 ? c2g[j] : r2g[j], p1u = fr == 0 ? c1u[j] : r1u[j], p2u = fr < 2 ? c2u[j] : r2u[j];
                        cg[j] = wg[2][j] * G[j] + wg[1][j] * p1g + wg[0][j] * p2g; cu[j] = wu[2][j] * U[j] + wu[1][j] * p1u + wu[0][j] * p2u; }
                    c1g = r1g; c2g = r2g; c1u = r1u; c2u = r2u;
                    const int row = u.pm * BM + ai * HALF + wr * 64 + m * 16 + fr;
                    if (ai == 0 && m == 0 && wr == 0 && fr < 2) {
                        *(f32x4*)(part + ((size_t)(u.pm * 2 + fr) * 2 + 0) * dff + ch) = cg; *(f32x4*)(part + ((size_t)(u.pm * 2 + fr) * 2 + 1) * dff + ch) = cu;
                    } else {
                        f32x4 a;
#pragma unroll
                        for (int j = 0; j < 4; ++j) a[j] = cg[j] / (1.0f + __expf(-cg[j])) * cu[j];
                        typedef unsigned u32x2 __attribute__((ext_vector_type(2)));
                        u32x2 w; w.x = cvt_pk_bf16(a[0], a[1]); w.y = cvt_pk_bf16(a[2], a[3]);
                        *(u32x2*)(act + (size_t)row * dff + ch) = w;
                    }
                }
            }
        }
    }
};

template <class Epi, class Sched, bool ALIGN_EPI = false>
__device__ __forceinline__ void gemm_phase(PG8_LAS unsigned char* lds, const Gemm g, const Sched& S, const Epi& E) {
    int tid_ = threadIdx.x; asm volatile("" : "+v"(tid_));
    const int tid = tid_, wid = __builtin_amdgcn_readfirstlane(tid >> 6), lane = tid & 63, wr = wid >> 2, wc = wid & 3, fr = lane & 15, fq = lane >> 4;
    const int K = g.K, nt = K / BK;
    unsigned voffA[2], voffB[2];
#pragma unroll
    for (int i = 0; i < 2; ++i) { int R, C; stage_rc(tid * 16 + i * 8192, R, C); const int Rb = Epi::PERM ? ((R & ~31) + perm32(R & 31)) : R;
        voffA[i] = (unsigned)(R * g.lda + C) * 2u; voffB[i] = (unsigned)(Rb * g.ldb + C) * 2u; }
    const size_t kstep = (size_t)(BK * 2);
    const size_t hstepA = (size_t)HALF * g.lda * 2, hstepB = (size_t)HALF * g.ldb * 2;
    const unsigned ldsw = (unsigned)wid * 1024u;
    const int aoff = lds_byte(wr * 64 + fr, fq * 8), boff = lds_byte(wc * 32 + fr, fq * 8);
#define PG8_SA(b, h) (((b) * 2 + (h)) * HTB)
#define PG8_SB(b, h) ((4 + (b) * 2 + (h)) * HTB)
#define PG8_STAGE(bufoff, gbase, voff) do { _Pragma("unroll") for (int _i = 0; _i < 2; ++_i) \
        __builtin_amdgcn_global_load_lds((const unsigned*)((const char*)(gbase) + (voff)[_i]), (PG8_LAS unsigned*)(lds + (bufoff) + ldsw + _i * 8192), 16, 0, 0); } while (0)
#define PG8_LDA(dst, b, h) do { _Pragma("unroll") for (int m = 0; m < 4; ++m) _Pragma("unroll") for (int k = 0; k < 2; ++k) dst[m][k] = *(const PG8_LAS bf16x8*)(lds + PG8_SA(b, h) + aoff + m * 2048 + k * 1024); } while (0)
#define PG8_LDB(dst, b, h) do { _Pragma("unroll") for (int n = 0; n < 2; ++n) _Pragma("unroll") for (int k = 0; k < 2; ++k) dst[n][k] = *(const PG8_LAS bf16x8*)(lds + PG8_SB(b, h) + boff + n * 2048 + k * 1024); } while (0)
#define PG8_MMA(ai, bj, At, Bt) do { __builtin_amdgcn_s_setprio(1); _Pragma("unroll") for (int m = 0; m < 4; ++m) _Pragma("unroll") for (int n = 0; n < 2; ++n) _Pragma("unroll") for (int k = 0; k < 2; ++k) \
        acc[ai][bj][m][n] = __builtin_amdgcn_mfma_f32_16x16x32_bf16(Bt[n][k], At[m][k], acc[ai][bj][m][n], 0, 0, 0); __builtin_amdgcn_s_setprio(0); } while (0)
#define PG8_WAIT_V(n) asm volatile("s_waitcnt vmcnt(" #n ")" ::: "memory")
#define PG8_WAIT_L(n) asm volatile("s_waitcnt lgkmcnt(" #n ")" ::: "memory")
#define PG8_BAR __builtin_amdgcn_s_barrier()
#define PG8_SCHED __builtin_amdgcn_sched_barrier(0)
    Unit cur, nxt; int ui = 0;
    if (!S.next(0, cur)) return;
    f32x4 acc[2][2][4][2];
#pragma unroll
    for (int a = 0; a < 2; ++a)
#pragma unroll
        for (int b = 0; b < 2; ++b)
#pragma unroll
            for (int m = 0; m < 4; ++m)
#pragma unroll
                for (int n = 0; n < 2; ++n) acc[a][b][m][n] = (f32x4){0.f, 0.f, 0.f, 0.f};
    bf16x8 At[4][2], B0[2][2], B1[2][2];
    const char* cA = S.pa(g, cur); const char* cB = S.pb(g, cur);
    PG8_STAGE(PG8_SB(0, 0), cB, voffB); PG8_STAGE(PG8_SB(0, 1), cB + hstepB, voffB); PG8_STAGE(PG8_SA(0, 0), cA, voffA); PG8_STAGE(PG8_SA(0, 1), cA + hstepA, voffA);
    if (wr == 1) PG8_BAR;
    PG8_WAIT_V(2); PG8_BAR;
    PG8_STAGE(PG8_SB(1, 0), cB + kstep, voffB); PG8_STAGE(PG8_SA(1, 0), cA + kstep, voffA); PG8_STAGE(PG8_SB(1, 1), cB + hstepB + kstep, voffB);
    PG8_WAIT_V(6); PG8_BAR;
    for (;;) {
        const bool has_next = S.next(ui + 1, nxt);
        const char* nA = has_next ? S.pa(g, nxt) : cA; const char* nB = has_next ? S.pb(g, nxt) : cB;
#pragma nounroll
        for (int t = 0; t < nt; t += 2) {
            const bool last = (t == nt - 2);
            const char* a1 = cA + (size_t)(t + 1) * kstep;
            const char* a2 = last ? nA : cA + (size_t)(t + 2) * kstep; const char* b2 = last ? nB : cB + (size_t)(t + 2) * kstep;
            const char* a3 = a2 + kstep; const char* b3 = b2 + kstep;
            PG8_LDB(B0, 0, 0); PG8_LDB(B1, 0, 1); PG8_SCHED; PG8_LDA(At, 0, 0); PG8_STAGE(PG8_SA(1, 1), a1 + hstepA, voffA);
            PG8_WAIT_V(8); PG8_WAIT_L(0); PG8_BAR; PG8_MMA(0, 0, At, B0); PG8_MMA(0, 1, At, B1); PG8_BAR; PG8_SCHED;
            PG8_LDA(At, 0, 1); PG8_STAGE(PG8_SB(0, 0), b2, voffB); PG8_STAGE(PG8_SB(0, 1), b2 + hstepB, voffB); PG8_STAGE(PG8_SA(0, 0), a2, voffA);
            PG8_WAIT_V(8); PG8_WAIT_L(0); PG8_BAR; PG8_MMA(1, 0, At, B0); PG8_MMA(1, 1, At, B1); PG8_BAR; PG8_SCHED;
            PG8_LDB(B0, 1, 0); PG8_LDB(B1, 1, 1); PG8_SCHED; PG8_LDA(At, 1, 0); PG8_STAGE(PG8_SA(0, 1), a2 + hstepA, voffA);
            PG8_WAIT_V(8); PG8_WAIT_L(0); PG8_BAR; PG8_MMA(0, 0, At, B0); PG8_MMA(0, 1, At, B1); PG8_BAR; PG8_SCHED;
            PG8_LDA(At, 1, 1); PG8_STAGE(PG8_SB(1, 0), b3, voffB); PG8_STAGE(PG8_SB(1, 1), b3 + hstepB, voffB); PG8_STAGE(PG8_SA(1, 0), a3, voffA);
            PG8_WAIT_V(8); PG8_WAIT_L(0); PG8_BAR; PG8_MMA(1, 0, At, B0); PG8_MMA(1, 1, At, B1); PG8_BAR; PG8_SCHED;
        }
        if constexpr (ALIGN_EPI) { if (wr == 0) PG8_BAR; }
        if constexpr (!Epi::AFTER_DRAIN) { E(acc, cur, wr, wc, fr, fq); }
        if (!has_next) break;
#pragma unroll
        for (int a = 0; a < 2; ++a)
#pragma unroll
            for (int b = 0; b < 2; ++b)
#pragma unroll
                for (int m = 0; m < 4; ++m)
#pragma unroll
                    for (int n = 0; n < 2; ++n) acc[a][b][m][n] = (f32x4){0.f, 0.f, 0.f, 0.f};
        cur = nxt; cA = nA; cB = nB; ++ui;
        if constexpr (ALIGN_EPI) { if (wr == 1) PG8_BAR; }
    }
    PG8_WAIT_V(0);
    if constexpr (!ALIGN_EPI) { if (wr == 0) PG8_BAR; }
    PG8_BAR;
    if constexpr (Epi::AFTER_DRAIN) { E.fused(acc, cur, wr, wc, fr, fq, lds, wid, lane); }
#undef PG8_SA
#undef PG8_SB
#undef PG8_STAGE
#undef PG8_LDA
#undef PG8_LDB
#undef PG8_MMA
#undef PG8_WAIT_V
#undef PG8_WAIT_L
#undef PG8_BAR
#undef PG8_SCHED
}
}

constexpr int BATCH = 2, SEQ = 8192, D = 2048, DEPTH = 4, M = BATCH * SEQ;
constexpr int GW = 1024, GH = 8, GD = 128, SCW = 1024, NMEM = 256, XH = 4, XD = 512, DFF = 5632;
constexpr int NMIX_SRC = 7184, NMIX = 7168;
constexpr int PC_Q = 0, PC_K = 1024, PC_V = 2048, PC_Z = 3072, PC_B = 4096, PC_C = 5120, PC_H = 6144;
constexpr float EPS = 1e-6f;
constexpr int NWAVES = 8, NTHREADS = 512;

constexpr size_t MiB = 1u << 20;
constexpr size_t WS_CTL = 0, CTL_ZERO_BYTES = 1 * MiB;
constexpr size_t WS_WMIX = 1 * MiB;
constexpr size_t WS_WOUT = WS_WMIX + 112 * MiB;
constexpr size_t WS_WXQ  = WS_WOUT + 32 * MiB;
constexpr size_t WS_WXK  = WS_WXQ + 32 * MiB;
constexpr size_t WS_WXV  = WS_WXK + 32 * MiB;
constexpr size_t WS_WXO  = WS_WXV + 32 * MiB;
constexpr size_t WS_WUP  = WS_WXO + 32 * MiB;
constexpr size_t WS_WDN  = WS_WUP + 176 * MiB;
constexpr size_t WS_MEMN = WS_WDN + 88 * MiB;
constexpr size_t WS_KX   = WS_MEMN + 8 * MiB;
constexpr size_t WS_VX   = WS_KX + 8 * MiB;
constexpr size_t WS_BETA = WS_VX + 8 * MiB;
constexpr size_t WS_WBA  = WS_BETA + 512 * 1024;
constexpr size_t WS_G    = WS_BETA + 1 * MiB;
constexpr size_t WS_H    = WS_G + 1 * MiB;
constexpr size_t WS_OG   = WS_H + 64 * MiB;
constexpr size_t WS_Y    = WS_OG + 64 * MiB;
constexpr size_t WS_PB   = WS_OG;
constexpr size_t WS_HB   = WS_Y + 64 * MiB;
constexpr size_t WS_BIG  = WS_HB + 64 * MiB;
constexpr size_t WS_PROJ = WS_BIG;
constexpr size_t WS_GS   = WS_BIG + 224 * MiB;
constexpr size_t WS_ACT  = WS_BIG;
constexpr size_t WS_HALO = WS_BIG + 192 * MiB;
constexpr size_t WS_PART = WS_BIG + 200 * MiB;
constexpr size_t WS_WQK  = WS_BIG + 416 * MiB;
constexpr size_t WS_VWO  = WS_WQK + 32 * MiB;
constexpr size_t WS_END  = WS_VWO + 32 * MiB;
constexpr size_t WS_SSQ  = 65536;
static_assert(WS_SSQ + (size_t)DEPTH * 3 * M * 4 <= CTL_ZERO_BYTES, "ssq arrays inside the zeroed region");
constexpr int CW_BAR = 4096;

constexpr int RING_OFF = 0, RING_BYTES = 131072;
constexpr int LDSCTL_OFF = RING_BYTES, MISC_OFF = LDSCTL_OFF + 320, XB_OFF = LDSCTL_OFF + 1024;
constexpr int LDS_BYTES = 147456;

#define GAS __attribute__((address_space(1)))
#define LAS __attribute__((address_space(3)))
typedef unsigned short bf16;
typedef unsigned v4u __attribute__((ext_vector_type(4)));
typedef unsigned v2u __attribute__((ext_vector_type(2)));
typedef float f32x4 __attribute__((ext_vector_type(4)));
typedef short bf16x8 __attribute__((ext_vector_type(8)));
#define LDS_WAIT() asm volatile("s_waitcnt lgkmcnt(0)" ::: "memory")
#define VM_WAIT() asm volatile("s_waitcnt vmcnt(0)" ::: "memory")
__device__ __forceinline__ unsigned pk2(float lo, float hi) { return pg8::cvt_pk_bf16(lo, hi); }
__device__ __forceinline__ float bf_lo(unsigned w) { return __uint_as_float(w << 16); }
__device__ __forceinline__ float bf_hi(unsigned w) { return __uint_as_float(w & 0xffff0000u); }
__device__ __forceinline__ float wave_sum(float v) {
#pragma unroll
    for (int o = 1; o < 64; o <<= 1) v += __shfl_xor(v, o);
    return v;
}
__device__ __forceinline__ float silu_f(float y) { return y / (1.0f + __expf(-y)); }
__device__ __forceinline__ float sigmoid_f(float y) { return 1.0f / (1.0f + __expf(-y)); }

#define XB_TMO      128
#define XB_XCNT(j)  (256  + 64 * (j))
#define XB_XSUB(j)  (1280 + 64 * (j))
#define XB_XGEN(j)  (2304 + 64 * (j))
#define XB_TOP      3328
#define XB_TOPGEN   3392
#define XCD_BAR_WORDS 3456
#define XB_SPIN_CAP (1u << 18)

__device__ __forceinline__ unsigned xb_ld(unsigned* p)              { return __hip_atomic_load(p, __ATOMIC_RELAXED, __HIP_MEMORY_SCOPE_AGENT); }
__device__ __forceinline__ unsigned xb_add(unsigned* p, unsigned v) { return __hip_atomic_fetch_add(p, v, __ATOMIC_RELAXED, __HIP_MEMORY_SCOPE_AGENT); }
__device__ __forceinline__ unsigned xb_xcc_id() { return (unsigned)__builtin_amdgcn_s_getreg((3 << 11) | 20) & 0xFu; }
#define XB_SPIN(cond, bar) do { unsigned _sp = 0; while (cond) { __builtin_amdgcn_s_sleep(1); \
    if ((++_sp & 255u) == 0u) { if (xb_ld(&(bar)[XB_TMO])) break; if (_sp > XB_SPIN_CAP) { atomicAdd(&(bar)[XB_TMO], 1u); break; } } } } while (0)

struct XcdBarrier {
    unsigned* bar; unsigned x;
    volatile LAS unsigned* st;
};

__device__ __forceinline__ XcdBarrier xcd_barrier_post(unsigned* bar, volatile LAS unsigned* st) {
    XcdBarrier b; b.bar = bar; b.x = xb_xcc_id(); b.st = st;
    if (threadIdx.x == 0) (void)xb_add(&bar[XB_XCNT(b.x)], 1u);
    return b;
}
__device__ __forceinline__ void xcd_barrier_complete(unsigned* bar, unsigned x, unsigned& nloc, unsigned& nx) {
    const unsigned G = gridDim.x * gridDim.y * gridDim.z;
    unsigned sum, cnt, mine, sp = 0u;
    for (;;) {
        sum = 0u; cnt = 0u; mine = 0u;
#pragma unroll
        for (unsigned j = 0; j < 16; ++j) { const unsigned c = xb_ld(&bar[XB_XCNT(j)]); sum += c; cnt += (c > 0u) ? 1u : 0u; mine = (j == x) ? c : mine; }
        if (sum == G) break;
        __builtin_amdgcn_s_sleep(1);
        if ((++sp & 255u) == 0u) { if (xb_ld(&bar[XB_TMO])) break; if (sp > XB_SPIN_CAP) { atomicAdd(&bar[XB_TMO], 1u); break; } }
    }
    nloc = mine > 0u ? mine : 1u; nx = cnt > 0u ? cnt : 1u;
}

__device__ __forceinline__ void xcd_barrier(const XcdBarrier& b) {
    asm volatile("s_waitcnt vmcnt(0)" ::: "memory");
    __syncthreads();
    if (threadIdx.x == 0) {
        unsigned* bar = b.bar;
        __builtin_amdgcn_s_waitcnt(0);
        unsigned nloc = b.st[0], nx = b.st[1];
        if (nloc == 0u) { xcd_barrier_complete(bar, b.x, nloc, nx); b.st[0] = nloc; b.st[1] = nx; }
        const unsigned old = xb_add(&bar[XB_XSUB(b.x)], 1u);
        const unsigned gen = old / nloc;
        if (old + 1u == (gen + 1u) * nloc) {
            __builtin_amdgcn_fence(__ATOMIC_RELEASE, "agent");
            asm volatile("s_waitcnt vmcnt(0)" ::: "memory");
            const unsigned og = xb_add(&bar[XB_TOP], 1u);
            const unsigned tg = og / nx;
            if (og + 1u == (tg + 1u) * nx) xb_add(&bar[XB_TOPGEN], 1u);
            else XB_SPIN(xb_ld(&bar[XB_TOPGEN]) == tg, bar);
            __builtin_amdgcn_fence(__ATOMIC_ACQUIRE, "agent");
            xb_add(&bar[XB_XGEN(b.x)], 1u);
            asm volatile("s_waitcnt vmcnt(0)" ::: "memory");
        } else {
            XB_SPIN(xb_ld(&bar[XB_XGEN(b.x)]) == gen, bar);
            __builtin_amdgcn_fence(__ATOMIC_ACQUIRE, "agent");
            asm volatile("s_waitcnt vmcnt(0)" ::: "memory");
        }
    }
    __syncthreads();
}


struct Frame {
    LAS unsigned char* lds;
    int tid, lane, wave, G, gw, NGW;
    unsigned char* ws;
};
#define IN_X 0
#define IN_MEM 1
#define IN_MIX_NORM 2
#define IN_W_MIX_IN 3
#define IN_GDN_CONV 4
#define IN_A_LOG 5
#define IN_DT_BIAS 6
#define IN_OUT_NORM 7
#define IN_SC_CONV 8
#define IN_W_MIX_OUT 9
#define IN_XATTN_NORM 10
#define IN_MEM_NORM 11
#define IN_W_XQ 12
#define IN_W_XK 13
#define IN_W_XV 14
#define IN_W_XO 15
#define IN_FFN_NORM 16
#define IN_W_UP 17
#define IN_FFN_CONV 18
#define IN_W_DOWN 19
#define IN_FINAL_NORM 20

__device__ __forceinline__ void xpose_item(const float* src  , size_t ld, bf16* dst  , size_t K, int lane, LAS unsigned char* T) {
    const int n4 = lane & 15, ksub = lane >> 4;
    const float* s = src + (size_t)(16 * ksub) * ld + 4 * n4;
    f32x4 v[16];
#pragma unroll
    for (int i = 0; i < 16; ++i) v[i] = *(const f32x4*)(s + (size_t)i * ld);
#pragma unroll
    for (int j = 0; j < 4; ++j) { v4u a, b; a.x = pk2(v[0][j], v[1][j]); a.y = pk2(v[2][j], v[3][j]); a.z = pk2(v[4][j], v[5][j]); a.w = pk2(v[6][j], v[7][j]);
        b.x = pk2(v[8][j], v[9][j]); b.y = pk2(v[10][j], v[11][j]); b.z = pk2(v[12][j], v[13][j]); b.w = pk2(v[14][j], v[15][j]);
        LAS v4u* t = (LAS v4u*)(T + (4 * n4 + j) * 144 + 32 * ksub); t[0] = a; t[1] = b; }
    LDS_WAIT(); asm volatile("" ::: "memory");
#pragma unroll
    for (int i = 0; i < 8; ++i) { const int n = 8 * i + (lane >> 3), c = lane & 7; *(v4u*)(dst + (size_t)n * K + 8 * c) = *(const LAS v4u*)(T + n * 144 + 16 * c); }
    LDS_WAIT(); asm volatile("" ::: "memory");
}
__device__ __forceinline__ void convert_item(const float* src, bf16* dst, int lane) {
#pragma unroll
    for (int k = 0; k < 8; ++k) { const f32x4 a = *(const f32x4*)(src + k * 512 + 8 * lane), b = *(const f32x4*)(src + k * 512 + 8 * lane + 4);
        v4u o; o.x = pk2(a[0], a[1]); o.y = pk2(a[2], a[3]); o.z = pk2(b[0], b[1]); o.w = pk2(b[2], b[3]); *(v4u*)(dst + k * 512 + 8 * lane) = o; }
}
__device__ __forceinline__ void p0_weights_x(Frame& F, const float* w_xq, const float* w_xk, const float* w_xv, const float* w_xo) {
    constexpr int I_SQ = 32 * 32, I_XQ = D * D / 4096, I_LAYER = 3 * I_SQ + I_XQ;
    LAS unsigned char* T = F.lds + RING_OFF + F.wave * 9216;
    for (int it = F.gw; it < DEPTH * I_LAYER; it += F.NGW) {
        const int l = it / I_LAYER; int r = it % I_LAYER;
        if (r < 3 * I_SQ) { const int f = r / I_SQ, rr = r % I_SQ, nb = rr >> 5, kb = rr & 31;
            const float* src = f == 0 ? w_xk : f == 1 ? w_xv : w_xo;
            const size_t dofs = f == 0 ? WS_WXK : f == 1 ? WS_WXV : WS_WXO;
            xpose_item(src + (size_t)l * D * D + (size_t)(kb * 64) * D + nb * 64, D, (bf16*)(F.ws + dofs) + (size_t)l * D * D + (size_t)(nb * 64) * D + kb * 64, D, F.lane, T); continue; }
        r -= 3 * I_SQ;
        convert_item(w_xq + (size_t)l * D * D + (size_t)r * 4096, (bf16*)(F.ws + WS_WXQ) + (size_t)l * D * D + (size_t)r * 4096, F.lane);
    }
}
__device__ __forceinline__ void p0_weights_main(Frame& F, int l, int gw, int ngw, const float* w_mix_in, const float* w_mix_out, const float* w_up, const float* w_down) {
    constexpr int I_MIX = 112 * 32, I_SQ = 32 * 32, I_UP = 176 * 32, I_DN = 32 * 88, I_LAYER = I_MIX + I_SQ + I_UP + I_DN;
    LAS unsigned char* T = F.lds + RING_OFF + F.wave * 9216;
    for (int it = gw; it < I_LAYER; it += ngw) {
        int r = it;
        if (r < I_MIX) { const int nb = r >> 5, kb = r & 31, n0 = nb * 64, sc = n0 < 4096 ? n0 : n0 + 16;
            xpose_item(w_mix_in + (size_t)l * D * NMIX_SRC + (size_t)(kb * 64) * NMIX_SRC + sc, NMIX_SRC, (bf16*)(F.ws + WS_WMIX) + (size_t)l * NMIX * D + (size_t)n0 * D + kb * 64, D, F.lane, T); continue; }
        r -= I_MIX;
        if (r < I_SQ) { const int nb = r >> 5, kb = r & 31;
            xpose_item(w_mix_out + (size_t)l * D * D + (size_t)(kb * 64) * D + nb * 64, D, (bf16*)(F.ws + WS_WOUT) + (size_t)l * D * D + (size_t)(nb * 64) * D + kb * 64, D, F.lane, T); continue; }
        r -= I_SQ;
        if (r < I_UP) { const int nb = r >> 5, kb = r & 31, n0 = nb * 64, c0 = n0 < DFF ? n0 : n0 - DFF, drow = (c0 >> 7) * 256 + (n0 < DFF ? 0 : 128) + (c0 & 127);
            xpose_item(w_up + (size_t)l * D * 2 * DFF + (size_t)(kb * 64) * 2 * DFF + n0, 2 * DFF, (bf16*)(F.ws + WS_WUP) + (size_t)l * 2 * DFF * D + (size_t)drow * D + kb * 64, D, F.lane, T); continue; }
        r -= I_UP;
        { const int nb = r / 88, kb = r % 88;
            xpose_item(w_down + (size_t)l * DFF * D + (size_t)(kb * 64) * D + nb * 64, D, (bf16*)(F.ws + WS_WDN) + (size_t)l * D * DFF + (size_t)(nb * 64) * DFF + kb * 64, DFF, F.lane, T); }
    }
    for (int i = gw * 64 + F.lane; i < 16 * D; i += ngw * 64) { const int n = i / D, k = i % D;
        ((bf16*)(F.ws + WS_WBA))[(size_t)l * 16 * D + i] = (bf16)(pk2(w_mix_in[(size_t)l * D * NMIX_SRC + (size_t)k * NMIX_SRC + 4096 + n], 0.f) & 0xffffu); }
}
__device__ __forceinline__ void p0_memn(Frame& F, const float* mem, const float* mem_norm) {
    for (int m = F.gw; m < BATCH * NMEM; m += F.NGW) {
        const f32x4* xr = (const f32x4*)(mem + (size_t)m * D) + F.lane;
        f32x4 v[8]; float s = 0.f;
#pragma unroll
        for (int j = 0; j < 8; ++j) { v[j] = xr[64 * j]; s += (v[j][0] * v[j][0] + v[j][1] * v[j][1]) + (v[j][2] * v[j][2] + v[j][3] * v[j][3]); }
        const float rstd = 1.0f / sqrtf(wave_sum(s) * (1.0f / D) + EPS);
        for (int l = 0; l < DEPTH; ++l) {
            const f32x4* gr = (const f32x4*)(mem_norm + (size_t)l * D) + F.lane;
            v2u* o8 = (v2u*)((bf16*)(F.ws + WS_MEMN) + ((size_t)l * 512 + m) * D) + F.lane;
#pragma unroll
            for (int j = 0; j < 8; ++j) { const f32x4 g4 = gr[64 * j]; const f32x4 h = v[j] * rstd * g4; v2u o; o.x = pk2(h[0], h[1]); o.y = pk2(h[2], h[3]); o8[64 * j] = o; }
        }
    }
}

__device__ __forceinline__ void prenorm_phase(Frame& F, const float* x, const float* gain, bf16* Hn, float* ssq) {
    f32x4 g4[8];
#pragma unroll
    for (int j = 0; j < 8; ++j) g4[j] = ((const f32x4*)gain)[64 * j + F.lane];
    for (int m = F.gw; m < M; m += F.NGW) {
        const f32x4* xr = (const f32x4*)(x + (size_t)m * D) + F.lane;
        f32x4 v[8]; float s = 0.f;
#pragma unroll
        for (int j = 0; j < 8; ++j) { v[j] = xr[64 * j]; s += (v[j][0] * v[j][0] + v[j][1] * v[j][1]) + (v[j][2] * v[j][2] + v[j][3] * v[j][3]); }
        s = wave_sum(s);
        if (F.lane == 0) ssq[m] = s;
        v2u* o8 = (v2u*)(Hn + (size_t)m * D) + F.lane;
#pragma unroll
        for (int j = 0; j < 8; ++j) { v[j] = v[j] * g4[j]; v2u o; o.x = pk2(v[j][0], v[j][1]); o.y = pk2(v[j][2], v[j][3]); o8[64 * j] = o; }
    }
}
__device__ __forceinline__ void ba_phase(Frame& F, const bf16* Hn, const float* ssq, const bf16* wba  , const float* alogp, const float* dtbp) {
    const int lane = F.lane, wave = F.wave, mtile = wave & 3, khalf = wave >> 2, fr = lane & 15, fq = lane >> 4;
    LAS f32x4* red = (LAS f32x4*)(F.lds);
    for (int rb = blockIdx.x; rb < M / 64; rb += F.G) {
        const int row0 = rb * 64 + 16 * mtile;
        const bf16* ap = Hn + (size_t)(row0 + fr) * D + khalf * 1024 + 8 * fq;
        const bf16* bp = wba + (size_t)fr * D + khalf * 1024 + 8 * fq;
        f32x4 acc = {0.f, 0.f, 0.f, 0.f};
#pragma unroll 8
        for (int s = 0; s < 32; ++s) { const bf16x8 a = __builtin_bit_cast(bf16x8, *(const v4u*)(ap + 32 * s)), b = __builtin_bit_cast(bf16x8, *(const v4u*)(bp + 32 * s));
            acc = __builtin_amdgcn_mfma_f32_16x16x32_bf16(a, b, acc, 0, 0, 0); }
        if (khalf == 1) red[mtile * 64 + lane] = acc;
        LDS_WAIT(); __syncthreads();
        if (khalf == 0) {
            const f32x4 o = red[mtile * 64 + lane]; acc = acc + o;
            const float al = fr >= 8 ? alogp[fr - 8] : 0.f, db = fr >= 8 ? dtbp[fr - 8] : 0.f;
#pragma unroll
            for (int i = 0; i < 4; ++i) { const int row = row0 + 4 * fq + i; const float v = acc[i] * (1.0f / sqrtf(ssq[row] * (1.0f / D) + EPS));
                if (fr < 8) ((float*)(F.ws + WS_BETA))[(size_t)row * GH + fr] = sigmoid_f(v);
                else { const float z = v + db; const float sp = fmaxf(z, 0.f) + log1pf(expf(-fabsf(z))); ((float*)(F.ws + WS_G))[(size_t)row * GH + fr - 8] = -expf(al) * sp; } }
        }
        LDS_WAIT(); __syncthreads();
    }
}
__device__ __forceinline__ void final_norm_phase(Frame& F, const float* x, const float* gain, float* out) {
    f32x4 g4[8];
#pragma unroll
    for (int j = 0; j < 8; ++j) g4[j] = ((const f32x4*)gain)[64 * j + F.lane];
    for (int m = F.gw; m < M; m += F.NGW) {
        const f32x4* xr = (const f32x4*)(x + (size_t)m * D) + F.lane;
        f32x4 v[8]; float s = 0.f;
#pragma unroll
        for (int j = 0; j < 8; ++j) { v[j] = xr[64 * j]; s += (v[j][0] * v[j][0] + v[j][1] * v[j][1]) + (v[j][2] * v[j][2] + v[j][3] * v[j][3]); }
        const float rstd = 1.0f / sqrtf(wave_sum(s) * (1.0f / D) + EPS);
        f32x4* o = (f32x4*)(out + (size_t)m * D) + F.lane;
#pragma unroll
        for (int j = 0; j < 8; ++j) o[64 * j] = v[j] * rstd * g4[j];
    }
}

__device__ __forceinline__ void unpack8(const v4u w, float (&f)[8]) {
    f[0] = bf_lo(w.x); f[1] = bf_hi(w.x); f[2] = bf_lo(w.y); f[3] = bf_hi(w.y); f[4] = bf_lo(w.z); f[5] = bf_hi(w.z); f[6] = bf_lo(w.w); f[7] = bf_hi(w.w);
}

__device__ __forceinline__ void shortconv_phase(Frame& F, const float* cw, int gw, int ngw) {
    const bf16* PROJ = (const bf16*)(F.ws + WS_PROJ);
    bf16* Y = (bf16*)(F.ws + WS_Y);
    for (int rb = gw; rb < M / 8; rb += ngw) {
        const int m0 = rb * 8, t0 = m0 % SEQ;
        for (int i = 0; i < 2; ++i) {
            const int ch0 = 8 * (F.lane + 64 * i);
            float w[3][8];
#pragma unroll
            for (int j = 0; j < 3; ++j) { const f32x4 a = *(const f32x4*)(cw + (size_t)j * SCW + ch0), b = *(const f32x4*)(cw + (size_t)j * SCW + ch0 + 4);
                w[j][0] = a[0]; w[j][1] = a[1]; w[j][2] = a[2]; w[j][3] = a[3]; w[j][4] = b[0]; w[j][5] = b[1]; w[j][6] = b[2]; w[j][7] = b[3]; }
            float x0[8], x1[8], x2[8], cg[8], hh[8], bg[8];
            const bf16* p = PROJ + (size_t)m0 * NMIX + ch0;
            if (t0 >= 2) {
                unpack8(*(const v4u*)(p - 2 * (size_t)NMIX + PC_C), cg); unpack8(*(const v4u*)(p - 2 * (size_t)NMIX + PC_H), hh);
#pragma unroll
                for (int e = 0; e < 8; ++e) x0[e] = cg[e] * hh[e];
                unpack8(*(const v4u*)(p - (size_t)NMIX + PC_C), cg); unpack8(*(const v4u*)(p - (size_t)NMIX + PC_H), hh);
#pragma unroll
                for (int e = 0; e < 8; ++e) x1[e] = cg[e] * hh[e];
            } else {
#pragma unroll
                for (int e = 0; e < 8; ++e) { x0[e] = 0.f; x1[e] = 0.f; } }
            for (int r = 0; r < 8; ++r) {
                unpack8(*(const v4u*)(p + (size_t)r * NMIX + PC_C), cg); unpack8(*(const v4u*)(p + (size_t)r * NMIX + PC_H), hh); unpack8(*(const v4u*)(p + (size_t)r * NMIX + PC_B), bg);
                float y[8];
#pragma unroll
                for (int e = 0; e < 8; ++e) { x2[e] = cg[e] * hh[e]; y[e] = bg[e] * (w[0][e] * x0[e] + w[1][e] * x1[e] + w[2][e] * x2[e]); x0[e] = x1[e]; x1[e] = x2[e]; }
                v4u o; o.x = pk2(y[0], y[1]); o.y = pk2(y[2], y[3]); o.z = pk2(y[4], y[5]); o.w = pk2(y[6], y[7]);
                *(v4u*)(Y + (size_t)(m0 + r) * D + GW + ch0) = o;
            }
        }
    }
}
__device__ __forceinline__ void swiglu_fix_phase(Frame& F, const float* cw) {
    bf16* ACT = (bf16*)(F.ws + WS_ACT); const float* PART = (const float*)(F.ws + WS_PART); const float* HALO = (const float*)(F.ws + WS_HALO);
    for (int idx = F.gw * 64 + F.lane; idx < (M / 256) * (DFF / 4); idx += F.NGW * 64) {
        const int pm = idx / (DFF / 4), ch = 4 * (idx % (DFF / 4));
        f32x4 wg[3], wu[3];
#pragma unroll
        for (int t = 0; t < 3; ++t) { wg[t] = *(const f32x4*)(cw + (size_t)t * 2 * DFF + ch); wu[t] = *(const f32x4*)(cw + (size_t)t * 2 * DFF + DFF + ch); }
        f32x4 g0 = *(const f32x4*)(PART + ((size_t)(pm * 2 + 0) * 2 + 0) * DFF + ch), u0 = *(const f32x4*)(PART + ((size_t)(pm * 2 + 0) * 2 + 1) * DFF + ch);
        f32x4 g1 = *(const f32x4*)(PART + ((size_t)(pm * 2 + 1) * 2 + 0) * DFF + ch), u1 = *(const f32x4*)(PART + ((size_t)(pm * 2 + 1) * 2 + 1) * DFF + ch);
        if (pm % (SEQ / 256) != 0) {
            const f32x4 hg0 = *(const f32x4*)(HALO + ((size_t)((pm - 1) * 2 + 0) * 2 + 0) * DFF + ch), hu0 = *(const f32x4*)(HALO + ((size_t)((pm - 1) * 2 + 0) * 2 + 1) * DFF + ch);
            const f32x4 hg1 = *(const f32x4*)(HALO + ((size_t)((pm - 1) * 2 + 1) * 2 + 0) * DFF + ch), hu1 = *(const f32x4*)(HALO + ((size_t)((pm - 1) * 2 + 1) * 2 + 1) * DFF + ch);
            g0 = g0 + wg[1] * hg1 + wg[0] * hg0; u0 = u0 + wu[1] * hu1 + wu[0] * hu0; g1 = g1 + wg[0] * hg1; u1 = u1 + wu[0] * hu1;
        }
        v2u w0, w1; w0.x = pk2(silu_f(g0[0]) * u0[0], silu_f(g0[1]) * u0[1]); w0.y = pk2(silu_f(g0[2]) * u0[2], silu_f(g0[3]) * u0[3]);
        w1.x = pk2(silu_f(g1[0]) * u1[0], silu_f(g1[1]) * u1[1]); w1.y = pk2(silu_f(g1[2]) * u1[2], silu_f(g1[3]) * u1[3]);
        *(v2u*)(ACT + (size_t)(pm * 256) * DFF + ch) = w0; *(v2u*)(ACT + (size_t)(pm * 256 + 1) * DFF + ch) = w1;
    }
}

struct KvOrder {
    int G, c; const bf16 *memn, *wxk, *wxv;
    __device__ __forceinline__ bool next(int i, pg8::Unit& u) const { const long L = (long)i * G + c; if (L >= 128) return false; u.pm = (int)L; u.pn = 0; return true; }
    __device__ __forceinline__ const char* pa(const pg8::Gemm&, const pg8::Unit& u) const { const int l = u.pm >> 5, r = u.pm & 15; return (const char*)(memn + ((size_t)l * 512 + (r >> 3) * 256) * D); }
    __device__ __forceinline__ const char* pb(const pg8::Gemm&, const pg8::Unit& u) const { const int l = u.pm >> 5, r = u.pm & 15;
        const bf16* wk = wxk + ((size_t)l * D + (r & 7) * 256) * D; const bf16* wv = wxv + ((size_t)l * D + (r & 7) * 256) * D; return (const char*)((u.pm & 16) ? wv : wk); }
};
struct LocKv { bf16 *kx, *vx;
    __device__ __forceinline__ void operator()(const pg8::Unit& u, bf16*& base, int& ld) const { const int l = u.pm >> 5, r = u.pm & 15;
        bf16* bk = kx + ((size_t)l * 512 + (r >> 3) * 256) * D + (r & 7) * 256; bf16* bv = vx + ((size_t)l * 512 + (r >> 3) * 256) * D + (r & 7) * 256; base = (u.pm & 16) ? bv : bk; ld = D; } };
struct PreOrder {
    int G, c; const bf16 *kx, *vx, *wxq, *wxo;
    __device__ __forceinline__ bool next(int i, pg8::Unit& u) const { const long L = (long)i * G + c; if (L >= 512) return false; u.pm = (int)L; u.pn = 0; return true; }
    __device__ __forceinline__ const char* pa(const pg8::Gemm&, const pg8::Unit& u) const { const int jj = u.pm & 255, l = jj >> 6, b = (jj >> 5) & 1, h = (jj >> 3) & 3, t = jj & 7;
        return (const char*)(u.pm < 256 ? kx + ((size_t)l * 512 + b * 256) * D + h * XD : wxo + ((size_t)l * D + t * 256) * D + h * XD); }
    __device__ __forceinline__ const char* pb(const pg8::Gemm&, const pg8::Unit& u) const { const int jj = u.pm & 255, l = jj >> 6, b = (jj >> 5) & 1, h = (jj >> 3) & 3, t = jj & 7;
        return (const char*)(u.pm < 256 ? wxq + ((size_t)l * D + t * 256) * D + h * XD : vx + ((size_t)l * 512 + b * 256) * D + h * XD); }
};
struct LocPre { bf16 *wqk, *vwo;
    __device__ __forceinline__ void operator()(const pg8::Unit& u, bf16*& base, int& ld) const { const int jj = u.pm & 255, l = jj >> 6, b = (jj >> 5) & 1, h = (jj >> 3) & 3, t = jj & 7;
        if (u.pm < 256) { base = wqk + ((size_t)(l * 2 + b) * (XH * NMEM) + h * NMEM) * D + t * 256; ld = D; }
        else { base = vwo + ((size_t)(l * 2 + b) * D + t * 256) * (XH * NMEM) + h * NMEM; ld = XH * NMEM; } } };
struct SOrder {
    int G, c;
    __device__ __forceinline__ bool next(int i, pg8::Unit& u) const { const long L = (long)i * G + c; if (L >= 256) return false; u.pm = (int)L & 63; u.pn = (int)L >> 6; return true; }
    __device__ __forceinline__ const char* pa(const pg8::Gemm& g, const pg8::Unit& u) const { return (const char*)(g.A + (size_t)u.pm * 256 * D); }
    __device__ __forceinline__ const char* pb(const pg8::Gemm& g, const pg8::Unit& u) const { return (const char*)(g.Bt + (size_t)(u.pm >> 5) * (XH * NMEM) * D + (size_t)u.pn * NMEM * D); }
};
struct BatchOrder : pg8::StaticOrder {
    size_t bstride;
    __device__ __forceinline__ const char* pb(const pg8::Gemm& g, const pg8::Unit& u) const { return (const char*)(g.Bt + (size_t)(u.pm >> 5) * bstride + (size_t)u.pn * pg8::BM * g.ldb); }
};

typedef float f32x16 __attribute__((ext_vector_type(16)));
typedef float f32x2n __attribute__((ext_vector_type(2)));
typedef __bf16 bf16x2n __attribute__((ext_vector_type(2)));
__device__ __forceinline__ unsigned pkn(float a, float b) { f32x2n v = {a, b}; bf16x2n r = __builtin_convertvector(v, bf16x2n); return __builtin_bit_cast(unsigned, r); }
__device__ __forceinline__ int kmap(int p) { const int pp = p & 15, hh = pp >> 3, jj = pp & 7; return (p & ~15) + 8 * (jj >> 2) + 4 * hh + (jj & 3); }
__device__ __forceinline__ int kpos(int d) { const int dd = d & 15; return (d & ~15) + 8 * ((dd >> 2) & 1) + 4 * (dd >> 3) + (dd & 3); }
__device__ __forceinline__ bf16x8 pack_step(const f32x16& x, int s) {
    v4u w; w.x = pkn(x[8 * s], x[8 * s + 1]); w.y = pkn(x[8 * s + 2], x[8 * s + 3]); w.z = pkn(x[8 * s + 4], x[8 * s + 5]); w.w = pkn(x[8 * s + 6], x[8 * s + 7]);
    return __builtin_bit_cast(bf16x8, w);
}
constexpr int REC_BYTES = 36864, WIMG_STRIDE = 272, KDIMG_OFF = 17408, KDIMG_STRIDE = 144, IMG_USED = 35840;
constexpr size_t WS_REC = WS_GS;
constexpr size_t WS_UT = WS_GS + 80 * MiB;
constexpr size_t WS_ATTN = WS_GS + 144 * MiB;
constexpr size_t WS_EGL = WS_GS + 160 * MiB;
constexpr size_t WS_SST = WS_H;
constexpr size_t WS_QD = WS_OG;
constexpr size_t WS_VST = WS_OG + 32 * MiB;

__device__ __forceinline__ void gdn_prep_phase(Frame& F, const float* cw  ) {
    const bf16* PROJ = (const bf16*)(F.ws + WS_PROJ);
    const float* BETA = (const float*)(F.ws + WS_BETA); const float* GG = (const float*)(F.ws + WS_G);
    unsigned o_vs = 32768, o_kb = 65536, o_qb = 82944, o_as = 101376, o_att = 117760, o_gc = 125952;
    asm volatile("" : "+v"(o_vs), "+v"(o_kb), "+v"(o_qb), "+v"(o_as), "+v"(o_att), "+v"(o_gc));
    LAS float* KS = (LAS float*)(F.lds);
    LAS float* VS = (LAS float*)(F.lds + o_vs);
    LAS unsigned char* KB16 = F.lds + o_kb;
    LAS unsigned char* QB16 = F.lds + o_qb;
    LAS unsigned char* IMG = KB16;
    LAS float* AS = (LAS float*)(F.lds + o_as);
    LAS unsigned short* ATT = (LAS unsigned short*)(F.lds + o_att);
    LAS float* GC = (LAS float*)(F.lds + o_gc);
    const int tid = F.tid, lane = F.lane, wave = F.wave;
#ifndef G1_REP
#define G1_REP 1
#endif
    for (int it = 0; it * F.G < 2048 * G1_REP; ++it) {
        const int u = blockIdx.x + F.G * (it / G1_REP);
        const int ch = u, n = ch & 127, bh = ch >> 7, b = bh >> 3, h = bh & 7;
        const int m0 = b * SEQ + n * 64;
        if (tid < 384) {
            const int rb = tid / 48, cgi = tid % 48, tensor = cgi >> 4, cg = cgi & 15;
            const int ch0 = tensor * GW + h * GD + 8 * cg, c0 = rb * 8;
            float w[4][8];
#pragma unroll
            for (int j = 0; j < 4; ++j) { const f32x4 a = *(const f32x4*)(cw + (size_t)j * 3 * GW + ch0), bq = *(const f32x4*)(cw + (size_t)j * 3 * GW + ch0 + 4);
                w[j][0] = a[0]; w[j][1] = a[1]; w[j][2] = a[2]; w[j][3] = a[3]; w[j][4] = bq[0]; w[j][5] = bq[1]; w[j][6] = bq[2]; w[j][7] = bq[3]; }
            float x0[8], x1[8], x2[8], x3[8];
            const bf16* p = PROJ + (size_t)(m0 + c0) * NMIX + ch0;
            const bool hist = n * 64 + c0 >= 3;
            v4u raw[11];
#pragma unroll
            for (int q = 0; q < 3; ++q) raw[q] = *(const v4u*)(hist ? p - (size_t)(3 - q) * NMIX : p);
#pragma unroll
            for (int q = 0; q < 8; ++q) raw[3 + q] = *(const v4u*)(p + (size_t)q * NMIX);
            if (!hist) { raw[0] = (v4u){0u, 0u, 0u, 0u}; raw[1] = raw[0]; raw[2] = raw[0]; }
            unpack8(raw[0], x0); unpack8(raw[1], x1); unpack8(raw[2], x2);
#pragma unroll
            for (int r = 0; r < 8; ++r) {
                unpack8(raw[3 + r], x3);
                float y[8]; float ss = 0.f;
#pragma unroll
                for (int e = 0; e < 8; ++e) { const float c = w[0][e] * x0[e] + w[1][e] * x1[e] + w[2][e] * x2[e] + w[3][e] * x3[e]; y[e] = silu_f(c); ss += y[e] * y[e]; x0[e] = x1[e]; x1[e] = x2[e]; x2[e] = x3[e]; }
                const int c = c0 + r;
                if (tensor < 2) {
                    ss += __shfl_xor(ss, 1); ss += __shfl_xor(ss, 2); ss += __shfl_xor(ss, 4); ss += __shfl_xor(ss, 8);
                    float sc = 1.0f / sqrtf(ss + EPS); if (tensor == 0) sc *= 0.08838834764831845f;
#pragma unroll
                    for (int e = 0; e < 8; ++e) y[e] *= sc;
                    v4u o; o.x = pkn(y[0], y[1]); o.y = pkn(y[2], y[3]); o.z = pkn(y[4], y[5]); o.w = pkn(y[6], y[7]);
                    *(LAS v4u*)((tensor == 0 ? QB16 : KB16) + c * WIMG_STRIDE + 16 * cg) = o;
                    if (tensor == 1) { *(LAS f32x4*)(KS + c * 128 + 8 * cg) = (f32x4){y[0], y[1], y[2], y[3]}; *(LAS f32x4*)(KS + c * 128 + 8 * cg + 4) = (f32x4){y[4], y[5], y[6], y[7]}; }
                } else { *(LAS f32x4*)(VS + c * 128 + 8 * cg) = (f32x4){y[0], y[1], y[2], y[3]}; *(LAS f32x4*)(VS + c * 128 + 8 * cg + 4) = (f32x4){y[4], y[5], y[6], y[7]}; }
            }
        } else if (wave == 7) {
            const float g = GG[(size_t)(m0 + lane) * GH + h], be = BETA[(size_t)(m0 + lane) * GH + h];
            float x = g;
#pragma unroll
            for (int o = 1; o < 64; o <<= 1) { const float t = __shfl_up(x, o); if (lane >= o) x += t; }
            const float gl = __shfl(x, 63);
            GC[lane] = x; GC[64 + lane] = be; GC[128 + lane] = expf(x); GC[192 + lane] = expf(gl - x);
            if (lane == 0) ((float*)(F.ws + WS_EGL))[ch] = expf(gl);
        }
        LDS_WAIT(); __syncthreads();
        {
            const int mat = wave >> 2, mt = (wave >> 1) & 1, nt = wave & 1, r = lane & 31, hh = lane >> 5;
            const LAS unsigned char* Asrc = (mat ? QB16 : KB16) + (32 * mt + r) * WIMG_STRIDE + 16 * hh;
            const LAS unsigned char* Bsrc = KB16 + (32 * nt + r) * WIMG_STRIDE + 16 * hh;
            f32x16 acc;
#pragma unroll
            for (int i = 0; i < 16; ++i) acc[i] = 0.f;
#pragma unroll
            for (int ks = 0; ks < 8; ++ks) { const bf16x8 a = *(const LAS bf16x8*)(Asrc + 32 * ks), bb = *(const LAS bf16x8*)(Bsrc + 32 * ks); acc = __builtin_amdgcn_mfma_f32_32x32x16_bf16(a, bb, acc, 0, 0, 0); }
            const int m = 32 * nt + r; const float gcm = GC[m];
#pragma unroll
            for (int i = 0; i < 16; ++i) {
                const int c = 32 * mt + (i & 3) + 8 * (i >> 2) + 4 * hh;
                if (mat == 0) AS[c * 64 + m] = (m > c) ? GC[64 + m] * acc[i] * expf(fminf(gcm - GC[c], 0.f)) : 0.f;
                else { const float v = (m <= c) ? acc[i] * expf(fminf(GC[c] - gcm, 0.f)) : 0.f; ATT[c * 64 + kpos(m)] = (unsigned short)(pkn(v, 0.f) & 0xffffu); }
            }
            const int c = tid >> 3, p0 = (tid & 7) * 16; const float eg = GC[128 + c];
            const LAS unsigned short* qrow = (const LAS unsigned short*)(QB16 + c * WIMG_STRIDE);
            float qv[16];
#pragma unroll
            for (int pp = 0; pp < 16; ++pp) qv[pp] = __uint_as_float((unsigned)qrow[p0 + 8 * ((pp & 7) >> 2) + 4 * (pp >> 3) + (pp & 3)] << 16) * eg;
            v4u o0, o1; o0.x = pkn(qv[0], qv[1]); o0.y = pkn(qv[2], qv[3]); o0.z = pkn(qv[4], qv[5]); o0.w = pkn(qv[6], qv[7]); o1.x = pkn(qv[8], qv[9]); o1.y = pkn(qv[10], qv[11]); o1.z = pkn(qv[12], qv[13]); o1.w = pkn(qv[14], qv[15]);
            v4u* qd = (v4u*)((bf16*)(F.ws + WS_QD) + (size_t)ch * 64 * 128 + c * 128 + p0); qd[0] = o0; qd[1] = o1;
        }
        LDS_WAIT(); __syncthreads();
        if (tid < 256) {
            const int col = tid & 127; const bool isw = tid >= 128;
            const LAS float* src = (isw ? KS : VS) + col;
            f32x2n xp[32];
#pragma unroll
            for (int k = 0; k < 32; ++k) { float v0 = src[(2 * k) * 128] * GC[64 + 2 * k], v1 = src[(2 * k + 1) * 128] * GC[64 + 2 * k + 1]; if (isw) { v0 *= GC[128 + 2 * k]; v1 *= GC[128 + 2 * k + 1]; } xp[k] = (f32x2n){v0, v1}; }
            f32x4 acur[8], anxt[8];
#pragma unroll
            for (int g = 0; g < 8; ++g) acur[g] = *(const LAS f32x4*)(AS + 4 * g);
#pragma unroll
            for (int k = 0; k < 94; ++k) {
                const int m = k < 62 ? (k >> 1) : k - 31, hf = k < 62 ? (k & 1) : 1;
                if (k + 1 < 94) { const int m2 = (k + 1) < 62 ? ((k + 1) >> 1) : (k + 1) - 31, hf2 = (k + 1) < 62 ? ((k + 1) & 1) : 1; const int g0 = ((m2 + 1) >> 2) > 8 * hf2 ? ((m2 + 1) >> 2) : 8 * hf2;
#pragma unroll
                    for (int g = g0; g < 8 * hf2 + 8; ++g) anxt[g - 8 * hf2] = *(const LAS f32x4*)(AS + m2 * 64 + 4 * g); }
                __builtin_amdgcn_sched_barrier(0);
                { const int p0 = ((m + 1) >> 1) > 16 * hf ? ((m + 1) >> 1) : 16 * hf;
#pragma unroll
                    for (int pr = p0; pr < 16 * hf + 16; ++pr) { const f32x4 a4 = acur[(pr >> 1) - 8 * hf]; const f32x2n a2 = (pr & 1) ? (f32x2n){a4[2], a4[3]} : (f32x2n){a4[0], a4[1]};
                        if (m & 1) asm("v_pk_fma_f32 %0, %1, %2, %0 op_sel:[0,1,0] op_sel_hi:[1,1,1] neg_lo:[1,0,0] neg_hi:[1,0,0]" : "+v"(xp[pr]) : "v"(a2), "v"(xp[m >> 1]));
                        else       asm("v_pk_fma_f32 %0, %1, %2, %0 op_sel:[0,0,0] op_sel_hi:[1,0,1] neg_lo:[1,0,0] neg_hi:[1,0,0]" : "+v"(xp[pr]) : "v"(a2), "v"(xp[m >> 1])); } }
#pragma unroll
                for (int g = 0; g < 8; ++g) acur[g] = anxt[g];
                __builtin_amdgcn_sched_barrier(0);
            }
            float x[64];
#pragma unroll
            for (int k = 0; k < 32; ++k) { x[2 * k] = xp[k][0]; x[2 * k + 1] = xp[k][1]; }
            if (!isw) { f32x4* up = (f32x4*)((float*)(F.ws + WS_UT) + (size_t)ch * 128 * 64 + col * 64);
#pragma unroll
                for (int c4 = 0; c4 < 16; ++c4) up[c4] = (f32x4){x[4 * c4], x[4 * c4 + 1], x[4 * c4 + 2], x[4 * c4 + 3]}; }
            else { LAS unsigned short* wi = (LAS unsigned short*)(IMG) + kpos(col);
#pragma unroll
                for (int c = 0; c < 64; ++c) wi[c * (WIMG_STRIDE / 2)] = (unsigned short)(pkn(-x[c], 0.f) & 0xffffu); }
        } else {
            const int t = tid - 256, d = t & 127, ph = t >> 7;
#pragma unroll
            for (int q8 = 0; q8 < 4; ++q8) { const int p0 = 32 * ph + 8 * q8; float kv[8];
#pragma unroll
                for (int jj = 0; jj < 8; ++jj) { const int c = (p0 & ~15) + 8 * (jj >> 2) + 4 * ((p0 >> 3) & 1) + (jj & 3); kv[jj] = KS[c * 128 + d] * GC[192 + c]; }
                v4u o; o.x = pkn(kv[0], kv[1]); o.y = pkn(kv[2], kv[3]); o.z = pkn(kv[4], kv[5]); o.w = pkn(kv[6], kv[7]);
                *(LAS v4u*)(IMG + KDIMG_OFF + d * KDIMG_STRIDE + 2 * p0) = o; }
            const LAS v4u* as = (const LAS v4u*)ATT + 2 * t; v4u* ag = (v4u*)((bf16*)(F.ws + WS_ATTN) + (size_t)ch * 4096) + 2 * t; ag[0] = as[0]; ag[1] = as[1];
        }
        LDS_WAIT(); __syncthreads();
        { v4u* rec = (v4u*)(F.ws + WS_REC + (size_t)ch * REC_BYTES);
            for (int i = tid; i < IMG_USED / 16; i += NTHREADS) rec[i] = *(const LAS v4u*)(IMG + 16 * i); }
        LDS_WAIT(); __syncthreads();
    }
}

__device__ __forceinline__ void gdn_scan_phase(Frame& F) {
    const int j = blockIdx.x; if (j >= 64) return;
    const int bh = j & 15, quarter = j >> 4;
    const int lane = F.lane, wave = F.wave, r = lane & 31, hh = lane >> 5;
    const unsigned char* REC = F.ws + WS_REC + (size_t)bh * 128 * REC_BYTES;
#define SCAN_BAR() do { asm volatile("s_waitcnt lgkmcnt(0)" ::: "memory"); __builtin_amdgcn_s_barrier(); asm volatile("" ::: "memory"); } while (0)
#define SCAN_DMA(n_) do { _Pragma("unroll") for (int k_ = 0; k_ < 6; ++k_) { const int piece_ = (wave - 1) + 6 * k_; \
        __builtin_amdgcn_global_load_lds((const unsigned*)(REC + (size_t)(n_) * REC_BYTES + piece_ * 1024 + lane * 16), (PG8_LAS unsigned*)(F.lds + ((n_) % 3) * REC_BYTES + piece_ * 1024), 16, 0, 0); } } while (0)
    if (wave == 7) { for (int n = 0; n < 129; ++n) SCAN_BAR(); }
    else if (wave >= 1) {
        SCAN_DMA(0); SCAN_DMA(1); VM_WAIT(); SCAN_BAR();
        for (int n = 0; n < 128; ++n) {
            if (n + 2 < 128) { SCAN_DMA(n + 2); asm volatile("s_waitcnt vmcnt(6)" ::: "memory"); }
            else VM_WAIT();
            SCAN_BAR();
        }
    } else {
        const int cw = quarter;
        const float* UT = (const float*)(F.ws + WS_UT) + (size_t)bh * 128 * (128 * 64) + (size_t)(32 * cw + r) * 64 + 4 * hh;
        v4u* SST = (v4u*)(F.ws + WS_SST) + (size_t)bh * 128 * (4 * 8 * 64) + (size_t)cw * (8 * 64) + lane;
        v4u* VST = (v4u*)(F.ws + WS_VST) + (size_t)bh * 128 * (4 * 4 * 64) + (size_t)cw * (4 * 64) + lane;
        const float* EGLp = (const float*)(F.ws + WS_EGL) + bh * 128;
        f32x16 S[4];
#pragma unroll
        for (int t = 0; t < 4; ++t)
#pragma unroll
            for (int i = 0; i < 16; ++i) S[t][i] = 0.f;
        unsigned sbw[8][4];
#pragma unroll
        for (int q = 0; q < 8; ++q)
#pragma unroll
            for (int w = 0; w < 4; ++w) sbw[q][w] = 0u;
#define SB_FRAG(q_) __builtin_bit_cast(bf16x8, (v4u){sbw[q_][0], sbw[q_][1], sbw[q_][2], sbw[q_][3]})
#define SB_PACK_QUARTER(t_, qq_) do { const int s_ = (qq_) >> 1, h_ = (qq_) & 1; \
        sbw[2 * (t_) + s_][2 * h_] = pkn(S[t_][8 * s_ + 4 * h_], S[t_][8 * s_ + 4 * h_ + 1]); sbw[2 * (t_) + s_][2 * h_ + 1] = pkn(S[t_][8 * s_ + 4 * h_ + 2], S[t_][8 * s_ + 4 * h_ + 3]); } while (0)
        SCAN_BAR();
        for (int n = 0; n < 128; ++n) {
            const LAS unsigned char* buf = F.lds + (n % 3) * REC_BYTES;
            f32x4 un[4]; f32x16 acc[2];
            { const float* up = UT + (size_t)n * (128 * 64);
#pragma unroll
                for (int q = 0; q < 4; ++q) un[q] = *(const f32x4*)(up + 8 * q);
#pragma unroll
                for (int q = 0; q < 4; ++q) { const f32x4 v = *(const f32x4*)(up + 32 + 8 * q); acc[1][4 * q] = v[0]; acc[1][4 * q + 1] = v[1]; acc[1][4 * q + 2] = v[2]; acc[1][4 * q + 3] = v[3]; } }
            const float egl = EGLp[n];
            const LAS unsigned char* wb = buf + r * WIMG_STRIDE + 16 * hh;
            const LAS unsigned char* kb = buf + KDIMG_OFF + r * KDIMG_STRIDE + 16 * hh;
#define SCAN_FRAG(i_) ((i_) < 16 ? *(const LAS bf16x8*)(wb + ((i_) >> 3) * 32 * WIMG_STRIDE + 32 * ((i_) & 7)) : *(const LAS bf16x8*)(kb + (((i_) - 16) >> 2) * 32 * KDIMG_STRIDE + 32 * (((i_) - 16) & 3)))
            bf16x8 ring[6];
#pragma unroll
            for (int i = 0; i < 6; ++i) ring[i] = SCAN_FRAG(i);
#pragma unroll
            for (int i = 0; i < 16; ++i) acc[0][i] = 0.f;
            __builtin_amdgcn_sched_barrier(0);
#pragma unroll
            for (int i = 0; i < 16; ++i) {
                acc[i >> 3] = __builtin_amdgcn_mfma_f32_32x32x16_bf16(ring[i % 6], SB_FRAG(i & 7), acc[i >> 3], 0, 0, 0);
                ring[i % 6] = SCAN_FRAG(i + 6);
                if (i < 4) SB_PACK_QUARTER(3, i);
                __builtin_amdgcn_sched_barrier(0);
            }
#pragma unroll
            for (int q = 0; q < 4; ++q) { acc[0][4 * q] += un[q][0]; acc[0][4 * q + 1] += un[q][1]; acc[0][4 * q + 2] += un[q][2]; acc[0][4 * q + 3] += un[q][3]; }
            bf16x8 Vb[4];
#pragma unroll
            for (int mt = 0; mt < 2; ++mt) { Vb[2 * mt] = pack_step(acc[mt], 0); Vb[2 * mt + 1] = pack_step(acc[mt], 1); }
#pragma unroll
            for (int ks = 0; ks < 4; ++ks) VST[(size_t)n * (4 * 4 * 64) + ks * 64] = __builtin_bit_cast(v4u, Vb[ks]);
#pragma unroll
            for (int ks = 0; ks < 8; ++ks) SST[(size_t)n * (4 * 8 * 64) + ks * 64] = (v4u){sbw[ks][0], sbw[ks][1], sbw[ks][2], sbw[ks][3]};
#pragma unroll
            for (int i = 0; i < 16; ++i) S[0][i] *= egl;
            __builtin_amdgcn_sched_barrier(0);
#pragma unroll
            for (int i = 16; i < 32; ++i) { const int t = (i - 16) >> 2, ks = (i - 16) & 3;
                S[t] = __builtin_amdgcn_mfma_f32_32x32x16_bf16(ring[i % 6], Vb[ks], S[t], 0, 0, 0);
                if (i + 6 < 32) ring[i % 6] = SCAN_FRAG(i + 6);
                if (t < 3) {
#pragma unroll
                    for (int e = 0; e < 4; ++e) S[t + 1][4 * ks + e] *= egl; }
                if (t >= 1) SB_PACK_QUARTER(t - 1, ks);
                __builtin_amdgcn_sched_barrier(0);
            }
#undef SCAN_FRAG
            SCAN_BAR();
        }
#undef SB_FRAG
#undef SB_PACK_QUARTER
    }
#undef SCAN_DMA
#undef SCAN_BAR
    VM_WAIT(); __syncthreads();
}

__device__ __forceinline__ void gdn_out_phase(Frame& F, const float* out_norm  ) {
    const bf16* PROJ = (const bf16*)(F.ws + WS_PROJ); bf16* Y = (bf16*)(F.ws + WS_Y);
    const int lane = F.lane, r = lane & 31, hh = lane >> 5;
    LAS float* ot = (LAS float*)(F.lds + F.wave * 16384);
    float gain[8];
    { const f32x4 a = *(const f32x4*)(out_norm + 8 * (lane & 15)), b = *(const f32x4*)(out_norm + 8 * (lane & 15) + 4);
        gain[0] = a[0]; gain[1] = a[1]; gain[2] = a[2]; gain[3] = a[3]; gain[4] = b[0]; gain[5] = b[1]; gain[6] = b[2]; gain[7] = b[3]; }
    for (int wu = F.gw; wu < 4096; wu += F.NGW) {
        const int ch = wu >> 1, mt = wu & 1, n = ch & 127, bh = ch >> 7, b = bh >> 3, h = bh & 7, m0 = b * SEQ + n * 64 + 32 * mt;
        const bf16* qd = (const bf16*)(F.ws + WS_QD) + (size_t)ch * 64 * 128 + (32 * mt + r) * 128 + 8 * hh;
        const bf16* at = (const bf16*)(F.ws + WS_ATTN) + (size_t)ch * 4096 + (32 * mt + r) * 64 + 8 * hh;
        const v4u* sst = (const v4u*)(F.ws + WS_SST) + (size_t)ch * (4 * 8 * 64) + lane;
        const v4u* vst = (const v4u*)(F.ws + WS_VST) + (size_t)ch * (4 * 4 * 64) + lane;
        bf16x8 qa[8], aa[4];
#pragma unroll
        for (int ks = 0; ks < 8; ++ks) qa[ks] = __builtin_bit_cast(bf16x8, *(const v4u*)(qd + 16 * ks));
#pragma unroll
        for (int ks = 0; ks < 4; ++ks) aa[ks] = __builtin_bit_cast(bf16x8, *(const v4u*)(at + 16 * ks));
#pragma unroll
        for (int nt = 0; nt < 4; ++nt) {
            f32x16 acc;
#pragma unroll
            for (int i = 0; i < 16; ++i) acc[i] = 0.f;
#pragma unroll
            for (int ks = 0; ks < 8; ++ks) acc = __builtin_amdgcn_mfma_f32_32x32x16_bf16(qa[ks], __builtin_bit_cast(bf16x8, sst[nt * (8 * 64) + ks * 64]), acc, 0, 0, 0);
#pragma unroll
            for (int ks = 0; ks < 4; ++ks) acc = __builtin_amdgcn_mfma_f32_32x32x16_bf16(aa[ks], __builtin_bit_cast(bf16x8, vst[nt * (4 * 64) + ks * 64]), acc, 0, 0, 0);
#pragma unroll
            for (int i = 0; i < 16; ++i) ot[((i & 3) + 8 * (i >> 2) + 4 * hh) * 128 + 32 * nt + r] = acc[i];
        }
        LDS_WAIT();
#pragma unroll 2
        for (int k = 0; k < 8; ++k) {
            const int row = 4 * k + (lane >> 4), chunk = lane & 15;
            const f32x4 o0 = *(const LAS f32x4*)(ot + row * 128 + 8 * chunk), o1 = *(const LAS f32x4*)(ot + row * 128 + 8 * chunk + 4);
            float zz[8]; unpack8(*(const v4u*)(PROJ + (size_t)(m0 + row) * NMIX + PC_Z + h * GD + 8 * chunk), zz);
            float ss = (o0[0] * o0[0] + o0[1] * o0[1]) + (o0[2] * o0[2] + o0[3] * o0[3]) + (o1[0] * o1[0] + o1[1] * o1[1]) + (o1[2] * o1[2] + o1[3] * o1[3]);
            ss += __shfl_xor(ss, 1); ss += __shfl_xor(ss, 2); ss += __shfl_xor(ss, 4); ss += __shfl_xor(ss, 8);
            const float rstd = 1.0f / sqrtf(ss * (1.0f / GD) + EPS);
            float y[8];
#pragma unroll
            for (int e = 0; e < 4; ++e) { y[e] = o0[e] * rstd * gain[e] * silu_f(zz[e]); y[4 + e] = o1[e] * rstd * gain[4 + e] * silu_f(zz[4 + e]); }
            v4u w; w.x = pkn(y[0], y[1]); w.y = pkn(y[2], y[3]); w.z = pkn(y[4], y[5]); w.w = pkn(y[6], y[7]);
            *(v4u*)(Y + (size_t)(m0 + row) * D + h * GD + 8 * chunk) = w;
        }
        LDS_WAIT();
    }
}

#ifndef GDN_REF
#define GDN_REF 0
#endif
#ifndef REPMASK
#define REPMASK 0u
#endif
__device__ __forceinline__ int nrep_opaque(int n) { asm volatile("" : "+s"(n)); return n; }
#define NREP(k) (((((REPMASK) >> (k)) & 1)) ? nrep_opaque(2) : 1)
#ifndef PHMASK
#define PHMASK 0xFFFFFFFFu
#endif
struct Args { const float* in[21]; float* out; unsigned char* ws; int pro_lo, pro_hi, l_lo, l_hi, ph_lo, ph_hi, one, fin; };
enum { PH_MIXIN = 3, PH_GDNPRE, PH_GDNSCAN, PH_OUTGATE, PH_MIXOUT, PH_SCORES, PH_ATTOUT, PH_UP, PH_SWIGLU, PH_DOWN, PH_END };

typedef const __attribute__((address_space(4))) Args* KArgP;
__device__ __forceinline__ KArgP kargs() { KArgP ap = (KArgP)__builtin_amdgcn_kernarg_segment_ptr(); asm volatile("" : "+s"(ap)); return ap; }
__device__ __forceinline__ Frame mkframe(KArgP ap, LAS unsigned char* lds) {
    Frame F; int t = threadIdx.x; asm volatile("" : "+v"(t));
    F.lds = lds; F.tid = t; F.lane = t & 63; F.wave = __builtin_amdgcn_readfirstlane(t >> 6);
    F.G = gridDim.x; F.gw = blockIdx.x * NWAVES + F.wave; F.NGW = F.G * NWAVES; F.ws = ap->ws;
    return F;
}
__global__ void __launch_bounds__(NTHREADS, 2) trunk_fwd(Args args) {
    extern __shared__ __attribute__((aligned(16))) unsigned char lds_raw[];
    LAS unsigned char* const lds = (LAS unsigned char*)lds_raw;
    for (int u = threadIdx.x; u < (LDS_BYTES - LDSCTL_OFF) / 4; u += NTHREADS) ((LAS unsigned*)(lds + LDSCTL_OFF))[u] = 0u;
    __syncthreads();
    XcdBarrier bar; bar.bar = (unsigned*)(args.ws + WS_CTL) + CW_BAR; bar.x = 0; bar.st = nullptr;
    const bool one = args.one != 0;
    if (one) bar = xcd_barrier_post((unsigned*)(args.ws + WS_CTL) + CW_BAR, (volatile LAS unsigned*)(lds + MISC_OFF) + 8);
#define SEAM() do { if (one) xcd_barrier(bar); } while (0)
#define PHASE_BEGIN() KArgP ap = kargs(); Frame F = mkframe(ap, lds); PG8_LAS unsigned char* ring = (PG8_LAS unsigned char*)(lds + RING_OFF); (void)ring; float* const XR = ap->out; (void)XR; \
    bf16* const HA = (bf16*)(F.ws + WS_H); (void)HA; bf16* const HB = (bf16*)(F.ws + WS_HB); (void)HB; float* const SSQ = (float*)(F.ws + WS_SSQ); (void)SSQ
#define PRO(k) ((((PHMASK) >> (k)) & 1) && args.pro_lo <= (k) && (k) < args.pro_hi)

    if (PRO(0)) {
        PHASE_BEGIN();
        for (int rep = 0; rep < NREP(0); ++rep) { if (rep) SEAM();
        p0_weights_x(F, ap->in[IN_W_XQ], ap->in[IN_W_XK], ap->in[IN_W_XV], ap->in[IN_W_XO]);
        p0_weights_main(F, 0, F.gw, F.NGW, ap->in[IN_W_MIX_IN], ap->in[IN_W_MIX_OUT], ap->in[IN_W_UP], ap->in[IN_W_DOWN]);
        p0_memn(F, ap->in[IN_MEM], ap->in[IN_MEM_NORM]);
        prenorm_phase(F, ap->in[IN_X], ap->in[IN_MIX_NORM], HB, SSQ); }
        SEAM();
    }
    if (PRO(1)) {
        PHASE_BEGIN();
        KvOrder S{F.G, (int)blockIdx.x, (const bf16*)(F.ws + WS_MEMN), (const bf16*)(F.ws + WS_WXK), (const bf16*)(F.ws + WS_WXV)};
        pg8::Gemm g{nullptr, nullptr, D, D, D};
        pg8::EpiBf16<LocKv, false> E{LocKv{(bf16*)(F.ws + WS_KX), (bf16*)(F.ws + WS_VX)}, 1.0f, nullptr};
        pg8::gemm_phase<pg8::EpiBf16<LocKv, false>, KvOrder, true>(ring, g, S, E);
        SEAM();
    }
    if (PRO(2)) {
        PHASE_BEGIN();
        PreOrder S{F.G, (int)blockIdx.x, (const bf16*)(F.ws + WS_KX), (const bf16*)(F.ws + WS_VX), (const bf16*)(F.ws + WS_WXQ), (const bf16*)(F.ws + WS_WXO)};
        pg8::Gemm g{nullptr, nullptr, D, D, XD};
        pg8::EpiBf16<LocPre, false> E{LocPre{(bf16*)(F.ws + WS_WQK), (bf16*)(F.ws + WS_VWO)}, 1.0f, nullptr};
        pg8::gemm_phase<pg8::EpiBf16<LocPre, false>, PreOrder, true>(ring, g, S, E);
        SEAM();
    }
    const int lo = args.ph_lo, hi = args.ph_hi;
#define IN(k) ((((PHMASK) >> (k)) & 1) && lo <= (k) && (k) < hi)
    for (int l = args.l_lo; l < args.l_hi; ++l) {
        if (IN(PH_MIXIN)) {
            PHASE_BEGIN();
            ba_phase(F, HB, SSQ + (size_t)(3 * l) * M, (const bf16*)(F.ws + WS_WBA) + (size_t)l * 16 * D, ap->in[IN_A_LOG] + l * GH, ap->in[IN_DT_BIAS] + l * GH);
            pg8::Gemm g{HB, (const bf16*)(F.ws + WS_WMIX) + (size_t)l * NMIX * D, D, D, D}; pg8::StaticOrder S; S.init(M, NMIX, F.G, (int)blockIdx.x);
            pg8::EpiBf16<pg8::LocPlain, true> E{pg8::LocPlain{(bf16*)(F.ws + WS_PROJ), NMIX}, 1.0f, SSQ + (size_t)(3 * l) * M};
            for (int rep = 0; rep < NREP(3); ++rep) { if (rep) SEAM();
            pg8::gemm_phase<pg8::EpiBf16<pg8::LocPlain, true>, pg8::StaticOrder, true>(ring, g, S, E); }
            SEAM();
        }
        if (IN(PH_GDNPRE)) { PHASE_BEGIN(); for (int rep = 0; rep < NREP(4); ++rep) { if (rep) SEAM(); gdn_prep_phase(F, ap->in[IN_GDN_CONV] + (size_t)l * 4 * 3 * GW); } SEAM(); }
        if (IN(PH_GDNSCAN)) {
            PHASE_BEGIN();
            if (blockIdx.x < 64 || F.G <= 64) { for (int rep = 0; rep < NREP(5); ++rep) { if (rep) SEAM(); gdn_scan_phase(F); } }
            if (F.G <= 64) shortconv_phase(F, ap->in[IN_SC_CONV] + (size_t)l * 3 * SCW, F.gw, F.NGW);
            else if (blockIdx.x >= 64) shortconv_phase(F, ap->in[IN_SC_CONV] + (size_t)l * 3 * SCW, F.gw - 64 * NWAVES, F.NGW - 64 * NWAVES);
            if (l + 1 < DEPTH) { if (F.G <= 64) p0_weights_main(F, l + 1, F.gw, F.NGW, ap->in[IN_W_MIX_IN], ap->in[IN_W_MIX_OUT], ap->in[IN_W_UP], ap->in[IN_W_DOWN]);
                else if (blockIdx.x >= 64) p0_weights_main(F, l + 1, F.gw - 64 * NWAVES, F.NGW - 64 * NWAVES, ap->in[IN_W_MIX_IN], ap->in[IN_W_MIX_OUT], ap->in[IN_W_UP], ap->in[IN_W_DOWN]); }
            SEAM(); }
        if (IN(PH_OUTGATE)) { PHASE_BEGIN(); for (int rep = 0; rep < NREP(6); ++rep) { if (rep) SEAM(); gdn_out_phase(F, ap->in[IN_OUT_NORM] + (size_t)l * GD); } SEAM(); }
        if (IN(PH_MIXOUT)) {
            PHASE_BEGIN();
            pg8::Gemm g{(const bf16*)(F.ws + WS_Y), (const bf16*)(F.ws + WS_WOUT) + (size_t)l * D * D, D, D, D}; pg8::StaticOrder S; S.init(M, D, F.G, (int)blockIdx.x);
            pg8::EpiResNorm E{l == 0 ? ap->in[IN_X] : XR, XR, D, HA, ap->in[IN_XATTN_NORM] + (size_t)l * D, SSQ + (size_t)(3 * l + 1) * M};
            if (NREP(7) > 1) { pg8::EpiResNorm E0 = E; E0.out = (float*)(F.ws + WS_BIG); E0.hn = (pg8::bf16_t*)(F.ws + WS_BIG + 160 * MiB); E0.ssq = (float*)(F.ws + WS_BIG + 256 * MiB);
            pg8::gemm_phase<pg8::EpiResNorm, pg8::StaticOrder, true>(ring, g, S, E0); SEAM(); }
            pg8::gemm_phase<pg8::EpiResNorm, pg8::StaticOrder, true>(ring, g, S, E);
            SEAM();
        }
        if (IN(PH_SCORES)) {
            PHASE_BEGIN();
            pg8::Gemm g{HA, (const bf16*)(F.ws + WS_WQK) + (size_t)l * 2 * (XH * NMEM) * D, D, D, D}; SOrder S{F.G, (int)blockIdx.x};
            pg8::EpiSoftmax E{(bf16*)(F.ws + WS_PB), XH * NMEM, 0.044194173824159216f * 1.4426950408889634f, SSQ + (size_t)(3 * l + 1) * M};
            for (int rep = 0; rep < NREP(8); ++rep) { if (rep) SEAM();
            pg8::gemm_phase<pg8::EpiSoftmax, SOrder, false>(ring, g, S, E); }
            SEAM();
        }
        if (IN(PH_ATTOUT)) {
            PHASE_BEGIN();
            pg8::Gemm g{(const bf16*)(F.ws + WS_PB), (const bf16*)(F.ws + WS_VWO) + (size_t)l * 2 * D * (XH * NMEM), XH * NMEM, XH * NMEM, XH * NMEM};
            BatchOrder S; S.init(M, D, F.G, (int)blockIdx.x); S.bstride = (size_t)D * (XH * NMEM);
            pg8::EpiResNorm E{XR, XR, D, HA, ap->in[IN_FFN_NORM] + (size_t)l * D, SSQ + (size_t)(3 * l + 2) * M};
            if (NREP(9) > 1) { pg8::EpiResNorm E0 = E; E0.out = (float*)(F.ws + WS_BIG); E0.hn = (pg8::bf16_t*)(F.ws + WS_BIG + 160 * MiB); E0.ssq = (float*)(F.ws + WS_BIG + 256 * MiB);
            pg8::gemm_phase<pg8::EpiResNorm, BatchOrder, true>(ring, g, S, E0); SEAM(); }
            pg8::gemm_phase<pg8::EpiResNorm, BatchOrder, true>(ring, g, S, E);
            SEAM();
        }
        if (IN(PH_UP)) {
            PHASE_BEGIN();
            pg8::Gemm g{HA, (const bf16*)(F.ws + WS_WUP) + (size_t)l * 2 * DFF * D, D, D, D}; pg8::StaticOrder S; S.init(M, 2 * DFF, F.G, (int)blockIdx.x);
            pg8::EpiSwiglu E{(bf16*)(F.ws + WS_ACT), (float*)(F.ws + WS_PART), (float*)(F.ws + WS_HALO), ap->in[IN_FFN_CONV] + (size_t)l * 3 * 2 * DFF, SSQ + (size_t)(3 * l + 2) * M, (PG8_LAS float*)(lds + XB_OFF), DFF};
            pg8::gemm_phase<pg8::EpiSwiglu, pg8::StaticOrder, true>(ring, g, S, E);
            SEAM();
        }
        if (IN(PH_SWIGLU)) { PHASE_BEGIN(); swiglu_fix_phase(F, ap->in[IN_FFN_CONV] + (size_t)l * 3 * 2 * DFF); SEAM(); }
        if (IN(PH_DOWN)) {
            PHASE_BEGIN();
            pg8::Gemm g{(const bf16*)(F.ws + WS_ACT), (const bf16*)(F.ws + WS_WDN) + (size_t)l * D * DFF, DFF, DFF, DFF}; pg8::StaticOrder S; S.init(M, D, F.G, (int)blockIdx.x);
            const bool last = l + 1 >= DEPTH;
            pg8::EpiResNorm E{XR, XR, D, last ? nullptr : HB, ap->in[IN_MIX_NORM] + (size_t)(last ? l : l + 1) * D, SSQ + (size_t)(last ? 0 : 3 * (l + 1)) * M};
            if (NREP(12) > 1) { pg8::EpiResNorm E0 = E; E0.out = (float*)(F.ws + WS_BIG); E0.hn = (pg8::bf16_t*)(F.ws + WS_BIG + 160 * MiB); E0.ssq = (float*)(F.ws + WS_BIG + 256 * MiB);
            pg8::gemm_phase<pg8::EpiResNorm, pg8::StaticOrder, true>(ring, g, S, E0); SEAM(); }
            pg8::gemm_phase<pg8::EpiResNorm, pg8::StaticOrder, true>(ring, g, S, E);
            SEAM();
        }
    }
    if ((((PHMASK) >> 30) & 1) && args.fin) { PHASE_BEGIN(); final_norm_phase(F, XR, ap->in[IN_FINAL_NORM], ap->out); }
#undef IN
#undef PRO
#undef SEAM
#undef PHASE_BEGIN
}

extern "C" void kernel_launch(void* const* d_in, const int* in_sizes, int n_in, void* d_out, int out_size, void* d_ws, size_t ws_size, hipStream_t stream) {
    static int grid = 0;
    if (grid == 0) {
        if (n_in != 21 || in_sizes[0] != M * D || out_size != M * D || ws_size < WS_END) { fprintf(stderr, "kernel_launch: unexpected shapes / workspace (n_in %d, in0 %d, out %d, ws %zu < %zu); nothing launched\n", n_in, n_in > 0 ? in_sizes[0] : -1, out_size, ws_size, (size_t)WS_END); grid = -1; return; }
        int dev = 0, cus = 0, per_cu = 0;
        if (hipGetDevice(&dev) != hipSuccess || hipDeviceGetAttribute(&cus, hipDeviceAttributeMultiprocessorCount, dev) != hipSuccess) { fprintf(stderr, "kernel_launch: device query failed\n"); grid = -1; return; }
        if (hipFuncSetAttribute((const void*)trunk_fwd, hipFuncAttributeMaxDynamicSharedMemorySize, LDS_BYTES) != hipSuccess) { fprintf(stderr, "kernel_launch: hipFuncSetAttribute failed\n"); grid = -1; return; }
        if (hipOccupancyMaxActiveBlocksPerMultiprocessor(&per_cu, (const void*)trunk_fwd, NTHREADS, LDS_BYTES) != hipSuccess || per_cu < 1)
            fprintf(stderr, "kernel_launch: note: occupancy query reports %d workgroups per CU\n", per_cu);
        (void)hipGetLastError();
        if (cus != 256) { fprintf(stderr, "kernel_launch: built for 256 CUs, device has %d; nothing launched\n", cus); grid = -1; return; }
        grid = cus;
    }
    if (grid < 0) return;
    if (hipMemsetAsync((char*)d_ws + WS_CTL, 0, CTL_ZERO_BYTES, stream) != hipSuccess) { fprintf(stderr, "kernel_launch: memset failed\n"); return; }
    Args a{};
    for (int i = 0; i < 21; ++i) a.in[i] = (const float*)d_in[i];
    a.out = (float*)d_out; a.ws = (unsigned char*)d_ws;
#if MK_ONE_LAUNCH
    a.pro_lo = 0; a.pro_hi = 3; a.l_lo = 0; a.l_hi = DEPTH; a.ph_lo = PH_MIXIN; a.ph_hi = PH_END; a.one = 1; a.fin = 1;
    hipLaunchKernelGGL(trunk_fwd, dim3(grid), dim3(NTHREADS), LDS_BYTES, stream, a);
#else
    a.one = 0; a.fin = 0; a.l_lo = 0; a.l_hi = 0; a.ph_lo = 0; a.ph_hi = 0;
    for (int p = 0; p < 3; ++p) { a.pro_lo = p; a.pro_hi = p + 1; hipLaunchKernelGGL(trunk_fwd, dim3(grid), dim3(NTHREADS), LDS_BYTES, stream, a); }
    a.pro_lo = 0; a.pro_hi = 0;
    for (int l = 0; l < DEPTH; ++l)
        for (int p = PH_MIXIN; p < PH_END; ++p) { a.l_lo = l; a.l_hi = l + 1; a.ph_lo = p; a.ph_hi = p + 1;
            hipLaunchKernelGGL(trunk_fwd, dim3(grid), dim3(NTHREADS), LDS_BYTES, stream, a); }
    a.l_lo = 0; a.l_hi = 0; a.fin = 1;
    hipLaunchKernelGGL(trunk_fwd, dim3(grid), dim3(NTHREADS), LDS_BYTES, stream, a);
#endif
    const hipError_t le = hipPeekAtLastError();
    if (le != hipSuccess) fprintf(stderr, "kernel_launch: launch failed: %s\n", hipGetErrorName(le));
}
```

```cpp
#define MK_ONE_LAUNCH 1
#include <hip/hip_runtime.h>
#include <cstdio>
#include <cstdint>

#ifndef MK_ONE_LAUNCH
#define MK_ONE_LAUNCH 1
#endif

namespace pg8 {
#define PG8_LAS __attribute__((address_space(3)))
typedef unsigned short bf16_t;
typedef short bf16x8 __attribute__((ext_vector_type(8)));
typedef float f32x4 __attribute__((ext_vector_type(4)));
typedef float f32x2 __attribute__((ext_vector_type(2)));
typedef unsigned u32x4 __attribute__((ext_vector_type(4)));
constexpr int BM = 256, BK = 64, HALF = 128, HTB = HALF * BK * 2  , STAGE_BYTES = 8 * HTB, NXCD = 8, WGM = 8;

__host__ __device__ __forceinline__ int lds_byte(int r, int c) { const int st = (r >> 4) * 2 + (c >> 5), rr = r & 15, cc = c & 31, ob = rr * 64 + cc * 2; return st * 1024 + (ob ^ (((ob >> 9) & 1) << 5)); }
__host__ __device__ __forceinline__ void stage_rc(int b, int& R, int& C) { const int st = b / 1024, sb = b % 1024, swz = sb ^ (((sb >> 9) & 1) << 5); R = (st >> 1) * 16 + swz / 64; C = (st & 1) * 32 + (swz % 64) / 2; }
__host__ __device__ __forceinline__ int perm32(int rho) { const int n = rho >> 4, i = rho & 15; return 8 * (i >> 2) + 4 * n + (i & 3); }

struct Unit { int pm, pn; };
struct Gemm { const bf16_t* A; const bf16_t* Bt; int lda, ldb, K; };

struct StaticOrder {
    int nM, nN, nwg, G, c;
    __host__ __device__ void init(int M, int N, int G_, int c_) { nM = M / BM; nN = N / BM; nwg = nM * nN; G = G_; c = c_; }
    __host__ __device__ bool next(int i, Unit& u) const {
        const long L = (long)i * G + c; if (L >= nwg) return false;
        int wgid = (int)L; { const int q = nwg / NXCD, r = nwg % NXCD, xcd = wgid % NXCD, off = wgid / NXCD; wgid = (xcd < r ? xcd * (q + 1) : r * (q + 1) + (xcd - r) * q) + off; }
        const int nig = WGM * nN, gid = wgid / nig, fm = gid * WGM, gsz = (nM - fm) < WGM ? (nM - fm) : WGM;
        u.pm = fm + ((wgid % nig) % gsz); u.pn = (wgid % nig) / gsz; return true;
    }
    __device__ __forceinline__ const char* pa(const Gemm& g, const Unit& u) const { return (const char*)g.A + (size_t)u.pm * BM * g.lda * 2; }
    __device__ __forceinline__ const char* pb(const Gemm& g, const Unit& u) const { return (const char*)g.Bt + (size_t)u.pn * BM * g.ldb * 2; }
};

__device__ __forceinline__ unsigned cvt_pk_bf16(float lo, float hi) { unsigned r; asm volatile("v_cvt_pk_bf16_f32 %0, %1, %2" : "=v"(r) : "v"(lo), "v"(hi)); return r; }


template <class Loc, bool RS  > struct EpiBf16 {
    static constexpr bool PERM = true, AFTER_DRAIN = false;
    Loc loc; float scale; const float* ssq;
    __device__ __forceinline__ void operator()(const f32x4 (&acc)[2][2][4][2], const Unit& u, int wr, int wc, int fr, int fq) const {
        bf16_t* base; int ldc; loc(u, base, ldc);
        const int row0 = wr * 64 + fr, col0 = wc * 32 + 8 * fq;
        float sc[2][4];
#pragma unroll
        for (int ai = 0; ai < 2; ++ai)
#pragma unroll
            for (int m = 0; m < 4; ++m) sc[ai][m] = RS ? ssq[u.pm * BM + row0 + ai * HALF + m * 16] : 0.f;
#pragma unroll
        for (int ai = 0; ai < 2; ++ai)
#pragma unroll
            for (int m = 0; m < 4; ++m) sc[ai][m] = RS ? this->scale * (1.0f / sqrtf(sc[ai][m] * (1.0f / 2048.0f) + 1e-6f)) : this->scale;
#pragma unroll
        for (int ai = 0; ai < 2; ++ai)
#pragma unroll
            for (int m = 0; m < 4; ++m) { bf16_t* rowp = base + (size_t)(row0 + ai * HALF + m * 16) * ldc + col0;
                const float scale = sc[ai][m];
#pragma unroll
                for (int bj = 0; bj < 2; ++bj) { f32x4 v0 = acc[ai][bj][m][0] * scale, v1 = acc[ai][bj][m][1] * scale;
                    u32x4 w; w.x = cvt_pk_bf16(v0[0], v0[1]); w.y = cvt_pk_bf16(v0[2], v0[3]); w.z = cvt_pk_bf16(v1[0], v1[1]); w.w = cvt_pk_bf16(v1[2], v1[3]);
                    *(u32x4*)(rowp + bj * HALF) = w; } }
    }
};
struct EpiNull { static constexpr bool PERM = true, AFTER_DRAIN = false;
    __device__ __forceinline__ void operator()(const f32x4 (&acc)[2][2][4][2], const Unit&, int, int, int, int) const {
#pragma unroll
        for (int ai = 0; ai < 2; ++ai)
#pragma unroll
            for (int bj = 0; bj < 2; ++bj)
#pragma unroll
                for (int m = 0; m < 4; ++m)
#pragma unroll
                    for (int n = 0; n < 2; ++n) asm volatile("" :: "v"(acc[ai][bj][m][n])); } };
struct LocPlain { bf16_t* O; int ldc; __device__ __forceinline__ void operator()(const Unit& u, bf16_t*& base, int& ld) const { base = O + (size_t)u.pm * BM * ldc + (size_t)u.pn * BM; ld = ldc; } };

struct EpiResNorm {
    static constexpr bool PERM = true, AFTER_DRAIN = false;
    const float* res; float* out; int ldc; bf16_t* hn; const float* gain; float* ssq;
    __device__ __forceinline__ void operator()(const f32x4 (&acc)[2][2][4][2], const Unit& u, int wr, int wc, int fr, int fq) const {
        const int row0 = u.pm * BM + wr * 64 + fr, col0 = u.pn * BM + wc * 32 + 8 * fq;
        f32x4 g4[2][2];
        if (hn) {
#pragma unroll
            for (int bj = 0; bj < 2; ++bj)
#pragma unroll
                for (int n = 0; n < 2; ++n) g4[bj][n] = *(const f32x4*)(gain + col0 + bj * HALF + 4 * n); }
        f32x4 cur[2][2], nxt[2][2];
#pragma unroll
        for (int bj = 0; bj < 2; ++bj)
#pragma unroll
            for (int n = 0; n < 2; ++n) cur[bj][n] = *(const f32x4*)(res + (size_t)row0 * ldc + col0 + bj * HALF + 4 * n);
#pragma unroll
        for (int it = 0; it < 8; ++it) { const int ai = it >> 2, m = it & 3; const int row = row0 + ai * HALF + m * 16; const size_t off = (size_t)row * ldc + col0;
            if (it < 7) { const size_t off2 = (size_t)(row0 + ((it + 1) >> 2) * HALF + ((it + 1) & 3) * 16) * ldc + col0;
#pragma unroll
                for (int bj = 0; bj < 2; ++bj)
#pragma unroll
                    for (int n = 0; n < 2; ++n) nxt[bj][n] = *(const f32x4*)(res + off2 + bj * HALF + 4 * n); }
            __builtin_amdgcn_sched_barrier(0);
            f32x4 x[2][2]; float ss = 0.f;
#pragma unroll
            for (int bj = 0; bj < 2; ++bj)
#pragma unroll
                for (int n = 0; n < 2; ++n) { x[bj][n] = cur[bj][n] + acc[ai][bj][m][n]; *(f32x4*)(out + off + bj * HALF + 4 * n) = x[bj][n];
                    ss += (x[bj][n][0] * x[bj][n][0] + x[bj][n][1] * x[bj][n][1]) + (x[bj][n][2] * x[bj][n][2] + x[bj][n][3] * x[bj][n][3]); }
            if (hn) {
#pragma unroll
                for (int bj = 0; bj < 2; ++bj) { const f32x4 v0 = x[bj][0] * g4[bj][0], v1 = x[bj][1] * g4[bj][1];
                    u32x4 w; w.x = cvt_pk_bf16(v0[0], v0[1]); w.y = cvt_pk_bf16(v0[2], v0[3]); w.z = cvt_pk_bf16(v1[0], v1[1]); w.w = cvt_pk_bf16(v1[2], v1[3]);
                    *(u32x4*)(hn + off + bj * HALF) = w; }
                ss += __shfl_xor(ss, 16); ss += __shfl_xor(ss, 32);
                if (fq == 0) atomicAdd(ssq + row, ss);
            }
#pragma unroll
            for (int bj = 0; bj < 2; ++bj)
#pragma unroll
                for (int n = 0; n < 2; ++n) cur[bj][n] = nxt[bj][n];
            __builtin_amdgcn_sched_barrier(0);
        }
    }
};

struct EpiSoftmax {
    static constexpr bool PERM = true, AFTER_DRAIN = true;
    bf16_t* P; int ldc; float sl2e; const float* ssq;
    __device__ __forceinline__ void fused(f32x4 (&acc)[2][2][4][2], const Unit& u, int wr, int wc, int fr, int fq, PG8_LAS unsigned char* lds, int wid, int lane) const {
        PG8_LAS float* Pm = (PG8_LAS float*)lds;
        PG8_LAS float* Ps = (PG8_LAS float*)(lds + 4096);
        float rs[2][4];
#pragma unroll
        for (int ai = 0; ai < 2; ++ai)
#pragma unroll
            for (int m = 0; m < 4; ++m) rs[ai][m] = ssq[u.pm * BM + ai * HALF + wr * 64 + m * 16 + fr];
#pragma unroll
        for (int ai = 0; ai < 2; ++ai)
#pragma unroll
            for (int m = 0; m < 4; ++m) {
                float mx = -3.0e38f;
#pragma unroll
                for (int bj = 0; bj < 2; ++bj)
#pragma unroll
                    for (int n = 0; n < 2; ++n) { const f32x4 x = acc[ai][bj][m][n]; mx = fmaxf(mx, fmaxf(fmaxf(x[0], x[1]), fmaxf(x[2], x[3]))); }
                mx = fmaxf(mx, __shfl_xor(mx, 16)); mx = fmaxf(mx, __shfl_xor(mx, 32));
                if (fq == 0) Pm[(ai * HALF + wr * 64 + m * 16 + fr) * 4 + wc] = mx;
            }
        asm volatile("s_waitcnt lgkmcnt(0)" ::: "memory"); __builtin_amdgcn_s_barrier(); asm volatile("" ::: "memory");
#pragma unroll
        for (int ai = 0; ai < 2; ++ai)
#pragma unroll
            for (int m = 0; m < 4; ++m) {
                const int row = ai * HALF + wr * 64 + m * 16 + fr;
                const f32x4 pm4 = *(const PG8_LAS f32x4*)(Pm + row * 4);
                const float gm = fmaxf(fmaxf(pm4[0], pm4[1]), fmaxf(pm4[2], pm4[3]));
                const float sl2e = this->sl2e * (1.0f / sqrtf(rs[ai][m] * (1.0f / 2048.0f) + 1e-6f));
                float s = 0.f;
#pragma unroll
                for (int bj = 0; bj < 2; ++bj)
#pragma unroll
                    for (int n = 0; n < 2; ++n) { f32x4 x = acc[ai][bj][m][n];
#pragma unroll
                        for (int j = 0; j < 4; ++j) { x[j] = __builtin_amdgcn_exp2f((x[j] - gm) * sl2e); s += x[j]; }
                        acc[ai][bj][m][n] = x; }
                s += __shfl_xor(s, 16); s += __shfl_xor(s, 32);
                if (fq == 0) Ps[row * 4 + wc] = s;
            }
        asm volatile("s_waitcnt lgkmcnt(0)" ::: "memory"); __builtin_amdgcn_s_barrier(); asm volatile("" ::: "memory");
        bf16_t* base = P + (size_t)u.pm * BM * ldc + (size_t)u.pn * BM;
#pragma unroll
        for (int ai = 0; ai < 2; ++ai)
#pragma unroll
            for (int m = 0; m < 4; ++m) {
                const int row = ai * HALF + wr * 64 + m * 16 + fr;
                const f32x4 ps4 = *(const PG8_LAS f32x4*)(Ps + row * 4);
                const float inv = 1.0f / ((ps4[0] + ps4[1]) + (ps4[2] + ps4[3]));
                bf16_t* rowp = base + (size_t)row * ldc + wc * 32 + 8 * fq;
#pragma unroll
                for (int bj = 0; bj < 2; ++bj) { const f32x4 v0 = acc[ai][bj][m][0] * inv, v1 = acc[ai][bj][m][1] * inv;
                    u32x4 w; w.x = cvt_pk_bf16(v0[0], v0[1]); w.y = cvt_pk_bf16(v0[2], v0[3]); w.z = cvt_pk_bf16(v1[0], v1[1]); w.w = cvt_pk_bf16(v1[2], v1[3]);
                    *(u32x4*)(rowp + bj * HALF) = w; }
            }
    }
};

__device__ __forceinline__ float dpp_ror1(float v) { return __builtin_bit_cast(float, __builtin_amdgcn_update_dpp(0, __builtin_bit_cast(int, v), 0x121, 0xf, 0xf, false)); }
__device__ __forceinline__ float dpp_ror2(float v) { return __builtin_bit_cast(float, __builtin_amdgcn_update_dpp(0, __builtin_bit_cast(int, v), 0x122, 0xf, 0xf, false)); }
struct EpiSwiglu {
    static constexpr bool PERM = true, AFTER_DRAIN = false;
    bf16_t* act; float* part; float* halo; const float* cw; const float* ssq; PG8_LAS float* xb; int dff;
    __device__ __forceinline__ void operator()(f32x4 (&acc)[2][2][4][2], const Unit& u, int wr, int wc, int fr, int fq) const {
        const int ccol = wc * 32 + 8 * fq;
#pragma unroll
        for (int ai = 0; ai < 2; ++ai)
#pragma unroll
            for (int m = 0; m < 4; ++m) { const float sc = 1.0f / sqrtf(ssq[u.pm * BM + ai * HALF + wr * 64 + m * 16 + fr] * (1.0f / 2048.0f) + 1e-6f);
#pragma unroll
                for (int bj = 0; bj < 2; ++bj)
#pragma unroll
                    for (int n = 0; n < 2; ++n) acc[ai][bj][m][n] = acc[ai][bj][m][n] * sc; }
        if (fr >= 14) {
#pragma unroll
            for (int ai = 0; ai < 2; ++ai)
#pragma unroll
                for (int bj = 0; bj < 2; ++bj)
#pragma unroll
                    for (int n = 0; n < 2; ++n) { *(PG8_LAS f32x4*)(xb + ((wr * 2 + ai) * 2 + (fr - 14)) * 256 + bj * HALF + ccol + 4 * n) = acc[ai][bj][3][n];
                        if (wr == 1 && ai == 1) *(f32x4*)(halo + ((size_t)(u.pm * 2 + (fr - 14)) * 2 + bj) * dff + u.pn * HALF + ccol + 4 * n) = acc[1][bj][3][n]; }
        }
        asm volatile("s_waitcnt lgkmcnt(0)" ::: "memory"); __builtin_amdgcn_s_barrier(); asm volatile("" ::: "memory");
#pragma unroll
        for (int n = 0; n < 2; ++n) {
            const int ch = u.pn * HALF + ccol + 4 * n;
            f32x4 wg[3], wu[3];
#pragma unroll
            for (int t = 0; t < 3; ++t) { wg[t] = *(const f32x4*)(cw + (size_t)t * 2 * dff + ch); wu[t] = *(const f32x4*)(cw + (size_t)t * 2 * dff + dff + ch); }
#pragma unroll
            for (int ai = 0; ai < 2; ++ai) {
                f32x4 c1g = {0.f, 0.f, 0.f, 0.f}, c2g = c1g, c1u = c1g, c2u = c1g;
                if (ai + wr > 0) { const int sw = wr ^ 1, sa = wr == 0 ? ai - 1 : ai; const PG8_LAS float* xp = xb + ((sw * 2 + sa) * 2) * 256 + ccol + 4 * n;
                    const f32x4 e0g = *(const PG8_LAS f32x4*)(xp), e1g = *(const PG8_LAS f32x4*)(xp + 256), e0u = *(const PG8_LAS f32x4*)(xp + HALF), e1u = *(const PG8_LAS f32x4*)(xp + 256 + HALF);
                    c1g = e1g; c1u = e1u;
#pragma unroll
                    for (int j = 0; j < 4; ++j) { c2g[j] = fr == 0 ? e0g[j] : e1g[j]; c2u[j] = fr == 0 ? e0u[j] : e1u[j]; } }
#pragma unroll
                for (int m = 0; m < 4; ++m) {
                    const f32x4 G = acc[ai][0][m][n], U = acc[ai][1][m][n];
                    f32x4 r1g, r2g, r1u, r2u, cg, cu;
#pragma unroll
                    for (int j = 0; j < 4; ++j) { r1g[j] = dpp_ror1(G[j]); r2g[j] = dpp_ror2(G[j]); r1u[j] = dpp_ror1(U[j]); r2u[j] = dpp_ror2(U[j]);
                        const float p1g = fr == 0 ? c1g[j] : r1g[j], p2g = fr < 2 ? c2g[j] : r2g[j], p1u = fr == 0 ? c1u[j] : r1u[j], p2u = fr < 2 ? c2u[j] : r2u[j];
                        cg[j] = wg[2][j] * G[j] + wg[1][j] * p1g + wg[0][j] * p2g; cu[j] = wu[2][j] * U[j] + wu[1][j] * p1u + wu[0][j] * p2u; }
                    c1g = r1g; c2g = r2g; c1u = r1u; c2u = r2u;
                    const int row = u.pm * BM + ai * HALF + wr * 64 + m * 16 + fr;
                    if (ai == 0 && m == 0 && wr == 0 && fr < 2) {
                        *(f32x4*)(part + ((size_t)(u.pm * 2 + fr) * 2 + 0) * dff + ch) = cg; *(f32x4*)(part + ((size_t)(u.pm * 2 + fr) * 2 + 1) * dff + ch) = cu;
                    } else {
                        f32x4 a;
#pragma unroll
                        for (int j = 0; j < 4; ++j) a[j] = cg[j] / (1.0f + __expf(-cg[j])) * cu[j];
                        typedef unsigned u32x2 __attribute__((ext_vector_type(2)));
                        u32x2 w; w.x = cvt_pk_bf16(a[0], a[1]); w.y = cvt_pk_bf16(a[2], a[3]);
                        *(u32x2*)(act + (size_t)row * dff + ch) = w;
                    }
                }
            }
        }
    }
};

template <class Epi, class Sched, bool ALIGN_EPI = false>
__device__ __forceinline__ void gemm_phase(PG8_LAS unsigned char* lds, const Gemm g, const Sched& S, const Epi& E) {
    int tid_ = threadIdx.x; asm volatile("" : "+v"(tid_));
    const int tid = tid_, wid = __builtin_amdgcn_readfirstlane(tid >> 6), lane = tid & 63, wr = wid >> 2, wc = wid & 3, fr = lane & 15, fq = lane >> 4;
    const int K = g.K, nt = K / BK;
    unsigned voffA[2], voffB[2];
#pragma unroll
    for (int i = 0; i < 2; ++i) { int R, C; stage_rc(tid * 16 + i * 8192, R, C); const int Rb = Epi::PERM ? ((R & ~31) + perm32(R & 31)) : R;
        voffA[i] = (unsigned)(R * g.lda + C) * 2u; voffB[i] = (unsigned)(Rb * g.ldb + C) * 2u; }
    const size_t kstep = (size_t)(BK * 2);
    const size_t hstepA = (size_t)HALF * g.lda * 2, hstepB = (size_t)HALF * g.ldb * 2;
    const unsigned ldsw = (unsigned)wid * 1024u;
    const int aoff = lds_byte(wr * 64 + fr, fq * 8), boff = lds_byte(wc * 32 + fr, fq * 8);
#define PG8_SA(b, h) (((b) * 2 + (h)) * HTB)
#define PG8_SB(b, h) ((4 + (b) * 2 + (h)) * HTB)
#define PG8_STAGE(bufoff, gbase, voff) do { _Pragma("unroll") for (int _i = 0; _i < 2; ++_i) \
        __builtin_amdgcn_global_load_lds((const unsigned*)((const char*)(gbase) + (voff)[_i]), (PG8_LAS unsigned*)(lds + (bufoff) + ldsw + _i * 8192), 16, 0, 0); } while (0)
#define PG8_LDA(dst, b, h) do { _Pragma("unroll") for (int m = 0; m < 4; ++m) _Pragma("unroll") for (int k = 0; k < 2; ++k) dst[m][k] = *(const PG8_LAS bf16x8*)(lds + PG8_SA(b, h) + aoff + m * 2048 + k * 1024); } while (0)
#define PG8_LDB(dst, b, h) do { _Pragma("unroll") for (int n = 0; n < 2; ++n) _Pragma("unroll") for (int k = 0; k < 2; ++k) dst[n][k] = *(const PG8_LAS bf16x8*)(lds + PG8_SB(b, h) + boff + n * 2048 + k * 1024); } while (0)
#define PG8_MMA(ai, bj, At, Bt) do { __builtin_amdgcn_s_setprio(1); _Pragma("unroll") for (int m = 0; m < 4; ++m) _Pragma("unroll") for (int n = 0; n < 2; ++n) _Pragma("unroll") for (int k = 0; k < 2; ++k) \
        acc[ai][bj][m][n] = __builtin_amdgcn_mfma_f32_16x16x32_bf16(Bt[n][k], At[m][k], acc[ai][bj][m][n], 0, 0, 0); __builtin_amdgcn_s_setprio(0); } while (0)
#define PG8_WAIT_V(n) asm volatile("s_waitcnt vmcnt(" #n ")" ::: "memory")
#define PG8_WAIT_L(n) asm volatile("s_waitcnt lgkmcnt(" #n ")" ::: "memory")
#define PG8_BAR __builtin_amdgcn_s_barrier()
#define PG8_SCHED __builtin_amdgcn_sched_barrier(0)
    Unit cur, nxt; int ui = 0;
    if (!S.next(0, cur)) return;
    f32x4 acc[2][2][4][2];
#pragma unroll
    for (int a = 0; a < 2; ++a)
#pragma unroll
        for (int b = 0; b < 2; ++b)
#pragma unroll
            for (int m = 0; m < 4; ++m)
#pragma unroll
                for (int n = 0; n < 2; ++n) acc[a][b][m][n] = (f32x4){0.f, 0.f, 0.f, 0.f};
    bf16x8 At[4][2], B0[2][2], B1[2][2];
    const char* cA = S.pa(g, cur); const char* cB = S.pb(g, cur);
    PG8_STAGE(PG8_SB(0, 0), cB, voffB); PG8_STAGE(PG8_SB(0, 1), cB + hstepB, voffB); PG8_STAGE(PG8_SA(0, 0), cA, voffA); PG8_STAGE(PG8_SA(0, 1), cA + hstepA, voffA);
    if (wr == 1) PG8_BAR;
    PG8_WAIT_V(2); PG8_BAR;
    PG8_STAGE(PG8_SB(1, 0), cB + kstep, voffB); PG8_STAGE(PG8_SA(1, 0), cA + kstep, voffA); PG8_STAGE(PG8_SB(1, 1), cB + hstepB + kstep, voffB);
    PG8_WAIT_V(6); PG8_BAR;
    for (;;) {
        const bool has_next = S.next(ui + 1, nxt);
        const char* nA = has_next ? S.pa(g, nxt) : cA; const char* nB = has_next ? S.pb(g, nxt) : cB;
#pragma nounroll
        for (int t = 0; t < nt; t += 2) {
            const bool last = (t == nt - 2);
            const char* a1 = cA + (size_t)(t + 1) * kstep;
            const char* a2 = last ? nA : cA + (size_t)(t + 2) * kstep; const char* b2 = last ? nB : cB + (size_t)(t + 2) * kstep;
            const char* a3 = a2 + kstep; const char* b3 = b2 + kstep;
            PG8_LDB(B0, 0, 0); PG8_LDB(B1, 0, 1); PG8_SCHED; PG8_LDA(At, 0, 0); PG8_STAGE(PG8_SA(1, 1), a1 + hstepA, voffA);
            PG8_WAIT_V(8); PG8_WAIT_L(0); PG8_BAR; PG8_MMA(0, 0, At, B0); PG8_MMA(0, 1, At, B1); PG8_BAR; PG8_SCHED;
            PG8_LDA(At, 0, 1); PG8_STAGE(PG8_SB(0, 0), b2, voffB); PG8_STAGE(PG8_SB(0, 1), b2 + hstepB, voffB); PG8_STAGE(PG8_SA(0, 0), a2, voffA);
            PG8_WAIT_V(8); PG8_WAIT_L(0); PG8_BAR; PG8_MMA(1, 0, At, B0); PG8_MMA(1, 1, At, B1); PG8_BAR; PG8_SCHED;
            PG8_LDB(B0, 1, 0); PG8_LDB(B1, 1, 1); PG8_SCHED; PG8_LDA(At, 1, 0); PG8_STAGE(PG8_SA(0, 1), a2 + hstepA, voffA);
            PG8_WAIT_V(8); PG8_WAIT_L(0); PG8_BAR; PG8_MMA(0, 0, At, B0); PG8_MMA(0, 1, At, B1); PG8_BAR; PG8_SCHED;
            PG8_LDA(At, 1, 1); PG8_STAGE(PG8_SB(1, 0), b3, voffB); PG8_STAGE(PG8_SB(1, 1), b3 + hstepB, voffB); PG8_STAGE(PG8_SA(1, 0), a3, voffA);
            PG8_WAIT_V(8); PG8_WAIT_L(0); PG8_BAR; PG8_MMA(1, 0, At, B0); PG8_MMA(1, 1, At, B1); PG8_BAR; PG8_SCHED;
        }
        if constexpr (ALIGN_EPI) { if (wr == 0) PG8_BAR; }
        if constexpr (!Epi::AFTER_DRAIN) { E(acc, cur, wr, wc, fr, fq); }
        if (!has_next) break;
#pragma unroll
        for (int a = 0; a < 2; ++a)
#pragma unroll
            for (int b = 0; b < 2; ++b)
#pragma unroll
                for (int m = 0; m < 4; ++m)
#pragma unroll
                    for (int n = 0; n < 2; ++n) acc[a][b][m][n] = (f32x4){0.f, 0.f, 0.f, 0.f};
        cur = nxt; cA = nA; cB = nB; ++ui;
        if constexpr (ALIGN_EPI) { if (wr == 1) PG8_BAR; }
    }
    PG8_WAIT_V(0);
    if constexpr (!ALIGN_EPI) { if (wr == 0) PG8_BAR; }
    PG8_BAR;
    if constexpr (Epi::AFTER_DRAIN) { E.fused(acc, cur, wr, wc, fr, fq, lds, wid, lane); }
#undef PG8_SA
#undef PG8_SB
#undef PG8_STAGE
#undef PG8_LDA
#undef PG8_LDB
#undef PG8_MMA
#undef PG8_WAIT_V
#undef PG8_WAIT_L
#undef PG8_BAR
#undef PG8_SCHED
}
}

constexpr int BATCH = 2, SEQ = 8192, D = 2048, DEPTH = 4, M = BATCH * SEQ;
constexpr int GW = 1024, GH = 8, GD = 128, SCW = 1024, NMEM = 256, XH = 4, XD = 512, DFF = 5632;
constexpr int NMIX_SRC = 7184, NMIX = 7168;
constexpr int PC_Q = 0, PC_K = 1024, PC_V = 2048, PC_Z = 3072, PC_B = 4096, PC_C = 5120, PC_H = 6144;
constexpr float EPS = 1e-6f;
constexpr int NWAVES = 8, NTHREADS = 512;

constexpr size_t MiB = 1u << 20;
constexpr size_t WS_CTL = 0, CTL_ZERO_BYTES = 1 * MiB;
constexpr size_t WS_WMIX = 1 * MiB;
constexpr size_t WS_WOUT = WS_WMIX + 112 * MiB;
constexpr size_t WS_WXQ  = WS_WOUT + 32 * MiB;
constexpr size_t WS_WXK  = WS_WXQ + 32 * MiB;
constexpr size_t WS_WXV  = WS_WXK + 32 * MiB;
constexpr size_t WS_WXO  = WS_WXV + 32 * MiB;
constexpr size_t WS_WUP  = WS_WXO + 32 * MiB;
constexpr size_t WS_WDN  = WS_WUP + 176 * MiB;
constexpr size_t WS_MEMN = WS_WDN + 88 * MiB;
constexpr size_t WS_KX   = WS_MEMN + 8 * MiB;
constexpr size_t WS_VX   = WS_KX + 8 * MiB;
constexpr size_t WS_BETA = WS_VX + 8 * MiB;
constexpr size_t WS_WBA  = WS_BETA + 512 * 1024;
constexpr size_t WS_G    = WS_BETA + 1 * MiB;
constexpr size_t WS_H    = WS_G + 1 * MiB;
constexpr size_t WS_OG   = WS_H + 64 * MiB;
constexpr size_t WS_Y    = WS_OG + 64 * MiB;
constexpr size_t WS_PB   = WS_OG;
constexpr size_t WS_HB   = WS_Y + 64 * MiB;
constexpr size_t WS_BIG  = WS_HB + 64 * MiB;
constexpr size_t WS_PROJ = WS_BIG;
constexpr size_t WS_GS   = WS_BIG + 224 * MiB;
constexpr size_t WS_ACT  = WS_BIG;
constexpr size_t WS_HALO = WS_BIG + 192 * MiB;
constexpr size_t WS_PART = WS_BIG + 200 * MiB;
constexpr size_t WS_WQK  = WS_BIG + 416 * MiB;
constexpr size_t WS_VWO  = WS_WQK + 32 * MiB;
constexpr size_t WS_END  = WS_VWO + 32 * MiB;
constexpr size_t WS_SSQ  = 65536;
static_assert(WS_SSQ + (size_t)DEPTH * 3 * M * 4 <= CTL_ZERO_BYTES, "ssq arrays inside the zeroed region");
constexpr int CW_BAR = 4096;

constexpr int RING_OFF = 0, RING_BYTES = 131072;
constexpr int LDSCTL_OFF = RING_BYTES, MISC_OFF = LDSCTL_OFF + 320, XB_OFF = LDSCTL_OFF + 1024;
constexpr int LDS_BYTES = 147456;

#define GAS __attribute__((address_space(1)))
#define LAS __attribute__((address_space(3)))
typedef unsigned short bf16;
typedef unsigned v4u __attribute__((ext_vector_type(4)));
typedef unsigned v2u __attribute__((ext_vector_type(2)));
typedef float f32x4 __attribute__((ext_vector_type(4)));
typedef short bf16x8 __attribute__((ext_vector_type(8)));
#define LDS_WAIT() asm volatile("s_waitcnt lgkmcnt(0)" ::: "memory")
#define VM_WAIT() asm volatile("s_waitcnt vmcnt(0)" ::: "memory")
__device__ __forceinline__ unsigned pk2(float lo, float hi) { return pg8::cvt_pk_bf16(lo, hi); }
__device__ __forceinline__ float bf_lo(unsigned w) { return __uint_as_float(w << 16); }
__device__ __forceinline__ float bf_hi(unsigned w) { return __uint_as_float(w & 0xffff0000u); }
__device__ __forceinline__ float wave_sum(float v) {
#pragma unroll
    for (int o = 1; o < 64; o <<= 1) v += __shfl_xor(v, o);
    return v;
}
__device__ __forceinline__ float silu_f(float y) { return y / (1.0f + __expf(-y)); }
__device__ __forceinline__ float sigmoid_f(float y) { return 1.0f / (1.0f + __expf(-y)); }

#define XB_TMO      128
#define XB_XCNT(j)  (256  + 64 * (j))
#define XB_XSUB(j)  (1280 + 64 * (j))
#define XB_XGEN(j)  (2304 + 64 * (j))
#define XB_TOP      3328
#define XB_TOPGEN   3392
#define XCD_BAR_WORDS 3456
#define XB_SPIN_CAP (1u << 18)

__device__ __forceinline__ unsigned xb_ld(unsigned* p)              { return __hip_atomic_load(p, __ATOMIC_RELAXED, __HIP_MEMORY_SCOPE_AGENT); }
__device__ __forceinline__ unsigned xb_add(unsigned* p, unsigned v) { return __hip_atomic_fetch_add(p, v, __ATOMIC_RELAXED, __HIP_MEMORY_SCOPE_AGENT); }
__device__ __forceinline__ unsigned xb_xcc_id() { return (unsigned)__builtin_amdgcn_s_getreg((3 << 11) | 20) & 0xFu; }
#define XB_SPIN(cond, bar) do { unsigned _sp = 0; while (cond) { __builtin_amdgcn_s_sleep(1); \
    if ((++_sp & 255u) == 0u) { if (xb_ld(&(bar)[XB_TMO])) break; if (_sp > XB_SPIN_CAP) { atomicAdd(&(bar)[XB_TMO], 1u); break; } } } } while (0)

struct XcdBarrier {
    unsigned* bar; unsigned x;
    volatile LAS unsigned* st;
};

__device__ __forceinline__ XcdBarrier xcd_barrier_post(unsigned* bar, volatile LAS unsigned* st) {
    XcdBarrier b; b.bar = bar; b.x = xb_xcc_id(); b.st = st;
    if (threadIdx.x == 0) (void)xb_add(&bar[XB_XCNT(b.x)], 1u);
    return b;
}
__device__ __forceinline__ void xcd_barrier_complete(unsigned* bar, unsigned x, unsigned& nloc, unsigned& nx) {
    const unsigned G = gridDim.x * gridDim.y * gridDim.z;
    unsigned sum, cnt, mine, sp = 0u;
    for (;;) {
        sum = 0u; cnt = 0u; mine = 0u;
#pragma unroll
        for (unsigned j = 0; j < 16; ++j) { const unsigned c = xb_ld(&bar[XB_XCNT(j)]); sum += c; cnt += (c > 0u) ? 1u : 0u; mine = (j == x) ? c : mine; }
        if (sum == G) break;
        __builtin_amdgcn_s_sleep(1);
        if ((++sp & 255u) == 0u) { if (xb_ld(&bar[XB_TMO])) break; if (sp > XB_SPIN_CAP) { atomicAdd(&bar[XB_TMO], 1u); break; } }
    }
    nloc = mine > 0u ? mine : 1u; nx = cnt > 0u ? cnt : 1u;
}

__device__ __forceinline__ void xcd_barrier(const XcdBarrier& b) {
    asm volatile("s_waitcnt vmcnt(0)" ::: "memory");
    __syncthreads();
    if (threadIdx.x == 0) {
        unsigned* bar = b.bar;
        __builtin_amdgcn_s_waitcnt(0);
        unsigned nloc = b.st[0], nx = b.st[1];
        if (nloc == 0u) { xcd_barrier_complete(bar, b.x, nloc, nx); b.st[0] = nloc; b.st[1] = nx; }
        const unsigned old = xb_add(&bar[XB_XSUB(b.x)], 1u);
        const unsigned gen = old / nloc;
        if (old + 1u == (gen + 1u) * nloc) {
            __builtin_amdgcn_fence(__ATOMIC_RELEASE, "agent");
            asm volatile("s_waitcnt vmcnt(0)" ::: "memory");
            const unsigned og = xb_add(&bar[XB_TOP], 1u);
            const unsigned tg = og / nx;
            if (og + 1u == (tg + 1u) * nx) xb_add(&bar[XB_TOPGEN], 1u);
            else XB_SPIN(xb_ld(&bar[XB_TOPGEN]) == tg, bar);
            __builtin_amdgcn_fence(__ATOMIC_ACQUIRE, "agent");
            xb_add(&bar[XB_XGEN(b.x)], 1u);
            asm volatile("s_waitcnt vmcnt(0)" ::: "memory");
        } else {
            XB_SPIN(xb_ld(&bar[XB_XGEN(b.x)]) == gen, bar);
            __builtin_amdgcn_fence(__ATOMIC_ACQUIRE, "agent");
            asm volatile("s_waitcnt vmcnt(0)" ::: "memory");
        }
    }
    __syncthreads();
}


struct Frame {
    LAS unsigned char* lds;
    int tid, lane, wave, G, gw, NGW;
    unsigned char* ws;
};
#define IN_X 0
#define IN_MEM 1
#define IN_MIX_NORM 2
#define IN_W_MIX_IN 3
#define IN_GDN_CONV 4
#define IN_A_LOG 5
#define IN_DT_BIAS 6
#define IN_OUT_NORM 7
#define IN_SC_CONV 8
#define IN_W_MIX_OUT 9
#define IN_XATTN_NORM 10
#define IN_MEM_NORM 11
#define IN_W_XQ 12
#define IN_W_XK 13
#define IN_W_XV 14
#define IN_W_XO 15
#define IN_FFN_NORM 16
#define IN_W_UP 17
#define IN_FFN_CONV 18
#define IN_W_DOWN 19
#define IN_FINAL_NORM 20

__device__ __forceinline__ void xpose_item(const float* src  , size_t ld, bf16* dst  , size_t K, int lane, LAS unsigned char* T) {
    const int n4 = lane & 15, ksub = lane >> 4;
    const float* s = src + (size_t)(16 * ksub) * ld + 4 * n4;
    f32x4 v[16];
#pragma unroll
    for (int i = 0; i < 16; ++i) v[i] = *(const f32x4*)(s + (size_t)i * ld);
#pragma unroll
    for (int j = 0; j < 4; ++j) { v4u a, b; a.x = pk2(v[0][j], v[1][j]); a.y = pk2(v[2][j], v[3][j]); a.z = pk2(v[4][j], v[5][j]); a.w = pk2(v[6][j], v[7][j]);
        b.x = pk2(v[8][j], v[9][j]); b.y = pk2(v[10][j], v[11][j]); b.z = pk2(v[12][j], v[13][j]); b.w = pk2(v[14][j], v[15][j]);
        LAS v4u* t = (LAS v4u*)(T + (4 * n4 + j) * 144 + 32 * ksub); t[0] = a; t[1] = b; }
    LDS_WAIT(); asm volatile("" ::: "memory");
#pragma unroll
    for (int i = 0; i < 8; ++i) { const int n = 8 * i + (lane >> 3), c = lane & 7; *(v4u*)(dst + (size_t)n * K + 8 * c) = *(const LAS v4u*)(T + n * 144 + 16 * c); }
    LDS_WAIT(); asm volatile("" ::: "memory");
}
__device__ __forceinline__ void convert_item(const float* src, bf16* dst, int lane) {
#pragma unroll
    for (int k = 0; k < 8; ++k) { const f32x4 a = *(const f32x4*)(src + k * 512 + 8 * lane), b = *(const f32x4*)(src + k * 512 + 8 * lane + 4);
        v4u o; o.x = pk2(a[0], a[1]); o.y = pk2(a[2], a[3]); o.z = pk2(b[0], b[1]); o.w = pk2(b[2], b[3]); *(v4u*)(dst + k * 512 + 8 * lane) = o; }
}
__device__ __forceinline__ void p0_weights_x(Frame& F, const float* w_xq, const float* w_xk, const float* w_xv, const float* w_xo) {
    constexpr int I_SQ = 32 * 32, I_XQ = D * D / 4096, I_LAYER = 3 * I_SQ + I_XQ;
    LAS unsigned char* T = F.lds + RING_OFF + F.wave * 9216;
    for (int it = F.gw; it < DEPTH * I_LAYER; it += F.NGW) {
        const int l = it / I_LAYER; int r = it % I_LAYER;
        if (r < 3 * I_SQ) { const int f = r / I_SQ, rr = r % I_SQ, nb = rr >> 5, kb = rr & 31;
            const float* src = f == 0 ? w_xk : f == 1 ? w_xv : w_xo;
            const size_t dofs = f == 0 ? WS_WXK : f == 1 ? WS_WXV : WS_WXO;
            xpose_item(src + (size_t)l * D * D + (size_t)(kb * 64) * D + nb * 64, D, (bf16*)(F.ws + dofs) + (size_t)l * D * D + (size_t)(nb * 64) * D + kb * 64, D, F.lane, T); continue; }
        r -= 3 * I_SQ;
        convert_item(w_xq + (size_t)l * D * D + (size_t)r * 4096, (bf16*)(F.ws + WS_WXQ) + (size_t)l * D * D + (size_t)r * 4096, F.lane);
    }
}
__device__ __forceinline__ void p0_weights_main(Frame& F, int l, int gw, int ngw, const float* w_mix_in, const float* w_mix_out, const float* w_up, const float* w_down) {
    constexpr int I_MIX = 112 * 32, I_SQ = 32 * 32, I_UP = 176 * 32, I_DN = 32 * 88, I_LAYER = I_MIX + I_SQ + I_UP + I_DN;
    LAS unsigned char* T = F.lds + RING_OFF + F.wave * 9216;
    for (int it = gw; it < I_LAYER; it += ngw) {
        int r = it;
        if (r < I_MIX) { const int nb = r >> 5, kb = r & 31, n0 = nb * 64, sc = n0 < 4096 ? n0 : n0 + 16;
            xpose_item(w_mix_in + (size_t)l * D * NMIX_SRC + (size_t)(kb * 64) * NMIX_SRC + sc, NMIX_SRC, (bf16*)(F.ws + WS_WMIX) + (size_t)l * NMIX * D + (size_t)n0 * D + kb * 64, D, F.lane, T); continue; }
        r -= I_MIX;
        if (r < I_SQ) { const int nb = r >> 5, kb = r & 31;
            xpose_item(w_mix_out + (size_t)l * D * D + (size_t)(kb * 64) * D + nb * 64, D, (bf16*)(F.ws + WS_WOUT) + (size_t)l * D * D + (size_t)(nb * 64) * D + kb * 64, D, F.lane, T); continue; }
        r -= I_SQ;
        if (r < I_UP) { const int nb = r >> 5, kb = r & 31, n0 = nb * 64, c0 = n0 < DFF ? n0 : n0 - DFF, drow = (c0 >> 7) * 256 + (n0 < DFF ? 0 : 128) + (c0 & 127);
            xpose_item(w_up + (size_t)l * D * 2 * DFF + (size_t)(kb * 64) * 2 * DFF + n0, 2 * DFF, (bf16*)(F.ws + WS_WUP) + (size_t)l * 2 * DFF * D + (size_t)drow * D + kb * 64, D, F.lane, T); continue; }
        r -= I_UP;
        { const int nb = r / 88, kb = r % 88;
            xpose_item(w_down + (size_t)l * DFF * D + (size_t)(kb * 64) * D + nb * 64, D, (bf16*)(F.ws + WS_WDN) + (size_t)l * D * DFF + (size_t)(nb * 64) * DFF + kb * 64, DFF, F.lane, T); }
    }
    for (int i = gw * 64 + F.lane; i < 16 * D; i += ngw * 64) { const int n = i / D, k = i % D;
        ((bf16*)(F.ws + WS_WBA))[(size_t)l * 16 * D + i] = (bf16)(pk2(w_mix_in[(size_t)l * D * NMIX_SRC + (size_t)k * NMIX_SRC + 4096 + n], 0.f) & 0xffffu); }
}
__device__ __forceinline__ void p0_memn(Frame& F, const float* mem, const float* mem_norm) {
    for (int m = F.gw; m < BATCH * NMEM; m += F.NGW) {
        const f32x4* xr = (const f32x4*)(mem + (size_t)m * D) + F.lane;
        f32x4 v[8]; float s = 0.f;
#pragma unroll
        for (int j = 0; j < 8; ++j) { v[j] = xr[64 * j]; s += (v[j][0] * v[j][0] + v[j][1] * v[j][1]) + (v[j][2] * v[j][2] + v[j][3] * v[j][3]); }
        const float rstd = 1.0f / sqrtf(wave_sum(s) * (1.0f / D) + EPS);
        for (int l = 0; l < DEPTH; ++l) {
            const f32x4* gr = (const f32x4*)(mem_norm + (size_t)l * D) + F.lane;
            v2u* o8 = (v2u*)((bf16*)(F.ws + WS_MEMN) + ((size_t)l * 512 + m) * D) + F.lane;
#pragma unroll
            for (int j = 0; j < 8; ++j) { const f32x4 g4 = gr[64 * j]; const f32x4 h = v[j] * rstd * g4; v2u o; o.x = pk2(h[0], h[1]); o.y = pk2(h[2], h[3]); o8[64 * j] = o; }
        }
    }
}

__device__ __forceinline__ void prenorm_phase(Frame& F, const float* x, const float* gain, bf16* Hn, float* ssq) {
    f32x4 g4[8];
#pragma unroll
    for (int j = 0; j < 8; ++j) g4[j] = ((const f32x4*)gain)[64 * j + F.lane];
    for (int m = F.gw; m < M; m += F.NGW) {
        const f32x4* xr = (const f32x4*)(x + (size_t)m * D) + F.lane;
        f32x4 v[8]; float s = 0.f;
#pragma unroll
        for (int j = 0; j < 8; ++j) { v[j] = xr[64 * j]; s += (v[j][0] * v[j][0] + v[j][1] * v[j][1]) + (v[j][2] * v[j][2] + v[j][3] * v[j][3]); }
        s = wave_sum(s);
        if (F.lane == 0) ssq[m] = s;
        v2u* o8 = (v2u*)(Hn + (size_t)m * D) + F.lane;
#pragma unroll
        for (int j = 0; j < 8; ++j) { v[j] = v[j] * g4[j]; v2u o; o.x = pk2(v[j][0], v[j][1]); o.y = pk2(v[j][2], v[j][3]); o8[64 * j] = o; }
    }
}
__device__ __forceinline__ void ba_phase(Frame& F, const bf16* Hn, const float* ssq, const bf16* wba  , const float* alogp, const float* dtbp) {
    const int lane = F.lane, wave = F.wave, mtile = wave & 3, khalf = wave >> 2, fr = lane & 15, fq = lane >> 4;
    LAS f32x4* red = (LAS f32x4*)(F.lds);
    for (int rb = blockIdx.x; rb < M / 64; rb += F.G) {
        const int row0 = rb * 64 + 16 * mtile;
        const bf16* ap = Hn + (size_t)(row0 + fr) * D + khalf * 1024 + 8 * fq;
        const bf16* bp = wba + (size_t)fr * D + khalf * 1024 + 8 * fq;
        f32x4 acc = {0.f, 0.f, 0.f, 0.f};
#pragma unroll 8
        for (int s = 0; s < 32; ++s) { const bf16x8 a = __builtin_bit_cast(bf16x8, *(const v4u*)(ap + 32 * s)), b = __builtin_bit_cast(bf16x8, *(const v4u*)(bp + 32 * s));
            acc = __builtin_amdgcn_mfma_f32_16x16x32_bf16(a, b, acc, 0, 0, 0); }
        if (khalf == 1) red[mtile * 64 + lane] = acc;
        LDS_WAIT(); __syncthreads();
        if (khalf == 0) {
            const f32x4 o = red[mtile * 64 + lane]; acc = acc + o;
            const float al = fr >= 8 ? alogp[fr - 8] : 0.f, db = fr >= 8 ? dtbp[fr - 8] : 0.f;
#pragma unroll
            for (int i = 0; i < 4; ++i) { const int row = row0 + 4 * fq + i; const float v = acc[i] * (1.0f / sqrtf(ssq[row] * (1.0f / D) + EPS));
                if (fr < 8) ((float*)(F.ws + WS_BETA))[(size_t)row * GH + fr] = sigmoid_f(v);
                else { const float z = v + db; const float sp = fmaxf(z, 0.f) + log1pf(expf(-fabsf(z))); ((float*)(F.ws + WS_G))[(size_t)row * GH + fr - 8] = -expf(al) * sp; } }
        }
        LDS_WAIT(); __syncthreads();
    }
}
__device__ __forceinline__ void final_norm_phase(Frame& F, const float* x, const float* gain, float* out) {
    f32x4 g4[8];
#pragma unroll
    for (int j = 0; j < 8; ++j) g4[j] = ((const f32x4*)gain)[64 * j + F.lane];
    for (int m = F.gw; m < M; m += F.NGW) {
        const f32x4* xr = (const f32x4*)(x + (size_t)m * D) + F.lane;
        f32x4 v[8]; float s = 0.f;
#pragma unroll
        for (int j = 0; j < 8; ++j) { v[j] = xr[64 * j]; s += (v[j][0] * v[j][0] + v[j][1] * v[j][1]) + (v[j][2] * v[j][2] + v[j][3] * v[j][3]); }
        const float rstd = 1.0f / sqrtf(wave_sum(s) * (1.0f / D) + EPS);
        f32x4* o = (f32x4*)(out + (size_t)m * D) + F.lane;
#pragma unroll
        for (int j = 0; j < 8; ++j) o[64 * j] = v[j] * rstd * g4[j];
    }
}

__device__ __forceinline__ void unpack8(const v4u w, float (&f)[8]) {
    f[0] = bf_lo(w.x); f[1] = bf_hi(w.x); f[2] = bf_lo(w.y); f[3] = bf_hi(w.y); f[4] = bf_lo(w.z); f[5] = bf_hi(w.z); f[6] = bf_lo(w.w); f[7] = bf_hi(w.w);
}

__device__ __forceinline__ void shortconv_phase(Frame& F, const float* cw, int gw, int ngw) {
    const bf16* PROJ = (const bf16*)(F.ws + WS_PROJ);
    bf16* Y = (bf16*)(F.ws + WS_Y);
    for (int rb = gw; rb < M / 8; rb += ngw) {
        const int m0 = rb * 8, t0 = m0 % SEQ;
        for (int i = 0; i < 2; ++i) {
            const int ch0 = 8 * (F.lane + 64 * i);
            float w[3][8];
#pragma unroll
            for (int j = 0; j < 3; ++j) { const f32x4 a = *(const f32x4*)(cw + (size_t)j * SCW + ch0), b = *(const f32x4*)(cw + (size_t)j * SCW + ch0 + 4);
                w[j][0] = a[0]; w[j][1] = a[1]; w[j][2] = a[2]; w[j][3] = a[3]; w[j][4] = b[0]; w[j][5] = b[1]; w[j][6] = b[2]; w[j][7] = b[3]; }
            float x0[8], x1[8], x2[8], cg[8], hh[8], bg[8];
            const bf16* p = PROJ + (size_t)m0 * NMIX + ch0;
            if (t0 >= 2) {
                unpack8(*(const v4u*)(p - 2 * (size_t)NMIX + PC_C), cg); unpack8(*(const v4u*)(p - 2 * (size_t)NMIX + PC_H), hh);
#pragma unroll
                for (int e = 0; e < 8; ++e) x0[e] = cg[e] * hh[e];
                unpack8(*(const v4u*)(p - (size_t)NMIX + PC_C), cg); unpack8(*(const v4u*)(p - (size_t)NMIX + PC_H), hh);
#pragma unroll
                for (int e = 0; e < 8; ++e) x1[e] = cg[e] * hh[e];
            } else {
#pragma unroll
                for (int e = 0; e < 8; ++e) { x0[e] = 0.f; x1[e] = 0.f; } }
            for (int r = 0; r < 8; ++r) {
                unpack8(*(const v4u*)(p + (size_t)r * NMIX + PC_C), cg); unpack8(*(const v4u*)(p + (size_t)r * NMIX + PC_H), hh); unpack8(*(const v4u*)(p + (size_t)r * NMIX + PC_B), bg);
                float y[8];
#pragma unroll
                for (int e = 0; e < 8; ++e) { x2[e] = cg[e] * hh[e]; y[e] = bg[e] * (w[0][e] * x0[e] + w[1][e] * x1[e] + w[2][e] * x2[e]); x0[e] = x1[e]; x1[e] = x2[e]; }
                v4u o; o.x = pk2(y[0], y[1]); o.y = pk2(y[2], y[3]); o.z = pk2(y[4], y[5]); o.w = pk2(y[6], y[7]);
                *(v4u*)(Y + (size_t)(m0 + r) * D + GW + ch0) = o;
            }
        }
    }
}
__device__ __forceinline__ void swiglu_fix_phase(Frame& F, const float* cw) {
    bf16* ACT = (bf16*)(F.ws + WS_ACT); const float* PART = (const float*)(F.ws + WS_PART); const float* HALO = (const float*)(F.ws + WS_HALO);
    for (int idx = F.gw * 64 + F.lane; idx < (M / 256) * (DFF / 4); idx += F.NGW * 64) {
        const int pm = idx / (DFF / 4), ch = 4 * (idx % (DFF / 4));
        f32x4 wg[3], wu[3];
#pragma unroll
        for (int t = 0; t < 3; ++t) { wg[t] = *(const f32x4*)(cw + (size_t)t * 2 * DFF + ch); wu[t] = *(const f32x4*)(cw + (size_t)t * 2 * DFF + DFF + ch); }
        f32x4 g0 = *(const f32x4*)(PART + ((size_t)(pm * 2 + 0) * 2 + 0) * DFF + ch), u0 = *(const f32x4*)(PART + ((size_t)(pm * 2 + 0) * 2 + 1) * DFF + ch);
        f32x4 g1 = *(const f32x4*)(PART + ((size_t)(pm * 2 + 1) * 2 + 0) * DFF + ch), u1 = *(const f32x4*)(PART + ((size_t)(pm * 2 + 1) * 2 + 1) * DFF + ch);
        if (pm % (SEQ / 256) != 0) {
            const f32x4 hg0 = *(const f32x4*)(HALO + ((size_t)((pm - 1) * 2 + 0) * 2 + 0) * DFF + ch), hu0 = *(const f32x4*)(HALO + ((size_t)((pm - 1) * 2 + 0) * 2 + 1) * DFF + ch);
            const f32x4 hg1 = *(const f32x4*)(HALO + ((size_t)((pm - 1) * 2 + 1) * 2 + 0) * DFF + ch), hu1 = *(const f32x4*)(HALO + ((size_t)((pm - 1) * 2 + 1) * 2 + 1) * DFF + ch);
            g0 = g0 + wg[1] * hg1 + wg[0] * hg0; u0 = u0 + wu[1] * hu1 + wu[0] * hu0; g1 = g1 + wg[0] * hg1; u1 = u1 + wu[0] * hu1;
        }
        v2u w0, w1; w0.x = pk2(silu_f(g0[0]) * u0[0], silu_f(g0[1]) * u0[1]); w0.y = pk2(silu_f(g0[2]) * u0[2], silu_f(g0[3]) * u0[3]);
        w1.x = pk2(silu_f(g1[0]) * u1[0], silu_f(g1[1]) * u1[1]); w1.y = pk2(silu_f(g1[2]) * u1[2], silu_f(g1[3]) * u1[3]);
        *(v2u*)(ACT + (size_t)(pm * 256) * DFF + ch) = w0; *(v2u*)(ACT + (size_t)(pm * 256 + 1) * DFF + ch) = w1;
    }
}

struct KvOrder {
    int G, c; const bf16 *memn, *wxk, *wxv;
    __device__ __forceinline__ bool next(int i, pg8::Unit& u) const { const long L = (long)i * G + c; if (L >= 128) return false; u.pm = (int)L; u.pn = 0; return true; }
    __device__ __forceinline__ const char* pa(const pg8::Gemm&, const pg8::Unit& u) const { const int l = u.pm >> 5, r = u.pm & 15; return (const char*)(memn + ((size_t)l * 512 + (r >> 3) * 256) * D); }
    __device__ __forceinline__ const char* pb(const pg8::Gemm&, const pg8::Unit& u) const { const int l = u.pm >> 5, r = u.pm & 15;
        const bf16* wk = wxk + ((size_t)l * D + (r & 7) * 256) * D; const bf16* wv = wxv + ((size_t)l * D + (r & 7) * 256) * D; return (const char*)((u.pm & 16) ? wv : wk); }
};
struct LocKv { bf16 *kx, *vx;
    __device__ __forceinline__ void operator()(const pg8::Unit& u, bf16*& base, int& ld) const { const int l = u.pm >> 5, r = u.pm & 15;
        bf16* bk = kx + ((size_t)l * 512 + (r >> 3) * 256) * D + (r & 7) * 256; bf16* bv = vx + ((size_t)l * 512 + (r >> 3) * 256) * D + (r & 7) * 256; base = (u.pm & 16) ? bv : bk; ld = D; } };
struct PreOrder {
    int G, c; const bf16 *kx, *vx, *wxq, *wxo;
    __device__ __forceinline__ bool next(int i, pg8::Unit& u) const { const long L = (long)i * G + c; if (L >= 512) return false; u.pm = (int)L; u.pn = 0; return true; }
    __device__ __forceinline__ const char* pa(const pg8::Gemm&, const pg8::Unit& u) const { const int jj = u.pm & 255, l = jj >> 6, b = (jj >> 5) & 1, h = (jj >> 3) & 3, t = jj & 7;
        return (const char*)(u.pm < 256 ? kx + ((size_t)l * 512 + b * 256) * D + h * XD : wxo + ((size_t)l * D + t * 256) * D + h * XD); }
    __device__ __forceinline__ const char* pb(const pg8::Gemm&, const pg8::Unit& u) const { const int jj = u.pm & 255, l = jj >> 6, b = (jj >> 5) & 1, h = (jj >> 3) & 3, t = jj & 7;
        return (const char*)(u.pm < 256 ? wxq + ((size_t)l * D + t * 256) * D + h * XD : vx + ((size_t)l * 512 + b * 256) * D + h * XD); }
};
struct LocPre { bf16 *wqk, *vwo;
    __device__ __forceinline__ void operator()(const pg8::Unit& u, bf16*& base, int& ld) const { const int jj = u.pm & 255, l = jj >> 6, b = (jj >> 5) & 1, h = (jj >> 3) & 3, t = jj & 7;
        if (u.pm < 256) { base = wqk + ((size_t)(l * 2 + b) * (XH * NMEM) + h * NMEM) * D + t * 256; ld = D; }
        else { base = vwo + ((size_t)(l * 2 + b) * D + t * 256) * (XH * NMEM) + h * NMEM; ld = XH * NMEM; } } };
struct SOrder {
    int G, c;
    __device__ __forceinline__ bool next(int i, pg8::Unit& u) const { const long L = (long)i * G + c; if (L >= 256) return false; u.pm = (int)L & 63; u.pn = (int)L >> 6; return true; }
    __device__ __forceinline__ const char* pa(const pg8::Gemm& g, const pg8::Unit& u) const { return (const char*)(g.A + (size_t)u.pm * 256 * D); }
    __device__ __forceinline__ const char* pb(const pg8::Gemm& g, const pg8::Unit& u) const { return (const char*)(g.Bt + (size_t)(u.pm >> 5) * (XH * NMEM) * D + (size_t)u.pn * NMEM * D); }
};
struct BatchOrder : pg8::StaticOrder {
    size_t bstride;
    __device__ __forceinline__ const char* pb(const pg8::Gemm& g, const pg8::Unit& u) const { return (const char*)(g.Bt + (size_t)(u.pm >> 5) * bstride + (size_t)u.pn * pg8::BM * g.ldb); }
};

typedef float f32x16 __attribute__((ext_vector_type(16)));
typedef float f32x2n __attribute__((ext_vector_type(2)));
typedef __bf16 bf16x2n __attribute__((ext_vector_type(2)));
__device__ __forceinline__ unsigned pkn(float a, float b) { f32x2n v = {a, b}; bf16x2n r = __builtin_convertvector(v, bf16x2n); return __builtin_bit_cast(unsigned, r); }
__device__ __forceinline__ int kmap(int p) { const int pp = p & 15, hh = pp >> 3, jj = pp & 7; return (p & ~15) + 8 * (jj >> 2) + 4 * hh + (jj & 3); }
__device__ __forceinline__ int kpos(int d) { const int dd = d & 15; return (d & ~15) + 8 * ((dd >> 2) & 1) + 4 * (dd >> 3) + (dd & 3); }
__device__ __forceinline__ bf16x8 pack_step(const f32x16& x, int s) {
    v4u w; w.x = pkn(x[8 * s], x[8 * s + 1]); w.y = pkn(x[8 * s + 2], x[8 * s + 3]); w.z = pkn(x[8 * s + 4], x[8 * s + 5]); w.w = pkn(x[8 * s + 6], x[8 * s + 7]);
    return __builtin_bit_cast(bf16x8, w);
}
constexpr int REC_BYTES = 36864, WIMG_STRIDE = 272, KDIMG_OFF = 17408, KDIMG_STRIDE = 144, IMG_USED = 35840;
constexpr size_t WS_REC = WS_GS;
constexpr size_t WS_UT = WS_GS + 80 * MiB;
constexpr size_t WS_ATTN = WS_GS + 144 * MiB;
constexpr size_t WS_EGL = WS_GS + 160 * MiB;
constexpr size_t WS_SST = WS_H;
constexpr size_t WS_QD = WS_OG;
constexpr size_t WS_VST = WS_OG + 32 * MiB;

__device__ __forceinline__ void gdn_prep_phase(Frame& F, const float* cw  ) {
    const bf16* PROJ = (const bf16*)(F.ws + WS_PROJ);
    const float* BETA = (const float*)(F.ws + WS_BETA); const float* GG = (const float*)(F.ws + WS_G);
    unsigned o_vs = 32768, o_kb = 65536, o_qb = 82944, o_as = 101376, o_att = 117760, o_gc = 125952;
    asm volatile("" : "+v"(o_vs), "+v"(o_kb), "+v"(o_qb), "+v"(o_as), "+v"(o_att), "+v"(o_gc));
    LAS float* KS = (LAS float*)(F.lds);
    LAS float* VS = (LAS float*)(F.lds + o_vs);
    LAS unsigned char* KB16 = F.lds + o_kb;
    LAS unsigned char* QB16 = F.lds + o_qb;
    LAS unsigned char* IMG = KB16;
    LAS float* AS = (LAS float*)(F.lds + o_as);
    LAS unsigned short* ATT = (LAS unsigned short*)(F.lds + o_att);
    LAS float* GC = (LAS float*)(F.lds + o_gc);
    const int tid = F.tid, lane = F.lane, wave = F.wave;
#ifndef G1_REP
#define G1_REP 1
#endif
    for (int it = 0; it * F.G < 2048 * G1_REP; ++it) {
        const int u = blockIdx.x + F.G * (it / G1_REP);
        const int ch = u, n = ch & 127, bh = ch >> 7, b = bh >> 3, h = bh & 7;
        const int m0 = b * SEQ + n * 64;
        if (tid < 384) {
            const int rb = tid / 48, cgi = tid % 48, tensor = cgi >> 4, cg = cgi & 15;
            const int ch0 = tensor * GW + h * GD + 8 * cg, c0 = rb * 8;
            float w[4][8];
#pragma unroll
            for (int j = 0; j < 4; ++j) { const f32x4 a = *(const f32x4*)(cw + (size_t)j * 3 * GW + ch0), bq = *(const f32x4*)(cw + (size_t)j * 3 * GW + ch0 + 4);
                w[j][0] = a[0]; w[j][1] = a[1]; w[j][2] = a[2]; w[j][3] = a[3]; w[j][4] = bq[0]; w[j][5] = bq[1]; w[j][6] = bq[2]; w[j][7] = bq[3]; }
            float x0[8], x1[8], x2[8], x3[8];
            const bf16* p = PROJ + (size_t)(m0 + c0) * NMIX + ch0;
            const bool hist = n * 64 + c0 >= 3;
            v4u raw[11];
#pragma unroll
            for (int q = 0; q < 3; ++q) raw[q] = *(const v4u*)(hist ? p - (size_t)(3 - q) * NMIX : p);
#pragma unroll
            for (int q = 0; q < 8; ++q) raw[3 + q] = *(const v4u*)(p + (size_t)q * NMIX);
            if (!hist) { raw[0] = (v4u){0u, 0u, 0u, 0u}; raw[1] = raw[0]; raw[2] = raw[0]; }
            unpack8(raw[0], x0); unpack8(raw[1], x1); unpack8(raw[2], x2);
#pragma unroll
            for (int r = 0; r < 8; ++r) {
                unpack8(raw[3 + r], x3);
                float y[8]; float ss = 0.f;
#pragma unroll
                for (int e = 0; e < 8; ++e) { const float c = w[0][e] * x0[e] + w[1][e] * x1[e] + w[2][e] * x2[e] + w[3][e] * x3[e]; y[e] = silu_f(c); ss += y[e] * y[e]; x0[e] = x1[e]; x1[e] = x2[e]; x2[e] = x3[e]; }
                const int c = c0 + r;
                if (tensor < 2) {
                    ss += __shfl_xor(ss, 1); ss += __shfl_xor(ss, 2); ss += __shfl_xor(ss, 4); ss += __shfl_xor(ss, 8);
                    float sc = 1.0f / sqrtf(ss + EPS); if (tensor == 0) sc *= 0.08838834764831845f;
#pragma unroll
                    for (int e = 0; e < 8; ++e) y[e] *= sc;
                    v4u o; o.x = pkn(y[0], y[1]); o.y = pkn(y[2], y[3]); o.z = pkn(y[4], y[5]); o.w = pkn(y[6], y[7]);
                    *(LAS v4u*)((tensor == 0 ? QB16 : KB16) + c * WIMG_STRIDE + 16 * cg) = o;
                    if (tensor == 1) { *(LAS f32x4*)(KS + c * 128 + 8 * cg) = (f32x4){y[0], y[1], y[2], y[3]}; *(LAS f32x4*)(KS + c * 128 + 8 * cg + 4) = (f32x4){y[4], y[5], y[6], y[7]}; }
                } else { *(LAS f32x4*)(VS + c * 128 + 8 * cg) = (f32x4){y[0], y[1], y[2], y[3]}; *(LAS f32x4*)(VS + c * 128 + 8 * cg + 4) = (f32x4){y[4], y[5], y[6], y[7]}; }
            }
        } else if (wave == 7) {
            const float g = GG[(size_t)(m0 + lane) * GH + h], be = BETA[(size_t)(m0 + lane) * GH + h];
            float x = g;
#pragma unroll
            for (int o = 1; o < 64; o <<= 1) { const float t = __shfl_up(x, o); if (lane >= o) x += t; }
            const float gl = __shfl(x, 63);
            GC[lane] = x; GC[64 + lane] = be; GC[128 + lane] = expf(x); GC[192 + lane] = expf(gl - x);
            if (lane == 0) ((float*)(F.ws + WS_EGL))[ch] = expf(gl);
        }
        LDS_WAIT(); __syncthreads();
        {
            const int mat = wave >> 2, mt = (wave >> 1) & 1, nt = wave & 1, r = lane & 31, hh = lane >> 5;
            const LAS unsigned char* Asrc = (mat ? QB16 : KB16) + (32 * mt + r) * WIMG_STRIDE + 16 * hh;
            const LAS unsigned char* Bsrc = KB16 + (32 * nt + r) * WIMG_STRIDE + 16 * hh;
            f32x16 acc;
#pragma unroll
            for (int i = 0; i < 16; ++i) acc[i] = 0.f;
#pragma unroll
            for (int ks = 0; ks < 8; ++ks) { const bf16x8 a = *(const LAS bf16x8*)(Asrc + 32 * ks), bb = *(const LAS bf16x8*)(Bsrc + 32 * ks); acc = __builtin_amdgcn_mfma_f32_32x32x16_bf16(a, bb, acc, 0, 0, 0); }
            const int m = 32 * nt + r; const float gcm = GC[m];
#pragma unroll
            for (int i = 0; i < 16; ++i) {
                const int c = 32 * mt + (i & 3) + 8 * (i >> 2) + 4 * hh;
                if (mat == 0) AS[c * 64 + m] = (m > c) ? GC[64 + m] * acc[i] * expf(fminf(gcm - GC[c], 0.f)) : 0.f;
                else { const float v = (m <= c) ? acc[i] * expf(fminf(GC[c] - gcm, 0.f)) : 0.f; ATT[c * 64 + kpos(m)] = (unsigned short)(pkn(v, 0.f) & 0xffffu); }
            }
            const int c = tid >> 3, p0 = (tid & 7) * 16; const float eg = GC[128 + c];
            const LAS unsigned short* qrow = (const LAS unsigned short*)(QB16 + c * WIMG_STRIDE);
            float qv[16];
#pragma unroll
            for (int pp = 0; pp < 16; ++pp) qv[pp] = __uint_as_float((unsigned)qrow[p0 + 8 * ((pp & 7) >> 2) + 4 * (pp >> 3) + (pp & 3)] << 16) * eg;
            v4u o0, o1; o0.x = pkn(qv[0], qv[1]); o0.y = pkn(qv[2], qv[3]); o0.z = pkn(qv[4], qv[5]); o0.w = pkn(qv[6], qv[7]); o1.x = pkn(qv[8], qv[9]); o1.y = pkn(qv[10], qv[11]); o1.z = pkn(qv[12], qv[13]); o1.w = pkn(qv[14], qv[15]);
            v4u* qd = (v4u*)((bf16*)(F.ws + WS_QD) + (size_t)ch * 64 * 128 + c * 128 + p0); qd[0] = o0; qd[1] = o1;
        }
        LDS_WAIT(); __syncthreads();
        if (tid < 256) {
            const int col = tid & 127; const bool isw = tid >= 128;
            const LAS float* src = (isw ? KS : VS) + col;
            f32x2n xp[32];
#pragma unroll
            for (int k = 0; k < 32; ++k) { float v0 = src[(2 * k) * 128] * GC[64 + 2 * k], v1 = src[(2 * k + 1) * 128] * GC[64 + 2 * k + 1]; if (isw) { v0 *= GC[128 + 2 * k]; v1 *= GC[128 + 2 * k + 1]; } xp[k] = (f32x2n){v0, v1}; }
            f32x4 acur[8], anxt[8];
#pragma unroll
            for (int g = 0; g < 8; ++g) acur[g] = *(const LAS f32x4*)(AS + 4 * g);
#pragma unroll
            for (int k = 0; k < 94; ++k) {
                const int m = k < 62 ? (k >> 1) : k - 31, hf = k < 62 ? (k & 1) : 1;
                if (k + 1 < 94) { const int m2 = (k + 1) < 62 ? ((k + 1) >> 1) : (k + 1) - 31, hf2 = (k + 1) < 62 ? ((k + 1) & 1) : 1; const int g0 = ((m2 + 1) >> 2) > 8 * hf2 ? ((m2 + 1) >> 2) : 8 * hf2;
#pragma unroll
                    for (int g = g0; g < 8 * hf2 + 8; ++g) anxt[g - 8 * hf2] = *(const LAS f32x4*)(AS + m2 * 64 + 4 * g); }
                __builtin_amdgcn_sched_barrier(0);
                { const int p0 = ((m + 1) >> 1) > 16 * hf ? ((m + 1) >> 1) : 16 * hf;
#pragma unroll
                    for (int pr = p0; pr < 16 * hf + 16; ++pr) { const f32x4 a4 = acur[(pr >> 1) - 8 * hf]; const f32x2n a2 = (pr & 1) ? (f32x2n){a4[2], a4[3]} : (f32x2n){a4[0], a4[1]};
                        if (m & 1) asm("v_pk_fma_f32 %0, %1, %2, %0 op_sel:[0,1,0] op_sel_hi:[1,1,1] neg_lo:[1,0,0] neg_hi:[1,0,0]" : "+v"(xp[pr]) : "v"(a2), "v"(xp[m >> 1]));
                        else       asm("v_pk_fma_f32 %0, %1, %2, %0 op_sel:[0,0,0] op_sel_hi:[1,0,1] neg_lo:[1,0,0] neg_hi:[1,0,0]" : "+v"(xp[pr]) : "v"(a2), "v"(xp[m >> 1])); } }
#pragma unroll
                for (int g = 0; g < 8; ++g) acur[g] = anxt[g];
                __builtin_amdgcn_sched_barrier(0);
            }
            float x[64];
#pragma unroll
            for (int k = 0; k < 32; ++k) { x[2 * k] = xp[k][0]; x[2 * k + 1] = xp[k][1]; }
            if (!isw) { f32x4* up = (f32x4*)((float*)(F.ws + WS_UT) + (size_t)ch * 128 * 64 + col * 64);
#pragma unroll
                for (int c4 = 0; c4 < 16; ++c4) up[c4] = (f32x4){x[4 * c4], x[4 * c4 + 1], x[4 * c4 + 2], x[4 * c4 + 3]}; }
            else { LAS unsigned short* wi = (LAS unsigned short*)(IMG) + kpos(col);
#pragma unroll
                for (int c = 0; c < 64; ++c) wi[c * (WIMG_STRIDE / 2)] = (unsigned short)(pkn(-x[c], 0.f) & 0xffffu); }
        } else {
            const int t = tid - 256, d = t & 127, ph = t >> 7;
#pragma unroll
            for (int q8 = 0; q8 < 4; ++q8) { const int p0 = 32 * ph + 8 * q8; float kv[8];
#pragma unroll
                for (int jj = 0; jj < 8; ++jj) { const int c = (p0 & ~15) + 8 * (jj >> 2) + 4 * ((p0 >> 3) & 1) + (jj & 3); kv[jj] = KS[c * 128 + d] * GC[192 + c]; }
                v4u o; o.x = pkn(kv[0], kv[1]); o.y = pkn(kv[2], kv[3]); o.z = pkn(kv[4], kv[5]); o.w = pkn(kv[6], kv[7]);
                *(LAS v4u*)(IMG + KDIMG_OFF + d * KDIMG_STRIDE + 2 * p0) = o; }
            const LAS v4u* as = (const LAS v4u*)ATT + 2 * t; v4u* ag = (v4u*)((bf16*)(F.ws + WS_ATTN) + (size_t)ch * 4096) + 2 * t; ag[0] = as[0]; ag[1] = as[1];
        }
        LDS_WAIT(); __syncthreads();
        { v4u* rec = (v4u*)(F.ws + WS_REC + (size_t)ch * REC_BYTES);
            for (int i = tid; i < IMG_USED / 16; i += NTHREADS) rec[i] = *(const LAS v4u*)(IMG + 16 * i); }
        LDS_WAIT(); __syncthreads();
    }
}

__device__ __forceinline__ void gdn_scan_phase(Frame& F) {
    const int j = blockIdx.x; if (j >= 64) return;
    const int bh = j & 15, quarter = j >> 4;
    const int lane = F.lane, wave = F.wave, r = lane & 31, hh = lane >> 5;
    const unsigned char* REC = F.ws + WS_REC + (size_t)bh * 128 * REC_BYTES;
#define SCAN_BAR() do { asm volatile("s_waitcnt lgkmcnt(0)" ::: "memory"); __builtin_amdgcn_s_barrier(); asm volatile("" ::: "memory"); } while (0)
#define SCAN_DMA(n_) do { _Pragma("unroll") for (int k_ = 0; k_ < 6; ++k_) { const int piece_ = (wave - 1) + 6 * k_; \
        __builtin_amdgcn_global_load_lds((const unsigned*)(REC + (size_t)(n_) * REC_BYTES + piece_ * 1024 + lane * 16), (PG8_LAS unsigned*)(F.lds + ((n_) % 3) * REC_BYTES + piece_ * 1024), 16, 0, 0); } } while (0)
    if (wave == 7) {
        const unsigned char* uw = (const unsigned char*)((const float*)(F.ws + WS_UT) + (size_t)bh * 128 * (128 * 64) + (size_t)(32 * quarter) * 64) + lane * 16;
        v4u dummy = {0u, 0u, 0u, 0u};
        SCAN_BAR();
        for (int n = 0; n < 128; ++n) {
            const int nw = n + 3 < 128 ? n + 3 : 127;
            asm volatile("s_waitcnt vmcnt(8)" : "+v"(dummy) :: "memory");
#pragma unroll
            for (int k_ = 0; k_ < 8; ++k_) asm volatile("global_load_dwordx4 %0, %1, off" : "+v"(dummy) : "v"(uw + (size_t)nw * (128 * 64 * 4) + k_ * 1024) : "memory");
            SCAN_BAR();
        }
        asm volatile("s_waitcnt vmcnt(0)" : "+v"(dummy) :: "memory");
    }
    else if (wave >= 1) {
        SCAN_DMA(0); SCAN_DMA(1); VM_WAIT(); SCAN_BAR();
        for (int n = 0; n < 128; ++n) {
            if (n + 2 < 128) { SCAN_DMA(n + 2); asm volatile("s_waitcnt vmcnt(6)" ::: "memory"); }
            else VM_WAIT();
            SCAN_BAR();
        }
    } else {
        const int cw = quarter;
        const float* UT = (const float*)(F.ws + WS_UT) + (size_t)bh * 128 * (128 * 64) + (size_t)(32 * cw + r) * 64 + 4 * hh;
        v4u* SST = (v4u*)(F.ws + WS_SST) + (size_t)bh * 128 * (4 * 8 * 64) + (size_t)cw * (8 * 64) + lane;
        v4u* VST = (v4u*)(F.ws + WS_VST) + (size_t)bh * 128 * (4 * 4 * 64) + (size_t)cw * (4 * 64) + lane;
        const float* EGLp = (const float*)(F.ws + WS_EGL) + bh * 128;
        f32x16 S[4];
#pragma unroll
        for (int t = 0; t < 4; ++t)
#pragma unroll
            for (int i = 0; i < 16; ++i) S[t][i] = 0.f;
        unsigned sbw[8][4];
#pragma unroll
        for (int q = 0; q < 8; ++q)
#pragma unroll
            for (int w = 0; w < 4; ++w) sbw[q][w] = 0u;
#define SB_FRAG(q_) __builtin_bit_cast(bf16x8, (v4u){sbw[q_][0], sbw[q_][1], sbw[q_][2], sbw[q_][3]})
#define SB_PACK_QUARTER(t_, qq_) do { const int s_ = (qq_) >> 1, h_ = (qq_) & 1; \
        sbw[2 * (t_) + s_][2 * h_] = pkn(S[t_][8 * s_ + 4 * h_], S[t_][8 * s_ + 4 * h_ + 1]); sbw[2 * (t_) + s_][2 * h_ + 1] = pkn(S[t_][8 * s_ + 4 * h_ + 2], S[t_][8 * s_ + 4 * h_ + 3]); } while (0)
        SCAN_BAR();
        for (int n = 0; n < 128; ++n) {
            const LAS unsigned char* buf = F.lds + (n % 3) * REC_BYTES;
            f32x4 un[4]; f32x16 acc[2];
            { const float* up = UT + (size_t)n * (128 * 64);
#pragma unroll
                for (int q = 0; q < 4; ++q) un[q] = *(const f32x4*)(up + 8 * q);
#pragma unroll
                for (int q = 0; q < 4; ++q) { const f32x4 v = *(const f32x4*)(up + 32 + 8 * q); acc[1][4 * q] = v[0]; acc[1][4 * q + 1] = v[1]; acc[1][4 * q + 2] = v[2]; acc[1][4 * q + 3] = v[3]; } }
            const float egl = EGLp[n];
            const LAS unsigned char* wb = buf + r * WIMG_STRIDE + 16 * hh;
            const LAS unsigned char* kb = buf + KDIMG_OFF + r * KDIMG_STRIDE + 16 * hh;
#define SCAN_FRAG(i_) ((i_) < 16 ? *(const LAS bf16x8*)(wb + ((i_) >> 3) * 32 * WIMG_STRIDE + 32 * ((i_) & 7)) : *(const LAS bf16x8*)(kb + (((i_) - 16) >> 2) * 32 * KDIMG_STRIDE + 32 * (((i_) - 16) & 3)))
            bf16x8 ring[6];
#pragma unroll
            for (int i = 0; i < 6; ++i) ring[i] = SCAN_FRAG(i);
#pragma unroll
            for (int i = 0; i < 16; ++i) acc[0][i] = 0.f;
            __builtin_amdgcn_sched_barrier(0);
#pragma unroll
            for (int i = 0; i < 16; ++i) {
                acc[i >> 3] = __builtin_amdgcn_mfma_f32_32x32x16_bf16(ring[i % 6], SB_FRAG(i & 7), acc[i >> 3], 0, 0, 0);
                ring[i % 6] = SCAN_FRAG(i + 6);
                if (i < 4) SB_PACK_QUARTER(3, i);
                __builtin_amdgcn_sched_barrier(0);
            }
#pragma unroll
            for (int q = 0; q < 4; ++q) { acc[0][4 * q] += un[q][0]; acc[0][4 * q + 1] += un[q][1]; acc[0][4 * q + 2] += un[q][2]; acc[0][4 * q + 3] += un[q][3]; }
            bf16x8 Vb[4];
#pragma unroll
            for (int mt = 0; mt < 2; ++mt) { Vb[2 * mt] = pack_step(acc[mt], 0); Vb[2 * mt + 1] = pack_step(acc[mt], 1); }
#pragma unroll
            for (int ks = 0; ks < 4; ++ks) VST[(size_t)n * (4 * 4 * 64) + ks * 64] = __builtin_bit_cast(v4u, Vb[ks]);
#pragma unroll
            for (int ks = 0; ks < 8; ++ks) SST[(size_t)n * (4 * 8 * 64) + ks * 64] = (v4u){sbw[ks][0], sbw[ks][1], sbw[ks][2], sbw[ks][3]};
#pragma unroll
            for (int i = 0; i < 16; ++i) S[0][i] *= egl;
            __builtin_amdgcn_sched_barrier(0);
#pragma unroll
            for (int i = 16; i < 32; ++i) { const int t = (i - 16) >> 2, ks = (i - 16) & 3;
                S[t] = __builtin_amdgcn_mfma_f32_32x32x16_bf16(ring[i % 6], Vb[ks], S[t], 0, 0, 0);
                if (i + 6 < 32) ring[i % 6] = SCAN_FRAG(i + 6);
                if (t < 3) {
#pragma unroll
                    for (int e = 0; e < 4; ++e) S[t + 1][4 * ks + e] *= egl; }
                if (t >= 1) SB_PACK_QUARTER(t - 1, ks);
                __builtin_amdgcn_sched_barrier(0);
            }
#undef SCAN_FRAG
            SCAN_BAR();
        }
#undef SB_FRAG
#undef SB_PACK_QUARTER
    }
#undef SCAN_DMA
#undef SCAN_BAR
    VM_WAIT(); __syncthreads();
}

__device__ __forceinline__ void gdn_out_phase(Frame& F, const float* out_norm  ) {
    const bf16* PROJ = (const bf16*)(F.ws + WS_PROJ); bf16* Y = (bf16*)(F.ws + WS_Y);
    const int lane = F.lane, r = lane & 31, hh = lane >> 5;
    LAS float* ot = (LAS float*)(F.lds + F.wave * 16384);
    float gain[8];
    { const f32x4 a = *(const f32x4*)(out_norm + 8 * (lane & 15)), b = *(const f32x4*)(out_norm + 8 * (lane & 15) + 4);
        gain[0] = a[0]; gain[1] = a[1]; gain[2] = a[2]; gain[3] = a[3]; gain[4] = b[0]; gain[5] = b[1]; gain[6] = b[2]; gain[7] = b[3]; }
    for (int wu = F.gw; wu < 4096; wu += F.NGW) {
        const int ch = wu >> 1, mt = wu & 1, n = ch & 127, bh = ch >> 7, b = bh >> 3, h = bh & 7, m0 = b * SEQ + n * 64 + 32 * mt;
        const bf16* qd = (const bf16*)(F.ws + WS_QD) + (size_t)ch * 64 * 128 + (32 * mt + r) * 128 + 8 * hh;
        const bf16* at = (const bf16*)(F.ws + WS_ATTN) + (size_t)ch * 4096 + (32 * mt + r) * 64 + 8 * hh;
        const v4u* sst = (const v4u*)(F.ws + WS_SST) + (size_t)ch * (4 * 8 * 64) + lane;
        const v4u* vst = (const v4u*)(F.ws + WS_VST) + (size_t)ch * (4 * 4 * 64) + lane;
        bf16x8 qa[8], aa[4];
#pragma unroll
        for (int ks = 0; ks < 8; ++ks) qa[ks] = __builtin_bit_cast(bf16x8, *(const v4u*)(qd + 16 * ks));
#pragma unroll
        for (int ks = 0; ks < 4; ++ks) aa[ks] = __builtin_bit_cast(bf16x8, *(const v4u*)(at + 16 * ks));
#pragma unroll
        for (int nt = 0; nt < 4; ++nt) {
            f32x16 acc;
#pragma unroll
            for (int i = 0; i < 16; ++i) acc[i] = 0.f;
#pragma unroll
            for (int ks = 0; ks < 8; ++ks) acc = __builtin_amdgcn_mfma_f32_32x32x16_bf16(qa[ks], __builtin_bit_cast(bf16x8, sst[nt * (8 * 64) + ks * 64]), acc, 0, 0, 0);
#pragma unroll
            for (int ks = 0; ks < 4; ++ks) acc = __builtin_amdgcn_mfma_f32_32x32x16_bf16(aa[ks], __builtin_bit_cast(bf16x8, vst[nt * (4 * 64) + ks * 64]), acc, 0, 0, 0);
#pragma unroll
            for (int i = 0; i < 16; ++i) ot[((i & 3) + 8 * (i >> 2) + 4 * hh) * 128 + 32 * nt + r] = acc[i];
        }
        LDS_WAIT();
#pragma unroll 2
        for (int k = 0; k < 8; ++k) {
            const int row = 4 * k + (lane >> 4), chunk = lane & 15;
            const f32x4 o0 = *(const LAS f32x4*)(ot + row * 128 + 8 * chunk), o1 = *(const LAS f32x4*)(ot + row * 128 + 8 * chunk + 4);
            float zz[8]; unpack8(*(const v4u*)(PROJ + (size_t)(m0 + row) * NMIX + PC_Z + h * GD + 8 * chunk), zz);
            float ss = (o0[0] * o0[0] + o0[1] * o0[1]) + (o0[2] * o0[2] + o0[3] * o0[3]) + (o1[0] * o1[0] + o1[1] * o1[1]) + (o1[2] * o1[2] + o1[3] * o1[3]);
            ss += __shfl_xor(ss, 1); ss += __shfl_xor(ss, 2); ss += __shfl_xor(ss, 4); ss += __shfl_xor(ss, 8);
            const float rstd = 1.0f / sqrtf(ss * (1.0f / GD) + EPS);
            float y[8];
#pragma unroll
            for (int e = 0; e < 4; ++e) { y[e] = o0[e] * rstd * gain[e] * silu_f(zz[e]); y[4 + e] = o1[e] * rstd * gain[4 + e] * silu_f(zz[4 + e]); }
            v4u w; w.x = pkn(y[0], y[1]); w.y = pkn(y[2], y[3]); w.z = pkn(y[4], y[5]); w.w = pkn(y[6], y[7]);
            *(v4u*)(Y + (size_t)(m0 + row) * D + h * GD + 8 * chunk) = w;
        }
        LDS_WAIT();
    }
}

#ifndef GDN_REF
#define GDN_REF 0
#endif
#ifndef REPMASK
#define REPMASK 0u
#endif
__device__ __forceinline__ int nrep_opaque(int n) { asm volatile("" : "+s"(n)); return n; }
#define NREP(k) (((((REPMASK) >> (k)) & 1)) ? nrep_opaque(2) : 1)
#ifndef PHMASK
#define PHMASK 0xFFFFFFFFu
#endif
struct Args { const float* in[21]; float* out; unsigned char* ws; int pro_lo, pro_hi, l_lo, l_hi, ph_lo, ph_hi, one, fin; };
enum { PH_MIXIN = 3, PH_GDNPRE, PH_GDNSCAN, PH_OUTGATE, PH_MIXOUT, PH_SCORES, PH_ATTOUT, PH_UP, PH_SWIGLU, PH_DOWN, PH_END };

typedef const __attribute__((address_space(4))) Args* KArgP;
__device__ __forceinline__ KArgP kargs() { KArgP ap = (KArgP)__builtin_amdgcn_kernarg_segment_ptr(); asm volatile("" : "+s"(ap)); return ap; }
__device__ __forceinline__ Frame mkframe(KArgP ap, LAS unsigned char* lds) {
    Frame F; int t = threadIdx.x; asm volatile("" : "+v"(t));
    F.lds = lds; F.tid = t; F.lane = t & 63; F.wave = __builtin_amdgcn_readfirstlane(t >> 6);
    F.G = gridDim.x; F.gw = blockIdx.x * NWAVES + F.wave; F.NGW = F.G * NWAVES; F.ws = ap->ws;
    return F;
}
__global__ void __launch_bounds__(NTHREADS, 2) trunk_fwd(Args args) {
    extern __shared__ __attribute__((aligned(16))) unsigned char lds_raw[];
    LAS unsigned char* const lds = (LAS unsigned char*)lds_raw;
    for (int u = threadIdx.x; u < (LDS_BYTES - LDSCTL_OFF) / 4; u += NTHREADS) ((LAS unsigned*)(lds + LDSCTL_OFF))[u] = 0u;
    __syncthreads();
    XcdBarrier bar; bar.bar = (unsigned*)(args.ws + WS_CTL) + CW_BAR; bar.x = 0; bar.st = nullptr;
    const bool one = args.one != 0;
    if (one) bar = xcd_barrier_post((unsigned*)(args.ws + WS_CTL) + CW_BAR, (volatile LAS unsigned*)(lds + MISC_OFF) + 8);
#define SEAM() do { if (one) xcd_barrier(bar); } while (0)
#define PHASE_BEGIN() KArgP ap = kargs(); Frame F = mkframe(ap, lds); PG8_LAS unsigned char* ring = (PG8_LAS unsigned char*)(lds + RING_OFF); (void)ring; float* const XR = ap->out; (void)XR; \
    bf16* const HA = (bf16*)(F.ws + WS_H); (void)HA; bf16* const HB = (bf16*)(F.ws + WS_HB); (void)HB; float* const SSQ = (float*)(F.ws + WS_SSQ); (void)SSQ
#define PRO(k) ((((PHMASK) >> (k)) & 1) && args.pro_lo <= (k) && (k) < args.pro_hi)

    if (PRO(0)) {
        PHASE_BEGIN();
        for (int rep = 0; rep < NREP(0); ++rep) { if (rep) SEAM();
        p0_weights_x(F, ap->in[IN_W_XQ], ap->in[IN_W_XK], ap->in[IN_W_XV], ap->in[IN_W_XO]);
        p0_weights_main(F, 0, F.gw, F.NGW, ap->in[IN_W_MIX_IN], ap->in[IN_W_MIX_OUT], ap->in[IN_W_UP], ap->in[IN_W_DOWN]);
        p0_memn(F, ap->in[IN_MEM], ap->in[IN_MEM_NORM]);
        prenorm_phase(F, ap->in[IN_X], ap->in[IN_MIX_NORM], HB, SSQ); }
        SEAM();
    }
    if (PRO(1)) {
        PHASE_BEGIN();
        KvOrder S{F.G, (int)blockIdx.x, (const bf16*)(F.ws + WS_MEMN), (const bf16*)(F.ws + WS_WXK), (const bf16*)(F.ws + WS_WXV)};
        pg8::Gemm g{nullptr, nullptr, D, D, D};
        pg8::EpiBf16<LocKv, false> E{LocKv{(bf16*)(F.ws + WS_KX), (bf16*)(F.ws + WS_VX)}, 1.0f, nullptr};
        pg8::gemm_phase<pg8::EpiBf16<LocKv, false>, KvOrder, true>(ring, g, S, E);
        SEAM();
    }
    if (PRO(2)) {
        PHASE_BEGIN();
        PreOrder S{F.G, (int)blockIdx.x, (const bf16*)(F.ws + WS_KX), (const bf16*)(F.ws + WS_VX), (const bf16*)(F.ws + WS_WXQ), (const bf16*)(F.ws + WS_WXO)};
        pg8::Gemm g{nullptr, nullptr, D, D, XD};
        pg8::EpiBf16<LocPre, false> E{LocPre{(bf16*)(F.ws + WS_WQK), (bf16*)(F.ws + WS_VWO)}, 1.0f, nullptr};
        pg8::gemm_phase<pg8::EpiBf16<LocPre, false>, PreOrder, true>(ring, g, S, E);
        SEAM();
    }
    const int lo = args.ph_lo, hi = args.ph_hi;
#define IN(k) ((((PHMASK) >> (k)) & 1) && lo <= (k) && (k) < hi)
    for (int l = args.l_lo; l < args.l_hi; ++l) {
        if (IN(PH_MIXIN)) {
            PHASE_BEGIN();
            ba_phase(F, HB, SSQ + (size_t)(3 * l) * M, (const bf16*)(F.ws + WS_WBA) + (size_t)l * 16 * D, ap->in[IN_A_LOG] + l * GH, ap->in[IN_DT_BIAS] + l * GH);
            pg8::Gemm g{HB, (const bf16*)(F.ws + WS_WMIX) + (size_t)l * NMIX * D, D, D, D}; pg8::StaticOrder S; S.init(M, NMIX, F.G, (int)blockIdx.x);
            pg8::EpiBf16<pg8::LocPlain, true> E{pg8::LocPlain{(bf16*)(F.ws + WS_PROJ), NMIX}, 1.0f, SSQ + (size_t)(3 * l) * M};
            for (int rep = 0; rep < NREP(3); ++rep) { if (rep) SEAM();
            pg8::gemm_phase<pg8::EpiBf16<pg8::LocPlain, true>, pg8::StaticOrder, true>(ring, g, S, E); }
            SEAM();
        }
        if (IN(PH_GDNPRE)) { PHASE_BEGIN(); for (int rep = 0; rep < NREP(4); ++rep) { if (rep) SEAM(); gdn_prep_phase(F, ap->in[IN_GDN_CONV] + (size_t)l * 4 * 3 * GW); } SEAM(); }
        if (IN(PH_GDNSCAN)) {
            PHASE_BEGIN();
            if (blockIdx.x < 64 || F.G <= 64) { for (int rep = 0; rep < NREP(5); ++rep) { if (rep) SEAM(); gdn_scan_phase(F); } }
            if (F.G <= 64) shortconv_phase(F, ap->in[IN_SC_CONV] + (size_t)l * 3 * SCW, F.gw, F.NGW);
            else if (blockIdx.x >= 64) shortconv_phase(F, ap->in[IN_SC_CONV] + (size_t)l * 3 * SCW, F.gw - 64 * NWAVES, F.NGW - 64 * NWAVES);
            if (l + 1 < DEPTH) { if (F.G <= 64) p0_weights_main(F, l + 1, F.gw, F.NGW, ap->in[IN_W_MIX_IN], ap->in[IN_W_MIX_OUT], ap->in[IN_W_UP], ap->in[IN_W_DOWN]);
                else if (blockIdx.x >= 64) p0_weights_main(F, l + 1, F.gw - 64 * NWAVES, F.NGW - 64 * NWAVES, ap->in[IN_W_MIX_IN], ap->in[IN_W_MIX_OUT], ap->in[IN_W_UP], ap->in[IN_W_DOWN]); }
            SEAM(); }
        if (IN(PH_OUTGATE)) { PHASE_BEGIN(); for (int rep = 0; rep < NREP(6); ++rep) { if (rep) SEAM(); gdn_out_phase(F, ap->in[IN_OUT_NORM] + (size_t)l * GD); } SEAM(); }
        if (IN(PH_MIXOUT)) {
            PHASE_BEGIN();
            pg8::Gemm g{(const bf16*)(F.ws + WS_Y), (const bf16*)(F.ws + WS_WOUT) + (size_t)l * D * D, D, D, D}; pg8::StaticOrder S; S.init(M, D, F.G, (int)blockIdx.x);
            pg8::EpiResNorm E{l == 0 ? ap->in[IN_X] : XR, XR, D, HA, ap->in[IN_XATTN_NORM] + (size_t)l * D, SSQ + (size_t)(3 * l + 1) * M};
            if (NREP(7) > 1) { pg8::EpiResNorm E0 = E; E0.out = (float*)(F.ws + WS_BIG); E0.hn = (pg8::bf16_t*)(F.ws + WS_BIG + 160 * MiB); E0.ssq = (float*)(F.ws + WS_BIG + 256 * MiB);
            pg8::gemm_phase<pg8::EpiResNorm, pg8::StaticOrder, true>(ring, g, S, E0); SEAM(); }
            pg8::gemm_phase<pg8::EpiResNorm, pg8::StaticOrder, true>(ring, g, S, E);
            SEAM();
        }
        if (IN(PH_SCORES)) {
            PHASE_BEGIN();
            pg8::Gemm g{HA, (const bf16*)(F.ws + WS_WQK) + (size_t)l * 2 * (XH * NMEM) * D, D, D, D}; SOrder S{F.G, (int)blockIdx.x};
            pg8::EpiSoftmax E{(bf16*)(F.ws + WS_PB), XH * NMEM, 0.044194173824159216f * 1.4426950408889634f, SSQ + (size_t)(3 * l + 1) * M};
            for (int rep = 0; rep < NREP(8); ++rep) { if (rep) SEAM();
            pg8::gemm_phase<pg8::EpiSoftmax, SOrder, false>(ring, g, S, E); }
            SEAM();
        }
        if (IN(PH_ATTOUT)) {
            PHASE_BEGIN();
            pg8::Gemm g{(const bf16*)(F.ws + WS_PB), (const bf16*)(F.ws + WS_VWO) + (size_t)l * 2 * D * (XH * NMEM), XH * NMEM, XH * NMEM, XH * NMEM};
            BatchOrder S; S.init(M, D, F.G, (int)blockIdx.x); S.bstride = (size_t)D * (XH * NMEM);
            pg8::EpiResNorm E{XR, XR, D, HA, ap->in[IN_FFN_NORM] + (size_t)l * D, SSQ + (size_t)(3 * l + 2) * M};
            if (NREP(9) > 1) { pg8::EpiResNorm E0 = E; E0.out = (float*)(F.ws + WS_BIG); E0.hn = (pg8::bf16_t*)(F.ws + WS_BIG + 160 * MiB); E0.ssq = (float*)(F.ws + WS_BIG + 256 * MiB);
            pg8::gemm_phase<pg8::EpiResNorm, BatchOrder, true>(ring, g, S, E0); SEAM(); }
            pg8::gemm_phase<pg8::EpiResNorm, BatchOrder, true>(ring, g, S, E);
            SEAM();
        }
        if (IN(PH_UP)) {
            PHASE_BEGIN();
            pg8::Gemm g{HA, (const bf16*)(F.ws + WS_WUP) + (size_t)l * 2 * DFF * D, D, D, D}; pg8::StaticOrder S; S.init(M, 2 * DFF, F.G, (int)blockIdx.x);
            pg8::EpiSwiglu E{(bf16*)(F.ws + WS_ACT), (float*)(F.ws + WS_PART), (float*)(F.ws + WS_HALO), ap->in[IN_FFN_CONV] + (size_t)l * 3 * 2 * DFF, SSQ + (size_t)(3 * l + 2) * M, (PG8_LAS float*)(lds + XB_OFF), DFF};
            pg8::gemm_phase<pg8::EpiSwiglu, pg8::StaticOrder, true>(ring, g, S, E);
            SEAM();
        }
        if (IN(PH_SWIGLU)) { PHASE_BEGIN(); swiglu_fix_phase(F, ap->in[IN_FFN_CONV] + (size_t)l * 3 * 2 * DFF); SEAM(); }
        if (IN(PH_DOWN)) {
            PHASE_BEGIN();
            pg8::Gemm g{(const bf16*)(F.ws + WS_ACT), (const bf16*)(F.ws + WS_WDN) + (size_t)l * D * DFF, DFF, DFF, DFF}; pg8::StaticOrder S; S.init(M, D, F.G, (int)blockIdx.x);
            const bool last = l + 1 >= DEPTH;
            pg8::EpiResNorm E{XR, XR, D, last ? nullptr : HB, ap->in[IN_MIX_NORM] + (size_t)(last ? l : l + 1) * D, SSQ + (size_t)(last ? 0 : 3 * (l + 1)) * M};
            if (NREP(12) > 1) { pg8::EpiResNorm E0 = E; E0.out = (float*)(F.ws + WS_BIG); E0.hn = (pg8::bf16_t*)(F.ws + WS_BIG + 160 * MiB); E0.ssq = (float*)(F.ws + WS_BIG + 256 * MiB);
            pg8::gemm_phase<pg8::EpiResNorm, pg8::StaticOrder, true>(ring, g, S, E0); SEAM(); }
            pg8::gemm_phase<pg8::EpiResNorm, pg8::StaticOrder, true>(ring, g, S, E);
            SEAM();
        }
    }
    if ((((PHMASK) >> 30) & 1) && args.fin) { PHASE_BEGIN(); final_norm_phase(F, XR, ap->in[IN_FINAL_NORM], ap->out); }
#undef IN
#undef PRO
#undef SEAM
#undef PHASE_BEGIN
}

extern "C" void kernel_launch(void* const* d_in, const int* in_sizes, int n_in, void* d_out, int out_size, void* d_ws, size_t ws_size, hipStream_t stream) {
    static int grid = 0;
    if (grid == 0) {
        if (n_in != 21 || in_sizes[0] != M * D || out_size != M * D || ws_size < WS_END) { fprintf(stderr, "kernel_launch: unexpected shapes / workspace (n_in %d, in0 %d, out %d, ws %zu < %zu); nothing launched\n", n_in, n_in > 0 ? in_sizes[0] : -1, out_size, ws_size, (size_t)WS_END); grid = -1; return; }
        int dev = 0, cus = 0, per_cu = 0;
        if (hipGetDevice(&dev) != hipSuccess || hipDeviceGetAttribute(&cus, hipDeviceAttributeMultiprocessorCount, dev) != hipSuccess) { fprintf(stderr, "kernel_launch: device query failed\n"); grid = -1; return; }
        if (hipFuncSetAttribute((const void*)trunk_fwd, hipFuncAttributeMaxDynamicSharedMemorySize, LDS_BYTES) != hipSuccess) { fprintf(stderr, "kernel_launch: hipFuncSetAttribute failed\n"); grid = -1; return; }
        if (hipOccupancyMaxActiveBlocksPerMultiprocessor(&per_cu, (const void*)trunk_fwd, NTHREADS, LDS_BYTES) != hipSuccess || per_cu < 1)
            fprintf(stderr, "kernel_launch: note: occupancy query reports %d workgroups per CU\n", per_cu);
        (void)hipGetLastError();
        if (cus != 256) { fprintf(stderr, "kernel_launch: built for 256 CUs, device has %d; nothing launched\n", cus); grid = -1; return; }
        grid = cus;
    }
    if (grid < 0) return;
    if (hipMemsetAsync((char*)d_ws + WS_CTL, 0, CTL_ZERO_BYTES, stream) != hipSuccess) { fprintf(stderr, "kernel_launch: memset failed\n"); return; }
    Args a{};
    for (int i = 0; i < 21; ++i) a.in[i] = (const float*)d_in[i];
    a.out = (float*)d_out; a.ws = (unsigned char*)d_ws;
#if MK_ONE_LAUNCH
    a.pro_lo = 0; a.pro_hi = 3; a.l_lo = 0; a.l_hi = DEPTH; a.ph_lo = PH_MIXIN; a.ph_hi = PH_END; a.one = 1; a.fin = 1;
    hipLaunchKernelGGL(trunk_fwd, dim3(grid), dim3(NTHREADS), LDS_BYTES, stream, a);
#else
    a.one = 0; a.fin = 0; a.l_lo = 0; a.l_hi = 0; a.ph_lo = 0; a.ph_hi = 0;
    for (int p = 0; p < 3; ++p) { a.pro_lo = p; a.pro_hi = p + 1; hipLaunchKernelGGL(trunk_fwd, dim3(grid), dim3(NTHREADS), LDS_BYTES, stream, a); }
    a.pro_lo = 0; a.pro_hi = 0;
    for (int l = 0; l < DEPTH; ++l)
        for (int p = PH_MIXIN; p < PH_END; ++p) { a.l_lo = l; a.l_hi = l + 1; a.ph_lo = p; a.ph_hi = p + 1;
            hipLaunchKernelGGL(trunk_fwd, dim3(grid), dim3(NTHREADS), LDS_BYTES, stream, a); }
    a.l_lo = 0; a.l_hi = 0; a.fin = 1;
    hipLaunchKernelGGL(trunk_fwd, dim3(grid), dim3(NTHREADS), LDS_BYTES, stream, a);
#endif
    const hipError_t le = hipPeekAtLastError();
    if (le != hipSuccess) fprintf(stderr, "kernel_launch: launch failed: %s\n", hipGetErrorName(le));
}
```

```cpp
#include <hip/hip_runtime.h>
#define MK_ONE_LAUNCH 1
#include <cstdio>
#include <cstdint>

#ifndef MK_ONE_LAUNCH
#define MK_ONE_LAUNCH 1
#endif

namespace pg8 {
#define PG8_LAS __attribute__((address_space(3)))
typedef unsigned short bf16_t;
typedef short bf16x8 __attribute__((ext_vector_type(8)));
typedef float f32x4 __attribute__((ext_vector_type(4)));
typedef float f32x2 __attribute__((ext_vector_type(2)));
typedef unsigned u32x4 __attribute__((ext_vector_type(4)));
constexpr int BM = 256, BK = 64, HALF = 128, HTB = HALF * BK * 2  , STAGE_BYTES = 8 * HTB, NXCD = 8, WGM = 4;

__host__ __device__ __forceinline__ int lds_byte(int r, int c) { const int st = (r >> 4) * 2 + (c >> 5), rr = r & 15, cc = c & 31, ob = rr * 64 + cc * 2; return st * 1024 + (ob ^ (((ob >> 9) & 1) << 5)); }
__host__ __device__ __forceinline__ void stage_rc(int b, int& R, int& C) { const int st = b / 1024, sb = b % 1024, swz = sb ^ (((sb >> 9) & 1) << 5); R = (st >> 1) * 16 + swz / 64; C = (st & 1) * 32 + (swz % 64) / 2; }
__host__ __device__ __forceinline__ int perm32(int rho) { const int n = rho >> 4, i = rho & 15; return 8 * (i >> 2) + 4 * n + (i & 3); }

struct Unit { int pm, pn; };
struct Gemm { const bf16_t* A; const bf16_t* Bt; int lda, ldb, K; };

struct StaticOrder {
    int nM, nN, nwg, G, c, wgm;
    __host__ __device__ void init(int M, int N, int G_, int c_, int wgm_ = WGM) { nM = M / BM; nN = N / BM; nwg = nM * nN; G = G_; c = c_; wgm = wgm_; }
    __host__ __device__ bool next(int i, Unit& u) const {
        const long L = (long)i * G + c; if (L >= nwg) return false;
        int wgid = (int)L; { const int q = nwg / NXCD, r = nwg % NXCD, xcd = wgid % NXCD, off = wgid / NXCD; wgid = (xcd < r ? xcd * (q + 1) : r * (q + 1) + (xcd - r) * q) + off; }
        const int nig = wgm * nN, gid = wgid / nig, fm = gid * wgm, gsz = (nM - fm) < wgm ? (nM - fm) : wgm;
        u.pm = fm + ((wgid % nig) % gsz); u.pn = (wgid % nig) / gsz; return true;
    }
    __device__ __forceinline__ const char* pa(const Gemm& g, const Unit& u) const { return (const char*)g.A + (size_t)u.pm * BM * g.lda * 2; }
    __device__ __forceinline__ const char* pb(const Gemm& g, const Unit& u) const { return (const char*)g.Bt + (size_t)u.pn * BM * g.ldb * 2; }
};

__device__ __forceinline__ float rcp_f(float x) { return __builtin_amdgcn_rcpf(x); }
__device__ __forceinline__ float rsq_f(float x) { return __builtin_amdgcn_rsqf(x); }
__device__ __forceinline__ unsigned cvt_pk_bf16(float lo, float hi) { unsigned r; asm volatile("v_cvt_pk_bf16_f32 %0, %1, %2" : "=v"(r) : "v"(lo), "v"(hi)); return r; }
typedef unsigned u32x2 __attribute__((ext_vector_type(2)));
__device__ __forceinline__ void xs_decode8(const u32x4 h, const u32x2 q, f32x2 (&x)[4]) {
#pragma unroll
    for (int e = 0; e < 8; ++e) { const unsigned sel = 0x0504000cu + 0x02020000u * (e & 1) + 0x100u * (e & 3);
        x[e >> 1][e & 1] = __uint_as_float(__builtin_amdgcn_perm(h[e >> 1], q[e >> 2], sel) - 0x8000u); }
}
__device__ __forceinline__ void xs_encode8(const f32x2 (&x)[4], u32x4& h, u32x2& q) {
    unsigned t[8];
#pragma unroll
    for (int e = 0; e < 8; ++e) t[e] = __float_as_uint(x[e >> 1][e & 1]) + 0x8080u;
#pragma unroll
    for (int k = 0; k < 4; ++k) h[k] = __builtin_amdgcn_perm(t[2 * k + 1], t[2 * k], 0x07060302u);
#pragma unroll
    for (int k = 0; k < 2; ++k) { const unsigned p01 = __builtin_amdgcn_perm(t[4 * k + 1], t[4 * k], 0x0c0c0501u), p23 = __builtin_amdgcn_perm(t[4 * k + 3], t[4 * k + 2], 0x0c0c0501u);
        q[k] = __builtin_amdgcn_perm(p23, p01, 0x05040100u); }
}
__device__ __forceinline__ float xs_sumsq8(const f32x2 (&x)[4]) { f32x2 s = x[0] * x[0]; s = x[1] * x[1] + s; s = x[2] * x[2] + s; s = x[3] * x[3] + s; return s[0] + s[1]; }


template <class Loc, bool RS  > struct EpiBf16 {
    static constexpr bool PERM = true, APERM = false, AFTER_DRAIN = false, ROWSCALE = RS;
    Loc loc; float scale; const float* ssq;
    __device__ __forceinline__ void operator()(const f32x4 (&acc)[2][2][4][2], const Unit& u, int wr, int wc, int fr, int fq, const PG8_LAS float* rows = nullptr) const {
        bf16_t* base; int ldc; loc(u, base, ldc);
        const int row0 = wr * 64 + fr, col0 = wc * 32 + 8 * fq;
        float sc[2][4];
#pragma unroll
        for (int ai = 0; ai < 2; ++ai)
#pragma unroll
            for (int m = 0; m < 4; ++m) sc[ai][m] = RS ? rows[row0 + ai * HALF + m * 16] : 0.f;
#pragma unroll
        for (int ai = 0; ai < 2; ++ai)
#pragma unroll
            for (int m = 0; m < 4; ++m) sc[ai][m] = RS ? this->scale * (rsq_f(sc[ai][m] * (1.0f / 2048.0f) + 1e-6f)) : this->scale;
#pragma unroll
        for (int ai = 0; ai < 2; ++ai)
#pragma unroll
            for (int m = 0; m < 4; ++m) { bf16_t* rowp = base + (size_t)(row0 + ai * HALF + m * 16) * ldc + col0;
                const float scale = sc[ai][m];
#pragma unroll
                for (int bj = 0; bj < 2; ++bj) { f32x4 v0 = acc[ai][bj][m][0] * scale, v1 = acc[ai][bj][m][1] * scale;
                    u32x4 w; w.x = cvt_pk_bf16(v0[0], v0[1]); w.y = cvt_pk_bf16(v0[2], v0[3]); w.z = cvt_pk_bf16(v1[0], v1[1]); w.w = cvt_pk_bf16(v1[2], v1[3]);
                    *(u32x4*)(rowp + bj * HALF) = w; } }
    }
};
struct EpiNull { static constexpr bool PERM = true, APERM = false, AFTER_DRAIN = false, ROWSCALE = false;
    __device__ __forceinline__ void operator()(const f32x4 (&acc)[2][2][4][2], const Unit&, int, int, int, int) const {
#pragma unroll
        for (int ai = 0; ai < 2; ++ai)
#pragma unroll
            for (int bj = 0; bj < 2; ++bj)
#pragma unroll
                for (int m = 0; m < 4; ++m)
#pragma unroll
                    for (int n = 0; n < 2; ++n) asm volatile("" :: "v"(acc[ai][bj][m][n])); } };
struct LocDummy { bf16_t* O; __device__ __forceinline__ void operator()(const Unit& u, bf16_t*& base, int& ld) const { base = O + (size_t)u.pm * BM * BM; ld = BM; } };
struct LocPlain { bf16_t* O; int ldc; __device__ __forceinline__ void operator()(const Unit& u, bf16_t*& base, int& ld) const { base = O + (size_t)u.pm * BM * ldc + (size_t)u.pn * BM; ld = ldc; } };

struct EpiResNorm {
    static constexpr bool PERM = true, APERM = false, AFTER_DRAIN = false, ROWSCALE = false;
    const bf16_t* rh; const unsigned char* rq; bf16_t* oh; unsigned char* oq; int ldc; float* ssq;
    __device__ __forceinline__ void operator()(const f32x4 (&acc)[2][2][4][2], const Unit& u, int wr, int wc, int fr, int fq) const {
        const int row0 = u.pm * BM + wr * 64 + fr, col0 = u.pn * BM + wc * 32 + 8 * fq;
        float ssv[8];
#pragma unroll
        for (int pr = 0; pr < 2; ++pr) {
            u32x4 hb[4][2]; u32x2 qb[4][2];
#pragma unroll
            for (int q = 0; q < 4; ++q) { const int it = 4 * pr + q; const size_t offq = (size_t)(row0 + (it >> 2) * HALF + (it & 3) * 16) * ldc + col0;
#pragma unroll
                for (int bj = 0; bj < 2; ++bj) { hb[q][bj] = *(const u32x4*)(rh + offq + bj * HALF); qb[q][bj] = *(const u32x2*)(rq + offq + bj * HALF); } }
            __builtin_amdgcn_sched_barrier(0);
#pragma unroll
            for (int q = 0; q < 4; ++q) { const int it = 4 * pr + q, ai = it >> 2, m = it & 3; const int row = row0 + ai * HALF + m * 16; const size_t off = (size_t)row * ldc + col0;
                float ss = 0.f;
#pragma unroll
                for (int bj = 0; bj < 2; ++bj) { f32x2 x[4]; xs_decode8(hb[q][bj], qb[q][bj], x);
#pragma unroll
                    for (int k = 0; k < 4; ++k) x[k] += (k & 1) ? acc[ai][bj][m][k >> 1].zw : acc[ai][bj][m][k >> 1].xy;
                    ss += xs_sumsq8(x);
                    u32x4 ho; u32x2 qo; xs_encode8(x, ho, qo);
                    *(u32x4*)(oh + off + bj * HALF) = ho; *(u32x2*)(oq + off + bj * HALF) = qo; }
                ss += __shfl_xor(ss, 16); ss += __shfl_xor(ss, 32);
                ssv[it] = ss;
            }
            __builtin_amdgcn_sched_barrier(0);
        }
        if (fq == 0) {
#pragma unroll
            for (int it = 0; it < 8; ++it) atomicAdd(ssq + row0 + (it >> 2) * HALF + (it & 3) * 16, ssv[it]);
        }
    }
};

struct EpiSoftmax {
    static constexpr bool PERM = true, APERM = false, AFTER_DRAIN = true, ROWSCALE = false;
    bf16_t* P; int ldc; float sl2e; const float* ssq;
    __device__ __forceinline__ void fused(f32x4 (&acc)[2][2][4][2], const Unit& u, int wr, int wc, int fr, int fq, PG8_LAS unsigned char* lds, int wid, int lane) const {
        PG8_LAS float* Pm = (PG8_LAS float*)lds;
        PG8_LAS float* Ps = (PG8_LAS float*)(lds + 4096);
        float rs[2][4];
#pragma unroll
        for (int ai = 0; ai < 2; ++ai)
#pragma unroll
            for (int m = 0; m < 4; ++m) rs[ai][m] = ssq[u.pm * BM + ai * HALF + wr * 64 + m * 16 + fr];
#pragma unroll
        for (int ai = 0; ai < 2; ++ai)
#pragma unroll
            for (int m = 0; m < 4; ++m) {
                float mx = -3.0e38f;
#pragma unroll
                for (int bj = 0; bj < 2; ++bj)
#pragma unroll
                    for (int n = 0; n < 2; ++n) { const f32x4 x = acc[ai][bj][m][n]; mx = fmaxf(mx, fmaxf(fmaxf(x[0], x[1]), fmaxf(x[2], x[3]))); }
                mx = fmaxf(mx, __shfl_xor(mx, 16)); mx = fmaxf(mx, __shfl_xor(mx, 32));
                if (fq == 0) Pm[(ai * HALF + wr * 64 + m * 16 + fr) * 4 + wc] = mx;
            }
        asm volatile("s_waitcnt lgkmcnt(0)" ::: "memory"); __builtin_amdgcn_s_barrier(); asm volatile("" ::: "memory");
#pragma unroll
        for (int ai = 0; ai < 2; ++ai)
#pragma unroll
            for (int m = 0; m < 4; ++m) {
                const int row = ai * HALF + wr * 64 + m * 16 + fr;
                const f32x4 pm4 = *(const PG8_LAS f32x4*)(Pm + row * 4);
                const float gm = fmaxf(fmaxf(pm4[0], pm4[1]), fmaxf(pm4[2], pm4[3]));
                const float sl2e = this->sl2e * (rsq_f(rs[ai][m] * (1.0f / 2048.0f) + 1e-6f));
                float s = 0.f;
#pragma unroll
                for (int bj = 0; bj < 2; ++bj)
#pragma unroll
                    for (int n = 0; n < 2; ++n) { f32x4 x = acc[ai][bj][m][n];
#pragma unroll
                        for (int j = 0; j < 4; ++j) { x[j] = __builtin_amdgcn_exp2f((x[j] - gm) * sl2e); s += x[j]; }
                        acc[ai][bj][m][n] = x; }
                s += __shfl_xor(s, 16); s += __shfl_xor(s, 32);
                if (fq == 0) Ps[row * 4 + wc] = s;
            }
        asm volatile("s_waitcnt lgkmcnt(0)" ::: "memory"); __builtin_amdgcn_s_barrier(); asm volatile("" ::: "memory");
        bf16_t* base = P + (size_t)u.pm * BM * ldc + (size_t)u.pn * BM;
#pragma unroll
        for (int ai = 0; ai < 2; ++ai)
#pragma unroll
            for (int m = 0; m < 4; ++m) {
                const int row = ai * HALF + wr * 64 + m * 16 + fr;
                const f32x4 ps4 = *(const PG8_LAS f32x4*)(Ps + row * 4);
                const float inv = rcp_f((ps4[0] + ps4[1]) + (ps4[2] + ps4[3]));
                bf16_t* rowp = base + (size_t)row * ldc + wc * 32 + 8 * fq;
#pragma unroll
                for (int bj = 0; bj < 2; ++bj) { const f32x4 v0 = acc[ai][bj][m][0] * inv, v1 = acc[ai][bj][m][1] * inv;
                    u32x4 w; w.x = cvt_pk_bf16(v0[0], v0[1]); w.y = cvt_pk_bf16(v0[2], v0[3]); w.z = cvt_pk_bf16(v1[0], v1[1]); w.w = cvt_pk_bf16(v1[2], v1[3]);
                    *(u32x4*)(rowp + bj * HALF) = w; }
            }
    }
};

__device__ __forceinline__ float dpp_shr1(float old, float v) { return __builtin_bit_cast(float, __builtin_amdgcn_update_dpp(__builtin_bit_cast(int, old), __builtin_bit_cast(int, v), 0x111, 0xf, 0xf, false)); }
struct EpiSwiglu {
    static constexpr bool PERM = true, APERM = true, AFTER_DRAIN = false, ROWSCALE = true;
    bf16_t* act; float* part; float* halo; const float* cw; const float* ssq; PG8_LAS float* xb; int dff;
    __device__ __forceinline__ void operator()(f32x4 (&acc)[2][2][4][2], const Unit& u, int wr, int wc, int fr, int fq, const PG8_LAS float* rows) const {
        const int ccol = wc * 32 + 8 * fq;
#pragma unroll
        for (int ai = 0; ai < 2; ++ai) { const f32x4 s4 = *(const PG8_LAS f32x4*)(rows + ai * HALF + wr * 64 + 4 * fr);
#pragma unroll
            for (int m = 0; m < 4; ++m) { const float sc = rsq_f(s4[m] * (1.0f / 2048.0f) + 1e-6f);
#pragma unroll
                for (int bj = 0; bj < 2; ++bj)
#pragma unroll
                    for (int n = 0; n < 2; ++n) acc[ai][bj][m][n] = acc[ai][bj][m][n] * sc; } }
        if (fr == 15) {
#pragma unroll
            for (int ai = 0; ai < 2; ++ai)
#pragma unroll
                for (int bj = 0; bj < 2; ++bj)
#pragma unroll
                    for (int n = 0; n < 2; ++n)
#pragma unroll
                        for (int k = 0; k < 2; ++k) { *(PG8_LAS f32x4*)(xb + ((wr * 2 + ai) * 2 + k) * 256 + bj * HALF + ccol + 4 * n) = acc[ai][bj][2 + k][n];
                            if (wr == 1 && ai == 1) *(f32x4*)(halo + ((size_t)(u.pm * 2 + k) * 2 + bj) * dff + u.pn * HALF + ccol + 4 * n) = acc[1][bj][2 + k][n]; }
        }
        asm volatile("s_waitcnt lgkmcnt(0)" ::: "memory"); __builtin_amdgcn_s_barrier(); asm volatile("" ::: "memory");
        u32x2 wsave[2][4];
#pragma unroll
        for (int n = 0; n < 2; ++n) {
            const int ch = u.pn * HALF + ccol + 4 * n;
            f32x4 wg[3], wu[3];
#pragma unroll
            for (int t = 0; t < 3; ++t) { wg[t] = *(const f32x4*)(cw + (size_t)t * 2 * dff + ch); wu[t] = *(const f32x4*)(cw + (size_t)t * 2 * dff + dff + ch); }
#pragma unroll
            for (int ai = 0; ai < 2; ++ai) {
                f32x4 e0g = {0.f, 0.f, 0.f, 0.f}, e1g = e0g, e0u = e0g, e1u = e0g;
                if (ai + wr > 0) { const int sw = wr ^ 1, sa = wr == 0 ? ai - 1 : ai; const PG8_LAS float* xp = xb + ((sw * 2 + sa) * 2) * 256 + ccol + 4 * n;
                    e0g = *(const PG8_LAS f32x4*)(xp); e1g = *(const PG8_LAS f32x4*)(xp + 256); e0u = *(const PG8_LAS f32x4*)(xp + HALF); e1u = *(const PG8_LAS f32x4*)(xp + 256 + HALF); }
                f32x4 p3g, p2g, p3u, p2u;
#pragma unroll
                for (int j = 0; j < 4; ++j) { p3g[j] = dpp_shr1(e1g[j], acc[ai][0][3][n][j]); p2g[j] = dpp_shr1(e0g[j], acc[ai][0][2][n][j]);
                    p3u[j] = dpp_shr1(e1u[j], acc[ai][1][3][n][j]); p2u[j] = dpp_shr1(e0u[j], acc[ai][1][2][n][j]); }
#pragma unroll
                for (int m = 0; m < 4; ++m) {
                    const f32x4 G = acc[ai][0][m][n], U = acc[ai][1][m][n];
                    const f32x4 g1 = m >= 1 ? acc[ai][0][m >= 1 ? m - 1 : 0][n] : p3g, g2 = m >= 2 ? acc[ai][0][m >= 2 ? m - 2 : 0][n] : (m == 1 ? p3g : p2g);
                    const f32x4 u1 = m >= 1 ? acc[ai][1][m >= 1 ? m - 1 : 0][n] : p3u, u2 = m >= 2 ? acc[ai][1][m >= 2 ? m - 2 : 0][n] : (m == 1 ? p3u : p2u);
                    const f32x4 cg = wg[2] * G + wg[1] * g1 + wg[0] * g2, cu = wu[2] * U + wu[1] * u1 + wu[0] * u2;
                    const int row = u.pm * BM + ai * HALF + wr * 64 + 4 * fr + m;
                    if (m < 2 && ai == 0 && wr == 0 && fr == 0) {
                        *(f32x4*)(part + ((size_t)(u.pm * 2 + m) * 2 + 0) * dff + ch) = cg; *(f32x4*)(part + ((size_t)(u.pm * 2 + m) * 2 + 1) * dff + ch) = cu;
                    } else {
                        f32x4 e;
#pragma unroll
                        for (int j = 0; j < 4; ++j) e[j] = rcp_f(1.0f + __expf(-cg[j]));
                        const f32x4 a = cg * cu * e;
                        u32x2 w; w.x = cvt_pk_bf16(a[0], a[1]); w.y = cvt_pk_bf16(a[2], a[3]);
                        if (n == 0) wsave[ai][m] = w;
                        else { u32x4 w4; w4.x = wsave[ai][m].x; w4.y = wsave[ai][m].y; w4.z = w.x; w4.w = w.y; *(u32x4*)(act + (size_t)row * dff + ch - 4) = w4; }
                    }
                }
                __builtin_amdgcn_sched_barrier(0);
            }
        }
    }
};

template <class Epi, class Sched, bool ALIGN_EPI = false>
__device__ __forceinline__ void gemm_phase(PG8_LAS unsigned char* lds, const Gemm g, const Sched& S, const Epi& E, int tid_in) {
    int tid_ = tid_in; asm volatile("" : "+v"(tid_));
    const int tid = tid_, wid = __builtin_amdgcn_readfirstlane(tid >> 6), lane = tid & 63, wr = wid >> 2, wc = wid & 3, fr = lane & 15, fq = lane >> 4;
    const int K = g.K, nt = K / BK;
    unsigned voffA[2], voffB[2];
#pragma unroll
    for (int i = 0; i < 2; ++i) { int R, C; stage_rc(tid * 16 + i * 8192, R, C); const int Rb = Epi::PERM ? ((R & ~31) + perm32(R & 31)) : R;
        const int Ra = Epi::APERM ? ((R & ~63) + 4 * (R & 15) + ((R >> 4) & 3)) : R;
        voffA[i] = (unsigned)(Ra * g.lda + C) * 2u; voffB[i] = (unsigned)(Rb * g.ldb + C) * 2u; }
    const size_t kstep = (size_t)(BK * 2);
    const size_t hstepA = (size_t)HALF * g.lda * 2, hstepB = (size_t)HALF * g.ldb * 2;
    const unsigned ldsw = (unsigned)wid * 1024u;
    const int aoff = lds_byte(wr * 64 + fr, fq * 8), boff = lds_byte(wc * 32 + fr, fq * 8);
#define PG8_SA(b, h) (((b) * 2 + (h)) * HTB)
#define PG8_SB(b, h) ((4 + (b) * 2 + (h)) * HTB)
#define PG8_STAGE(bufoff, gbase, voff) do { _Pragma("unroll") for (int _i = 0; _i < 2; ++_i) \
        __builtin_amdgcn_global_load_lds((const unsigned*)((const char*)(gbase) + (voff)[_i]), (PG8_LAS unsigned*)(lds + (bufoff) + ldsw + _i * 8192), 16, 0, 0); } while (0)
#define PG8_LDA(dst, b, h) do { _Pragma("unroll") for (int m = 0; m < 4; ++m) _Pragma("unroll") for (int k = 0; k < 2; ++k) dst[m][k] = *(const PG8_LAS bf16x8*)(lds + PG8_SA(b, h) + aoff + m * 2048 + k * 1024); } while (0)
#define PG8_LDB(dst, b, h) do { _Pragma("unroll") for (int n = 0; n < 2; ++n) _Pragma("unroll") for (int k = 0; k < 2; ++k) dst[n][k] = *(const PG8_LAS bf16x8*)(lds + PG8_SB(b, h) + boff + n * 2048 + k * 1024); } while (0)
#define PG8_MMA(ai, bj, At, Bt) do { __builtin_amdgcn_s_setprio(1); _Pragma("unroll") for (int m = 0; m < 4; ++m) _Pragma("unroll") for (int n = 0; n < 2; ++n) _Pragma("unroll") for (int k = 0; k < 2; ++k) \
        acc[ai][bj][m][n] = __builtin_amdgcn_mfma_f32_16x16x32_bf16(Bt[n][k], At[m][k], acc[ai][bj][m][n], 0, 0, 0); __builtin_amdgcn_s_setprio(0); } while (0)
#define PG8_WAIT_V(n) asm volatile("s_waitcnt vmcnt(" #n ")" ::: "memory")
#define PG8_WAIT_L(n) asm volatile("s_waitcnt lgkmcnt(" #n ")" ::: "memory")
#define PG8_BAR __builtin_amdgcn_s_barrier()
#define PG8_SCHED __builtin_amdgcn_sched_barrier(0)
    Unit cur, nxt; int ui = 0;
    if (!S.next(0, cur)) return;
    f32x4 acc[2][2][4][2];
#pragma unroll
    for (int a = 0; a < 2; ++a)
#pragma unroll
        for (int b = 0; b < 2; ++b)
#pragma unroll
            for (int m = 0; m < 4; ++m)
#pragma unroll
                for (int n = 0; n < 2; ++n) acc[a][b][m][n] = (f32x4){0.f, 0.f, 0.f, 0.f};
    bf16x8 At[4][2], B0[2][2], B1[2][2];
    const char* cA = S.pa(g, cur); const char* cB = S.pb(g, cur);
#define PG8_ROWS(ui_) ((const PG8_LAS float*)(lds + STAGE_BYTES + 1024 + 8192 + ((ui_) & 1) * 1024))
#define PG8_ROWFETCH(unit_, ui_) do { if constexpr (Epi::ROWSCALE) { if (wid < 4) __builtin_amdgcn_global_load_lds((const unsigned*)(E.ssq + (unit_).pm * BM + wid * 64 + lane), \
        (PG8_LAS unsigned*)(lds + STAGE_BYTES + 1024 + 8192 + ((ui_) & 1) * 1024 + wid * 256), 4, 0, 0); } } while (0)
    PG8_ROWFETCH(cur, 0);
    PG8_STAGE(PG8_SB(0, 0), cB, voffB); PG8_STAGE(PG8_SB(0, 1), cB + hstepB, voffB); PG8_STAGE(PG8_SA(0, 0), cA, voffA); PG8_STAGE(PG8_SA(0, 1), cA + hstepA, voffA);
    if (wr == 1) PG8_BAR;
    PG8_WAIT_V(2); PG8_BAR;
    PG8_STAGE(PG8_SB(1, 0), cB + kstep, voffB); PG8_STAGE(PG8_SA(1, 0), cA + kstep, voffA); PG8_STAGE(PG8_SB(1, 1), cB + hstepB + kstep, voffB);
    PG8_WAIT_V(6); PG8_BAR;
    for (;;) {
        const bool has_next = S.next(ui + 1, nxt);
        const char* nA = has_next ? S.pa(g, nxt) : cA; const char* nB = has_next ? S.pb(g, nxt) : cB;
#pragma nounroll
        for (int t = 0; t < nt; t += 2) {
            const bool last = (t == nt - 2);
            const char* a1 = cA + (size_t)(t + 1) * kstep;
            const char* a2 = last ? nA : cA + (size_t)(t + 2) * kstep; const char* b2 = last ? nB : cB + (size_t)(t + 2) * kstep;
            const char* a3 = a2 + kstep; const char* b3 = b2 + kstep;
            PG8_LDB(B0, 0, 0); PG8_LDB(B1, 0, 1); PG8_SCHED; PG8_LDA(At, 0, 0); PG8_STAGE(PG8_SA(1, 1), a1 + hstepA, voffA);
            PG8_WAIT_V(8); PG8_WAIT_L(0); PG8_BAR; PG8_MMA(0, 0, At, B0); PG8_MMA(0, 1, At, B1); PG8_BAR; PG8_SCHED;
            PG8_LDA(At, 0, 1); PG8_STAGE(PG8_SB(0, 0), b2, voffB); PG8_STAGE(PG8_SB(0, 1), b2 + hstepB, voffB); PG8_STAGE(PG8_SA(0, 0), a2, voffA);
            PG8_WAIT_V(8); PG8_WAIT_L(0); PG8_BAR; PG8_MMA(1, 0, At, B0); PG8_MMA(1, 1, At, B1); PG8_BAR; PG8_SCHED;
            PG8_LDB(B0, 1, 0); PG8_LDB(B1, 1, 1); PG8_SCHED; PG8_LDA(At, 1, 0); PG8_STAGE(PG8_SA(0, 1), a2 + hstepA, voffA);
            PG8_WAIT_V(8); PG8_WAIT_L(0); PG8_BAR; PG8_MMA(0, 0, At, B0); PG8_MMA(0, 1, At, B1); PG8_BAR; PG8_SCHED;
            PG8_LDA(At, 1, 1); PG8_STAGE(PG8_SB(1, 0), b3, voffB); PG8_STAGE(PG8_SB(1, 1), b3 + hstepB, voffB); PG8_STAGE(PG8_SA(1, 0), a3, voffA);
            PG8_WAIT_V(8); PG8_WAIT_L(0); PG8_BAR; PG8_MMA(1, 0, At, B0); PG8_MMA(1, 1, At, B1); PG8_BAR; PG8_SCHED;
        }
        if constexpr (ALIGN_EPI) { if (wr == 0) PG8_BAR; }
        if constexpr (!Epi::AFTER_DRAIN) { if constexpr (Epi::ROWSCALE) E(acc, cur, wr, wc, fr, fq, PG8_ROWS(ui)); else E(acc, cur, wr, wc, fr, fq); }
        if (!has_next) break;
#pragma unroll
        for (int a = 0; a < 2; ++a)
#pragma unroll
            for (int b = 0; b < 2; ++b)
#pragma unroll
                for (int m = 0; m < 4; ++m)
#pragma unroll
                    for (int n = 0; n < 2; ++n) acc[a][b][m][n] = (f32x4){0.f, 0.f, 0.f, 0.f};
        cur = nxt; cA = nA; cB = nB; ++ui;
        PG8_ROWFETCH(cur, ui);
        if constexpr (ALIGN_EPI) { if (wr == 1) PG8_BAR; }
    }
    PG8_WAIT_V(0);
    if constexpr (!ALIGN_EPI) { if (wr == 0) PG8_BAR; }
    PG8_BAR;
    if constexpr (Epi::AFTER_DRAIN) { E.fused(acc, cur, wr, wc, fr, fq, lds, wid, lane); }
#undef PG8_ROWS
#undef PG8_ROWFETCH
#undef PG8_SA
#undef PG8_SB
#undef PG8_STAGE
#undef PG8_LDA
#undef PG8_LDB
#undef PG8_MMA
#undef PG8_WAIT_V
#undef PG8_WAIT_L
#undef PG8_BAR
#undef PG8_SCHED
}
}

constexpr int BATCH = 2, SEQ = 8192, D = 2048, DEPTH = 4, M = BATCH * SEQ;
constexpr int GW = 1024, GH = 8, GD = 128, SCW = 1024, NMEM = 256, XH = 4, XD = 512, DFF = 5632;
constexpr int NMIX_SRC = 7184, NMIX = 7168;
constexpr int PC_Q = 0, PC_K = 1024, PC_V = 2048, PC_Z = 3072, PC_B = 4096, PC_C = 5120, PC_H = 6144;
constexpr float EPS = 1e-6f;
constexpr int NWAVES = 8, NTHREADS = 512;

constexpr size_t MiB = 1u << 20;
constexpr size_t WS_CTL = 0, CTL_ZERO_BYTES = 1 * MiB;
constexpr size_t WS_WMIX = 1 * MiB;
constexpr size_t WS_WOUT = WS_WMIX + 112 * MiB;
constexpr size_t WS_WXQ  = WS_WOUT + 32 * MiB;
constexpr size_t WS_WXK  = WS_WXQ + 32 * MiB;
constexpr size_t WS_WXV  = WS_WXK + 32 * MiB;
constexpr size_t WS_WXO  = WS_WXV + 32 * MiB;
constexpr size_t WS_WUP  = WS_WXO + 32 * MiB;
constexpr size_t WS_WDN  = WS_WUP + 176 * MiB;
constexpr size_t WS_MEMN = WS_WDN + 88 * MiB;
constexpr size_t WS_KX   = WS_MEMN + 8 * MiB;
constexpr size_t WS_VX   = WS_KX + 8 * MiB;
constexpr size_t WS_BETA = WS_VX + 8 * MiB;
constexpr size_t WS_WBA  = WS_BETA + 512 * 1024;
constexpr size_t WS_G    = WS_BETA + 1 * MiB;
constexpr size_t WS_H    = WS_G + 1 * MiB;
constexpr size_t WS_OG   = WS_H + 64 * MiB;
constexpr size_t WS_Y    = WS_OG + 64 * MiB;
constexpr size_t WS_PB   = WS_OG;
constexpr size_t WS_HB   = WS_Y + 64 * MiB;
constexpr size_t WS_BIG  = WS_HB + 64 * MiB;
constexpr size_t WS_PROJ = WS_BIG;
constexpr size_t WS_GS   = WS_BIG + 224 * MiB;
constexpr size_t WS_ACT  = WS_BIG;
constexpr size_t WS_HALO = WS_BIG + 192 * MiB;
constexpr size_t WS_PART = WS_BIG + 200 * MiB;
constexpr size_t WS_WQK  = WS_BIG + 416 * MiB;
constexpr size_t WS_VWO  = WS_WQK + 32 * MiB;
constexpr size_t WS_XQ   = WS_VWO + 32 * MiB;
constexpr size_t WS_END  = WS_XQ + 32 * MiB;
constexpr size_t WS_SSQ  = 65536;
static_assert(WS_SSQ + (size_t)(DEPTH * 3 + 1) * M * 4 <= CTL_ZERO_BYTES, "ssq arrays inside the zeroed region");
constexpr int CW_BAR = 4096;

constexpr int RING_OFF = 0, RING_BYTES = 131072;
constexpr int LDSCTL_OFF = RING_BYTES, MISC_OFF = LDSCTL_OFF + 320, XB_OFF = LDSCTL_OFF + 1024;
constexpr int LDS_BYTES = 147456;

#define GAS __attribute__((address_space(1)))
#define LAS __attribute__((address_space(3)))
typedef unsigned short bf16;
typedef unsigned v4u __attribute__((ext_vector_type(4)));
typedef unsigned v2u __attribute__((ext_vector_type(2)));
typedef float f32x4 __attribute__((ext_vector_type(4)));
typedef short bf16x8 __attribute__((ext_vector_type(8)));
#define LDS_WAIT() asm volatile("s_waitcnt lgkmcnt(0)" ::: "memory")
#define VM_WAIT() asm volatile("s_waitcnt vmcnt(0)" ::: "memory")
__device__ __forceinline__ unsigned pk2(float lo, float hi) { return pg8::cvt_pk_bf16(lo, hi); }
__device__ __forceinline__ float bf_lo(unsigned w) { return __uint_as_float(w << 16); }
__device__ __forceinline__ float bf_hi(unsigned w) { return __uint_as_float(w & 0xffff0000u); }
__device__ __forceinline__ float wave_sum(float v) {
#pragma unroll
    for (int o = 1; o < 64; o <<= 1) v += __shfl_xor(v, o);
    return v;
}
__device__ __forceinline__ float silu_f(float y) { return y * pg8::rcp_f(1.0f + __expf(-y)); }
__device__ __forceinline__ float sigmoid_f(float y) { return pg8::rcp_f(1.0f + __expf(-y)); }

#define XB_TMO      128
#define XB_XCNT(j)  (256  + 64 * (j))
#define XB_XSUB(j)  (1280 + 64 * (j))
#define XB_XGEN(j)  (2304 + 64 * (j))
#define XB_TOP      3328
#define XB_TOPGEN   3392
#define XCD_BAR_WORDS 3456
#define XB_SPIN_CAP (1u << 18)

__device__ __forceinline__ unsigned xb_ld(unsigned* p)              { return __hip_atomic_load(p, __ATOMIC_RELAXED, __HIP_MEMORY_SCOPE_AGENT); }
__device__ __forceinline__ unsigned xb_add(unsigned* p, unsigned v) { return __hip_atomic_fetch_add(p, v, __ATOMIC_RELAXED, __HIP_MEMORY_SCOPE_AGENT); }
__device__ __forceinline__ unsigned xb_xcc_id() { return (unsigned)__builtin_amdgcn_s_getreg((3 << 11) | 20) & 0xFu; }
#define XB_SPIN(cond, bar) do { unsigned _sp = 0; while (cond) { __builtin_amdgcn_s_sleep(1); \
    if ((++_sp & 255u) == 0u) { if (xb_ld(&(bar)[XB_TMO])) break; if (_sp > XB_SPIN_CAP) { atomicAdd(&(bar)[XB_TMO], 1u); break; } } } } while (0)

struct XcdBarrier {
    unsigned* bar; unsigned x;
    volatile LAS unsigned* st;
};

__device__ __forceinline__ XcdBarrier xcd_barrier_post(unsigned* bar, volatile LAS unsigned* st) {
    XcdBarrier b; b.bar = bar; b.x = xb_xcc_id(); b.st = st;
    if (threadIdx.x == 0) (void)xb_add(&bar[XB_XCNT(b.x)], 1u);
    return b;
}
__device__ __forceinline__ void xcd_barrier_complete(unsigned* bar, unsigned x, unsigned& nloc, unsigned& nx) {
    const unsigned G = gridDim.x * gridDim.y * gridDim.z;
    unsigned sum, cnt, mine, sp = 0u;
    for (;;) {
        sum = 0u; cnt = 0u; mine = 0u;
#pragma unroll
        for (unsigned j = 0; j < 16; ++j) { const unsigned c = xb_ld(&bar[XB_XCNT(j)]); sum += c; cnt += (c > 0u) ? 1u : 0u; mine = (j == x) ? c : mine; }
        if (sum == G) break;
        __builtin_amdgcn_s_sleep(1);
        if ((++sp & 255u) == 0u) { if (xb_ld(&bar[XB_TMO])) break; if (sp > XB_SPIN_CAP) { atomicAdd(&bar[XB_TMO], 1u); break; } }
    }
    nloc = mine > 0u ? mine : 1u; nx = cnt > 0u ? cnt : 1u;
}

__device__ __forceinline__ void xcd_barrier(const XcdBarrier& b, bool t0) {
    asm volatile("s_waitcnt vmcnt(0)" ::: "memory");
    __syncthreads();
    if (t0) {
        unsigned* bar = b.bar;
        __builtin_amdgcn_s_waitcnt(0);
        unsigned nloc = b.st[0], nx = b.st[1];
        if (nloc == 0u) { xcd_barrier_complete(bar, b.x, nloc, nx); b.st[0] = nloc; b.st[1] = nx; }
        const unsigned old = xb_add(&bar[XB_XSUB(b.x)], 1u);
        const unsigned gen = old / nloc;
        if (old + 1u == (gen + 1u) * nloc) {
            __builtin_amdgcn_fence(__ATOMIC_RELEASE, "agent");
            asm volatile("s_waitcnt vmcnt(0)" ::: "memory");
            const unsigned og = xb_add(&bar[XB_TOP], 1u);
            const unsigned tg = og / nx;
            if (og + 1u == (tg + 1u) * nx) xb_add(&bar[XB_TOPGEN], 1u);
            else XB_SPIN(xb_ld(&bar[XB_TOPGEN]) == tg, bar);
            __builtin_amdgcn_fence(__ATOMIC_ACQUIRE, "agent");
            xb_add(&bar[XB_XGEN(b.x)], 1u);
            asm volatile("s_waitcnt vmcnt(0)" ::: "memory");
        } else {
            XB_SPIN(xb_ld(&bar[XB_XGEN(b.x)]) == gen, bar);
            __builtin_amdgcn_fence(__ATOMIC_ACQUIRE, "agent");
            asm volatile("s_waitcnt vmcnt(0)" ::: "memory");
        }
    }
    __syncthreads();
}


struct Frame {
    LAS unsigned char* lds;
    int tid, lane, wave, G, gw, NGW, bx;
    unsigned char* ws;
};
#define IN_X 0
#define IN_MEM 1
#define IN_MIX_NORM 2
#define IN_W_MIX_IN 3
#define IN_GDN_CONV 4
#define IN_A_LOG 5
#define IN_DT_BIAS 6
#define IN_OUT_NORM 7
#define IN_SC_CONV 8
#define IN_W_MIX_OUT 9
#define IN_XATTN_NORM 10
#define IN_MEM_NORM 11
#define IN_W_XQ 12
#define IN_W_XK 13
#define IN_W_XV 14
#define IN_W_XO 15
#define IN_FFN_NORM 16
#define IN_W_UP 17
#define IN_FFN_CONV 18
#define IN_W_DOWN 19
#define IN_FINAL_NORM 20

template <bool SCALE>
__device__ __forceinline__ void xpose_item(const float* src  , size_t ld, bf16* dst  , size_t K, int lane, LAS unsigned char* T, const float* gk = nullptr  ) {
    const int n4 = lane & 15, ksub = lane >> 4;
    const float* s = src + (size_t)(16 * ksub) * ld + 4 * n4;
    f32x4 v[16];
#pragma unroll
    for (int i = 0; i < 16; ++i) v[i] = *(const f32x4*)(s + (size_t)i * ld);
    if constexpr (SCALE) { f32x4 g[4];
#pragma unroll
        for (int i = 0; i < 4; ++i) g[i] = *(const f32x4*)(gk + 16 * ksub + 4 * i);
#pragma unroll
        for (int i = 0; i < 16; ++i) v[i] = v[i] * g[i >> 2][i & 3]; }
#pragma unroll
    for (int j = 0; j < 4; ++j) { v4u a, b; a.x = pk2(v[0][j], v[1][j]); a.y = pk2(v[2][j], v[3][j]); a.z = pk2(v[4][j], v[5][j]); a.w = pk2(v[6][j], v[7][j]);
        b.x = pk2(v[8][j], v[9][j]); b.y = pk2(v[10][j], v[11][j]); b.z = pk2(v[12][j], v[13][j]); b.w = pk2(v[14][j], v[15][j]);
        LAS v4u* t = (LAS v4u*)(T + (4 * n4 + j) * 144 + 32 * ksub); t[0] = a; t[1] = b; }
    LDS_WAIT(); asm volatile("" ::: "memory");
#pragma unroll
    for (int i = 0; i < 8; ++i) { const int n = 8 * i + (lane >> 3), c = lane & 7; *(v4u*)(dst + (size_t)n * K + 8 * c) = *(const LAS v4u*)(T + n * 144 + 16 * c); }
    LDS_WAIT(); asm volatile("" ::: "memory");
}
__device__ __forceinline__ void convert_item(const float* src, bf16* dst, int lane, float g0, float g1) {
#pragma unroll
    for (int k = 0; k < 8; ++k) { const float g = k < 4 ? g0 : g1; const f32x4 a = *(const f32x4*)(src + k * 512 + 8 * lane) * g, b = *(const f32x4*)(src + k * 512 + 8 * lane + 4) * g;
        v4u o; o.x = pk2(a[0], a[1]); o.y = pk2(a[2], a[3]); o.z = pk2(b[0], b[1]); o.w = pk2(b[2], b[3]); *(v4u*)(dst + k * 512 + 8 * lane) = o; }
}
__device__ __forceinline__ void p0_weights_x(Frame& F, int mode, int l_lo, int l_hi, int gw, int ngw, const float* w_xq, const float* w_xk, const float* w_xv, const float* w_xo, const float* g_xattn  ) {
    constexpr int I_SQ = 32 * 32;
    LAS unsigned char* T = F.lds + RING_OFF + F.wave * 9216;
    for (int it = gw; it < (l_hi - l_lo) * 2 * I_SQ; it += ngw) {
        const int l = l_lo + it / (2 * I_SQ); int r = it % (2 * I_SQ);
        if (mode == 0 || r < I_SQ) { const int f = mode == 0 ? r / I_SQ : 2, rr = r % I_SQ, nb = rr >> 5, kb = rr & 31;
            const float* src = f == 0 ? w_xk : f == 1 ? w_xv : w_xo;
            const size_t dofs = f == 0 ? WS_WXK : f == 1 ? WS_WXV : WS_WXO;
            xpose_item<false>(src + (size_t)l * D * D + (size_t)(kb * 64) * D + nb * 64, D, (bf16*)(F.ws + dofs) + (size_t)l * D * D + (size_t)(nb * 64) * D + kb * 64, D, F.lane, T); continue; }
        r -= I_SQ;
        convert_item(w_xq + (size_t)l * D * D + (size_t)r * 4096, (bf16*)(F.ws + WS_WXQ) + (size_t)l * D * D + (size_t)r * 4096, F.lane, g_xattn[l * D + 2 * r], g_xattn[l * D + 2 * r + 1]);
    }
}
__device__ __forceinline__ void p0_weights_main(Frame& F, int l, int gw, int ngw, const float* w_mix_in, const float* w_mix_out, const float* w_up, const float* w_down, const float* g_mix  , const float* g_ffn) {
    constexpr int I_MIX = 112 * 32, I_SQ = 32 * 32, I_UP = 176 * 32, I_DN = 32 * 88, I_LAYER = I_MIX + I_SQ + I_UP + I_DN;
    LAS unsigned char* T = F.lds + RING_OFF + F.wave * 9216;
    for (int it = gw; it < I_LAYER; it += ngw) {
        int r = it;
        if (r < I_MIX) { const int nb = r >> 5, kb = r & 31, n0 = nb * 64, sc = n0 < 4096 ? n0 : n0 + 16;
            xpose_item<true>(w_mix_in + (size_t)l * D * NMIX_SRC + (size_t)(kb * 64) * NMIX_SRC + sc, NMIX_SRC, (bf16*)(F.ws + WS_WMIX) + (size_t)l * NMIX * D + (size_t)n0 * D + kb * 64, D, F.lane, T, g_mix + kb * 64); continue; }
        r -= I_MIX;
        if (r < I_SQ) { const int nb = r >> 5, kb = r & 31;
            xpose_item<false>(w_mix_out + (size_t)l * D * D + (size_t)(kb * 64) * D + nb * 64, D, (bf16*)(F.ws + WS_WOUT) + (size_t)l * D * D + (size_t)(nb * 64) * D + kb * 64, D, F.lane, T); continue; }
        r -= I_SQ;
        if (r < I_UP) { const int nb = r >> 5, kb = r & 31, n0 = nb * 64, c0 = n0 < DFF ? n0 : n0 - DFF, drow = (c0 >> 7) * 256 + (n0 < DFF ? 0 : 128) + (c0 & 127);
            xpose_item<true>(w_up + (size_t)l * D * 2 * DFF + (size_t)(kb * 64) * 2 * DFF + n0, 2 * DFF, (bf16*)(F.ws + WS_WUP) + (size_t)l * 2 * DFF * D + (size_t)drow * D + kb * 64, D, F.lane, T, g_ffn + kb * 64); continue; }
        r -= I_UP;
        { const int nb = r / 88, kb = r % 88;
            xpose_item<false>(w_down + (size_t)l * DFF * D + (size_t)(kb * 64) * D + nb * 64, D, (bf16*)(F.ws + WS_WDN) + (size_t)l * D * DFF + (size_t)(nb * 64) * DFF + kb * 64, DFF, F.lane, T); }
    }
    for (int i = gw * 64 + F.lane; i < 16 * D; i += ngw * 64) { const int n = i / D, k = i % D;
        ((bf16*)(F.ws + WS_WBA))[(size_t)l * 16 * D + i] = (bf16)(pk2(w_mix_in[(size_t)l * D * NMIX_SRC + (size_t)k * NMIX_SRC + 4096 + n] * g_mix[k], 0.f) & 0xffffu); }
}
__device__ __forceinline__ void p0_memn(Frame& F, const float* mem, const float* mem_norm) {
    for (int m = F.gw; m < BATCH * NMEM; m += F.NGW) {
        const f32x4* xr = (const f32x4*)(mem + (size_t)m * D) + F.lane;
        f32x4 v[8]; float s = 0.f;
#pragma unroll
        for (int j = 0; j < 8; ++j) { v[j] = xr[64 * j]; s += (v[j][0] * v[j][0] + v[j][1] * v[j][1]) + (v[j][2] * v[j][2] + v[j][3] * v[j][3]); }
        const float rstd = pg8::rsq_f(wave_sum(s) * (1.0f / D) + EPS);
#pragma unroll
        for (int l0 = 0; l0 < DEPTH; l0 += 2) {
            f32x4 g4[2][8];
#pragma unroll
            for (int l = 0; l < 2; ++l)
#pragma unroll
                for (int j = 0; j < 8; ++j) g4[l][j] = ((const f32x4*)(mem_norm + (size_t)(l0 + l) * D))[64 * j + F.lane];
#pragma unroll
            for (int l = 0; l < 2; ++l) {
                v2u* o8 = (v2u*)((bf16*)(F.ws + WS_MEMN) + ((size_t)(l0 + l) * 512 + m) * D) + F.lane;
#pragma unroll
                for (int j = 0; j < 8; ++j) { const f32x4 h = v[j] * rstd * g4[l][j]; v2u o; o.x = pk2(h[0], h[1]); o.y = pk2(h[2], h[3]); o8[64 * j] = o; }
            }
        }
    }
}

__device__ __forceinline__ void prenorm_phase(Frame& F, const float* x, bf16* Xh, unsigned char* Xq, float* ssq, int gw, int ngw, int m_lo, int m_hi) {
    for (int m = m_lo + gw; m < m_hi; m += ngw) {
        const float* xr = x + (size_t)m * D + 8 * F.lane;
        f32x4 v[4][2]; float s = 0.f;
#pragma unroll
        for (int j = 0; j < 4; ++j)
#pragma unroll
            for (int h = 0; h < 2; ++h) { v[j][h] = *(const f32x4*)(xr + 512 * j + 4 * h); s += (v[j][h][0] * v[j][h][0] + v[j][h][1] * v[j][h][1]) + (v[j][h][2] * v[j][h][2] + v[j][h][3] * v[j][h][3]); }
        s = wave_sum(s);
        if (F.lane == 0) ssq[m] = s;
#pragma unroll
        for (int j = 0; j < 4; ++j) { const pg8::f32x2 xx[4] = {v[j][0].xy, v[j][0].zw, v[j][1].xy, v[j][1].zw};
            pg8::u32x4 ho; pg8::u32x2 qo; pg8::xs_encode8(xx, ho, qo);
            *(pg8::u32x4*)(Xh + (size_t)m * D + 8 * F.lane + 512 * j) = ho; *(pg8::u32x2*)(Xq + (size_t)m * D + 8 * F.lane + 512 * j) = qo; }
    }
}
__device__ __forceinline__ void ba_phase(Frame& F, const bf16* Hn, const float* ssq, const bf16* wba  , const float* alogp, const float* dtbp) {
    const int lane = F.lane, wave = F.wave, mtile = wave & 3, khalf = wave >> 2, fr = lane & 15, fq = lane >> 4;
    LAS f32x4* red = (LAS f32x4*)(F.lds);
    for (int rb = F.bx; rb < M / 64; rb += F.G) {
        const int row0 = rb * 64 + 16 * mtile;
        const bf16* ap = Hn + (size_t)(row0 + fr) * D + khalf * 1024 + 8 * fq;
        const bf16* bp = wba + (size_t)fr * D + khalf * 1024 + 8 * fq;
        f32x4 acc = {0.f, 0.f, 0.f, 0.f};
        v4u fa[8], fb[8], na[8], nb[8];
#pragma unroll
        for (int s = 0; s < 8; ++s) { fa[s] = *(const v4u*)(ap + 32 * s); fb[s] = *(const v4u*)(bp + 32 * s); }
#pragma unroll
        for (int b8 = 0; b8 < 4; ++b8) {
            if (b8 < 3) {
#pragma unroll
                for (int s = 0; s < 8; ++s) { na[s] = *(const v4u*)(ap + 32 * (8 * (b8 + 1) + s)); nb[s] = *(const v4u*)(bp + 32 * (8 * (b8 + 1) + s)); } }
            __builtin_amdgcn_sched_barrier(0);
#pragma unroll
            for (int s = 0; s < 8; ++s) acc = __builtin_amdgcn_mfma_f32_16x16x32_bf16(__builtin_bit_cast(bf16x8, fa[s]), __builtin_bit_cast(bf16x8, fb[s]), acc, 0, 0, 0);
#pragma unroll
            for (int s = 0; s < 8; ++s) { fa[s] = na[s]; fb[s] = nb[s]; }
            __builtin_amdgcn_sched_barrier(0);
        }
        if (khalf == 1) red[mtile * 64 + lane] = acc;
        LDS_WAIT(); __syncthreads();
        if (khalf == 0) {
            const f32x4 o = red[mtile * 64 + lane]; acc = acc + o;
            const float al = fr >= 8 ? alogp[fr - 8] : 0.f, db = fr >= 8 ? dtbp[fr - 8] : 0.f;
#pragma unroll
            for (int i = 0; i < 4; ++i) { const int row = row0 + 4 * fq + i; const float v = acc[i] * (pg8::rsq_f(ssq[row] * (1.0f / D) + EPS));
                if (fr < 8) ((float*)(F.ws + WS_BETA))[(size_t)row * GH + fr] = sigmoid_f(v);
                else { const float z = v + db; const float sp = fmaxf(z, 0.f) + __logf(1.0f + __expf(-fabsf(z))); ((float*)(F.ws + WS_G))[(size_t)row * GH + fr - 8] = -__expf(al) * sp; } }
        }
        LDS_WAIT(); __syncthreads();
    }
}
__device__ __forceinline__ void final_norm_phase(Frame& F, const bf16* xh, const unsigned char* xq, const float* gain, float* out) {
    f32x4 g4[4][2];
#pragma unroll
    for (int j = 0; j < 4; ++j)
#pragma unroll
        for (int h = 0; h < 2; ++h) g4[j][h] = *(const f32x4*)(gain + 8 * F.lane + 512 * j + 4 * h);
    for (int m0 = F.gw; m0 < M; m0 += 4 * F.NGW) {
        pg8::u32x4 hb[4][4]; pg8::u32x2 qb[4][4]; float s[4];
#pragma unroll
        for (int q = 0; q < 4; ++q) { const int m = m0 + q * F.NGW < M ? m0 + q * F.NGW : m0; const size_t o = (size_t)m * D + 8 * F.lane;
#pragma unroll
            for (int j = 0; j < 4; ++j) { hb[q][j] = *(const pg8::u32x4*)(xh + o + 512 * j); qb[q][j] = *(const pg8::u32x2*)(xq + o + 512 * j); } }
#pragma unroll
        for (int q = 0; q < 4; ++q) { float a = 0.f;
#pragma unroll
            for (int j = 0; j < 4; ++j) { pg8::f32x2 x[4]; pg8::xs_decode8(hb[q][j], qb[q][j], x); a += pg8::xs_sumsq8(x); }
            s[q] = pg8::rsq_f(wave_sum(a) * (1.0f / D) + EPS); }
#pragma unroll
        for (int q = 0; q < 4; ++q) { const int m = m0 + q * F.NGW; if (m < M) { float* o = out + (size_t)m * D + 8 * F.lane;
#pragma unroll
            for (int j = 0; j < 4; ++j) { pg8::f32x2 x[4]; pg8::xs_decode8(hb[q][j], qb[q][j], x);
                f32x4 a = {x[0][0], x[0][1], x[1][0], x[1][1]}, b = {x[2][0], x[2][1], x[3][0], x[3][1]};
                *(f32x4*)(o + 512 * j) = a * s[q] * g4[j][0]; *(f32x4*)(o + 512 * j + 4) = b * s[q] * g4[j][1]; } } }
    }
}

__device__ __forceinline__ void unpack8(const v4u w, float (&f)[8]) {
    f[0] = bf_lo(w.x); f[1] = bf_hi(w.x); f[2] = bf_lo(w.y); f[3] = bf_hi(w.y); f[4] = bf_lo(w.z); f[5] = bf_hi(w.z); f[6] = bf_lo(w.w); f[7] = bf_hi(w.w);
}

__device__ __forceinline__ void shortconv_phase(Frame& F, const float* cw, int gw, int ngw) {
    const bf16* PROJ = (const bf16*)(F.ws + WS_PROJ);
    bf16* Y = (bf16*)(F.ws + WS_Y);
    for (int rb = gw; rb < M / 8; rb += ngw) {
        const int m0 = rb * 8, t0 = m0 % SEQ;
        for (int i = 0; i < 2; ++i) {
            const int ch0 = 8 * (F.lane + 64 * i);
            float w[3][8];
#pragma unroll
            for (int j = 0; j < 3; ++j) { const f32x4 a = *(const f32x4*)(cw + (size_t)j * SCW + ch0), b = *(const f32x4*)(cw + (size_t)j * SCW + ch0 + 4);
                w[j][0] = a[0]; w[j][1] = a[1]; w[j][2] = a[2]; w[j][3] = a[3]; w[j][4] = b[0]; w[j][5] = b[1]; w[j][6] = b[2]; w[j][7] = b[3]; }
            float x0[8], x1[8], x2[8], cg[8], hh[8], bg[8];
            const bf16* p = PROJ + (size_t)m0 * NMIX + ch0;
            const bool hist = t0 >= 2;
            v4u rc[10], rh[10], rbq[8];
#pragma unroll
            for (int q = 0; q < 2; ++q) { const bf16* pq = hist ? p - (size_t)(2 - q) * NMIX : p; rc[q] = *(const v4u*)(pq + PC_C); rh[q] = *(const v4u*)(pq + PC_H); }
#pragma unroll
            for (int q = 0; q < 8; ++q) { rc[2 + q] = *(const v4u*)(p + (size_t)q * NMIX + PC_C); rh[2 + q] = *(const v4u*)(p + (size_t)q * NMIX + PC_H); rbq[q] = *(const v4u*)(p + (size_t)q * NMIX + PC_B); }
            unpack8(rc[0], cg); unpack8(rh[0], hh);
#pragma unroll
            for (int e = 0; e < 8; ++e) x0[e] = hist ? cg[e] * hh[e] : 0.f;
            unpack8(rc[1], cg); unpack8(rh[1], hh);
#pragma unroll
            for (int e = 0; e < 8; ++e) x1[e] = hist ? cg[e] * hh[e] : 0.f;
#pragma unroll
            for (int r = 0; r < 8; ++r) {
                unpack8(rc[2 + r], cg); unpack8(rh[2 + r], hh); unpack8(rbq[r], bg);
                float y[8];
#pragma unroll
                for (int e = 0; e < 8; ++e) { x2[e] = cg[e] * hh[e]; y[e] = bg[e] * (w[0][e] * x0[e] + w[1][e] * x1[e] + w[2][e] * x2[e]); x0[e] = x1[e]; x1[e] = x2[e]; }
                v4u o; o.x = pk2(y[0], y[1]); o.y = pk2(y[2], y[3]); o.z = pk2(y[4], y[5]); o.w = pk2(y[6], y[7]);
                *(v4u*)(Y + (size_t)(m0 + r) * D + GW + ch0) = o;
            }
        }
    }
}
__device__ __forceinline__ void swiglu_fix_phase(Frame& F, const float* cw, int pm) {
    bf16* ACT = (bf16*)(F.ws + WS_ACT); const float* PART = (const float*)(F.ws + WS_PART); const float* HALO = (const float*)(F.ws + WS_HALO);
    for (int idx = F.tid; idx < DFF / 4; idx += NTHREADS) {
        const int ch = 4 * idx;
        f32x4 wg[3], wu[3];
#pragma unroll
        for (int t = 0; t < 3; ++t) { wg[t] = *(const f32x4*)(cw + (size_t)t * 2 * DFF + ch); wu[t] = *(const f32x4*)(cw + (size_t)t * 2 * DFF + DFF + ch); }
        f32x4 g0 = *(const f32x4*)(PART + ((size_t)(pm * 2 + 0) * 2 + 0) * DFF + ch), u0 = *(const f32x4*)(PART + ((size_t)(pm * 2 + 0) * 2 + 1) * DFF + ch);
        f32x4 g1 = *(const f32x4*)(PART + ((size_t)(pm * 2 + 1) * 2 + 0) * DFF + ch), u1 = *(const f32x4*)(PART + ((size_t)(pm * 2 + 1) * 2 + 1) * DFF + ch);
        const bool hist = pm % (SEQ / 256) != 0; const int ph = hist ? pm - 1 : pm;
        f32x4 hg0 = *(const f32x4*)(HALO + ((size_t)(ph * 2 + 0) * 2 + 0) * DFF + ch), hu0 = *(const f32x4*)(HALO + ((size_t)(ph * 2 + 0) * 2 + 1) * DFF + ch);
        f32x4 hg1 = *(const f32x4*)(HALO + ((size_t)(ph * 2 + 1) * 2 + 0) * DFF + ch), hu1 = *(const f32x4*)(HALO + ((size_t)(ph * 2 + 1) * 2 + 1) * DFF + ch);
        const float hm = hist ? 1.f : 0.f; hg0 = hg0 * hm; hu0 = hu0 * hm; hg1 = hg1 * hm; hu1 = hu1 * hm;
        g0 = g0 + wg[1] * hg1 + wg[0] * hg0; u0 = u0 + wu[1] * hu1 + wu[0] * hu0; g1 = g1 + wg[0] * hg1; u1 = u1 + wu[0] * hu1;
        v2u w0, w1; w0.x = pk2(silu_f(g0[0]) * u0[0], silu_f(g0[1]) * u0[1]); w0.y = pk2(silu_f(g0[2]) * u0[2], silu_f(g0[3]) * u0[3]);
        w1.x = pk2(silu_f(g1[0]) * u1[0], silu_f(g1[1]) * u1[1]); w1.y = pk2(silu_f(g1[2]) * u1[2], silu_f(g1[3]) * u1[3]);
        *(v2u*)(ACT + (size_t)(pm * 256) * DFF + ch) = w0; *(v2u*)(ACT + (size_t)(pm * 256 + 1) * DFF + ch) = w1;
    }
}

struct KvOrder {
    int G, c; const bf16 *memn, *wxk, *wxv;
    __device__ __forceinline__ bool next(int i, pg8::Unit& u) const { const long L = (long)i * G + c; if (L >= 128) return false; u.pm = (int)L; u.pn = 0; return true; }
    __device__ __forceinline__ const char* pa(const pg8::Gemm&, const pg8::Unit& u) const { const int l = u.pm >> 5, r = u.pm & 15; return (const char*)(memn + ((size_t)l * 512 + (r >> 3) * 256) * D); }
    __device__ __forceinline__ const char* pb(const pg8::Gemm&, const pg8::Unit& u) const { const int l = u.pm >> 5, r = u.pm & 15;
        const bf16* wk = wxk + ((size_t)l * D + (r & 7) * 256) * D; const bf16* wv = wxv + ((size_t)l * D + (r & 7) * 256) * D; return (const char*)((u.pm & 16) ? wv : wk); }
};
struct LocKv { bf16 *kx, *vx;
    __device__ __forceinline__ void operator()(const pg8::Unit& u, bf16*& base, int& ld) const { const int l = u.pm >> 5, r = u.pm & 15;
        bf16* bk = kx + ((size_t)l * 512 + (r >> 3) * 256) * D + (r & 7) * 256; bf16* bv = vx + ((size_t)l * 512 + (r >> 3) * 256) * D + (r & 7) * 256; base = (u.pm & 16) ? bv : bk; ld = D; } };
struct PreOrder {
    int l, c; const bf16 *kx, *vx, *wxq, *wxo;
    __device__ __forceinline__ bool next(int i, pg8::Unit& u) const { if (i != 0 || c >= 128) return false; u.pm = (c < 64 ? c : 192 + c) + l * 64; u.pn = 0; return true; }
    __device__ __forceinline__ const char* pa(const pg8::Gemm&, const pg8::Unit& u) const { const int jj = u.pm & 255, l = jj >> 6, b = (jj >> 5) & 1, h = (jj >> 3) & 3, t = jj & 7;
        return (const char*)(u.pm < 256 ? kx + ((size_t)l * 512 + b * 256) * D + h * XD : wxo + ((size_t)l * D + t * 256) * D + h * XD); }
    __device__ __forceinline__ const char* pb(const pg8::Gemm&, const pg8::Unit& u) const { const int jj = u.pm & 255, l = jj >> 6, b = (jj >> 5) & 1, h = (jj >> 3) & 3, t = jj & 7;
        return (const char*)(u.pm < 256 ? wxq + ((size_t)l * D + t * 256) * D + h * XD : vx + ((size_t)l * 512 + b * 256) * D + h * XD); }
};
struct LocPre { bf16 *wqk, *vwo;
    __device__ __forceinline__ void operator()(const pg8::Unit& u, bf16*& base, int& ld) const { const int jj = u.pm & 255, l = jj >> 6, b = (jj >> 5) & 1, h = (jj >> 3) & 3, t = jj & 7;
        if (u.pm < 256) { base = wqk + ((size_t)(l * 2 + b) * (XH * NMEM) + h * NMEM) * D + t * 256; ld = D; }
        else { base = vwo + ((size_t)(l * 2 + b) * D + t * 256) * (XH * NMEM) + h * NMEM; ld = XH * NMEM; } } };
struct SOrder {
    int G, c;
    __device__ __forceinline__ bool next(int i, pg8::Unit& u) const { const long L = (long)i * G + c; if (L >= 256) return false; const int w = ((int)L & 7) * 32 + ((int)L >> 3); u.pm = w >> 2; u.pn = w & 3; return true; }
    __device__ __forceinline__ const char* pa(const pg8::Gemm& g, const pg8::Unit& u) const { return (const char*)(g.A + (size_t)u.pm * 256 * D); }
    __device__ __forceinline__ const char* pb(const pg8::Gemm& g, const pg8::Unit& u) const { return (const char*)(g.Bt + (size_t)(u.pm >> 5) * (XH * NMEM) * D + (size_t)u.pn * NMEM * D); }
};
struct BatchOrder : pg8::StaticOrder {
    size_t bstride;
    __device__ __forceinline__ const char* pb(const pg8::Gemm& g, const pg8::Unit& u) const { return (const char*)(g.Bt + (size_t)(u.pm >> 5) * bstride + (size_t)u.pn * pg8::BM * g.ldb); }
};

typedef float f32x16 __attribute__((ext_vector_type(16)));
typedef float f32x2n __attribute__((ext_vector_type(2)));
typedef __bf16 bf16x2n __attribute__((ext_vector_type(2)));
__device__ __forceinline__ unsigned pkn(float a, float b) { f32x2n v = {a, b}; bf16x2n r = __builtin_convertvector(v, bf16x2n); return __builtin_bit_cast(unsigned, r); }
__device__ __forceinline__ int kmap(int p) { const int pp = p & 15, hh = pp >> 3, jj = pp & 7; return (p & ~15) + 8 * (jj >> 2) + 4 * hh + (jj & 3); }
__device__ __forceinline__ int kpos(int d) { const int dd = d & 15; return (d & ~15) + 8 * ((dd >> 2) & 1) + 4 * (dd >> 3) + (dd & 3); }
__device__ __forceinline__ bf16x8 pack_step(const f32x16& x, int s) {
    v4u w; w.x = pkn(x[8 * s], x[8 * s + 1]); w.y = pkn(x[8 * s + 2], x[8 * s + 3]); w.z = pkn(x[8 * s + 4], x[8 * s + 5]); w.w = pkn(x[8 * s + 6], x[8 * s + 7]);
    return __builtin_bit_cast(bf16x8, w);
}
constexpr int REC_BYTES = 36864, WIMG_STRIDE = 272, KDIMG_OFF = 17408, KDIMG_STRIDE = 144, IMG_USED = 35840;
constexpr size_t WS_REC = WS_GS;
constexpr size_t WS_UT = WS_GS + 80 * MiB;
constexpr size_t WS_ATTN = WS_GS + 144 * MiB;
constexpr size_t WS_EGL = WS_GS + 160 * MiB;
constexpr size_t WS_SST = WS_H;
constexpr size_t WS_QD = WS_OG;
constexpr size_t WS_VST = WS_OG + 32 * MiB;

__device__ __forceinline__ void gdn_prep_phase(Frame& F, const float* cw  ) {
    const bf16* PROJ = (const bf16*)(F.ws + WS_PROJ);
    const float* BETA = (const float*)(F.ws + WS_BETA); const float* GG = (const float*)(F.ws + WS_G);
    unsigned o_vs = 32768, o_kb = 65536, o_qb = 82944, o_as = 101376, o_att = 117760, o_gc = 125952;
    asm volatile("" : "+s"(o_vs), "+s"(o_kb), "+s"(o_qb), "+s"(o_as), "+s"(o_att), "+s"(o_gc));
    LAS float* KS = (LAS float*)(F.lds);
    LAS float* VS = (LAS float*)(F.lds + o_vs);
    LAS unsigned char* KB16 = F.lds + o_kb;
    LAS unsigned char* QB16 = F.lds + o_qb;
    LAS unsigned char* IMG = KB16;
    LAS float* AS = (LAS float*)(F.lds + o_as);
    LAS unsigned short* ATT = (LAS unsigned short*)(F.lds + o_att);
    LAS float* GC = (LAS float*)(F.lds + o_gc);
    const int tid = F.tid, lane = F.lane, wave = F.wave;
#ifndef G1_REP
#define G1_REP 1
#endif
    for (int it = 0; it * F.G < 2048 * G1_REP; ++it) {
        const int u = F.bx + F.G * (it / G1_REP);
        const int ch = u, n = ch & 127, bh = ch >> 7, b = bh >> 3, h = bh & 7;
        const int m0 = b * SEQ + n * 64;
        if (tid < 384) {
            const int rb = tid / 48, cgi = tid % 48, tensor = cgi >> 4, cg = cgi & 15;
            const int ch0 = tensor * GW + h * GD + 8 * cg, c0 = rb * 8;
            float w[4][8];
#pragma unroll
            for (int j = 0; j < 4; ++j) { const f32x4 a = *(const f32x4*)(cw + (size_t)j * 3 * GW + ch0), bq = *(const f32x4*)(cw + (size_t)j * 3 * GW + ch0 + 4);
                w[j][0] = a[0]; w[j][1] = a[1]; w[j][2] = a[2]; w[j][3] = a[3]; w[j][4] = bq[0]; w[j][5] = bq[1]; w[j][6] = bq[2]; w[j][7] = bq[3]; }
            float x0[8], x1[8], x2[8], x3[8];
            const bf16* p = PROJ + (size_t)(m0 + c0) * NMIX + ch0;
            const bool hist = n * 64 + c0 >= 3;
            v4u raw[11];
#pragma unroll
            for (int q = 0; q < 3; ++q) raw[q] = *(const v4u*)(hist ? p - (size_t)(3 - q) * NMIX : p);
#pragma unroll
            for (int q = 0; q < 8; ++q) raw[3 + q] = *(const v4u*)(p + (size_t)q * NMIX);
            if (!hist) { raw[0] = (v4u){0u, 0u, 0u, 0u}; raw[1] = raw[0]; raw[2] = raw[0]; }
            unpack8(raw[0], x0); unpack8(raw[1], x1); unpack8(raw[2], x2);
#pragma unroll
            for (int r = 0; r < 8; ++r) {
                unpack8(raw[3 + r], x3);
                float y[8]; float ss = 0.f;
#pragma unroll
                for (int e = 0; e < 8; ++e) { const float c = w[0][e] * x0[e] + w[1][e] * x1[e] + w[2][e] * x2[e] + w[3][e] * x3[e]; y[e] = silu_f(c); ss += y[e] * y[e]; x0[e] = x1[e]; x1[e] = x2[e]; x2[e] = x3[e]; }
                const int c = c0 + r;
                if (tensor < 2) {
                    ss += __shfl_xor(ss, 1); ss += __shfl_xor(ss, 2); ss += __shfl_xor(ss, 4); ss += __shfl_xor(ss, 8);
                    float sc = pg8::rsq_f(ss + EPS); if (tensor == 0) sc *= 0.08838834764831845f;
#pragma unroll
                    for (int e = 0; e < 8; ++e) y[e] *= sc;
                    v4u o; o.x = pkn(y[0], y[1]); o.y = pkn(y[2], y[3]); o.z = pkn(y[4], y[5]); o.w = pkn(y[6], y[7]);
                    *(LAS v4u*)((tensor == 0 ? QB16 : KB16) + c * WIMG_STRIDE + 16 * cg) = o;
                    if (tensor == 1) { *(LAS f32x4*)(KS + c * 128 + 8 * cg) = (f32x4){y[0], y[1], y[2], y[3]}; *(LAS f32x4*)(KS + c * 128 + 8 * cg + 4) = (f32x4){y[4], y[5], y[6], y[7]}; }
                } else { *(LAS f32x4*)(VS + c * 128 + 8 * cg) = (f32x4){y[0], y[1], y[2], y[3]}; *(LAS f32x4*)(VS + c * 128 + 8 * cg + 4) = (f32x4){y[4], y[5], y[6], y[7]}; }
                __builtin_amdgcn_sched_barrier(0);
            }
        } else if (wave == 7) {
            const float g = GG[(size_t)(m0 + lane) * GH + h], be = BETA[(size_t)(m0 + lane) * GH + h];
            float x = g;
#pragma unroll
            for (int o = 1; o < 64; o <<= 1) { const float t = __builtin_bit_cast(float, __builtin_amdgcn_ds_bpermute((lane - o) << 2, __builtin_bit_cast(int, x))); if (lane >= o) x += t; }
            const float gl = __builtin_bit_cast(float, __builtin_amdgcn_readlane(__builtin_bit_cast(int, x), 63));
            GC[lane] = x; GC[64 + lane] = be; GC[128 + lane] = expf(x); GC[192 + lane] = expf(gl - x);
            if (lane == 0) ((float*)(F.ws + WS_EGL))[ch] = expf(gl);
        }
        LDS_WAIT(); __syncthreads();
        {
            const int mat = wave >> 2, mt = (wave >> 1) & 1, nt = wave & 1, r = lane & 31, hh = lane >> 5;
            const LAS unsigned char* Asrc = (mat ? QB16 : KB16) + (32 * mt + r) * WIMG_STRIDE + 16 * hh;
            const LAS unsigned char* Bsrc = KB16 + (32 * nt + r) * WIMG_STRIDE + 16 * hh;
            f32x16 acc;
#pragma unroll
            for (int i = 0; i < 16; ++i) acc[i] = 0.f;
#pragma unroll
            for (int ks = 0; ks < 8; ++ks) { const bf16x8 a = *(const LAS bf16x8*)(Asrc + 32 * ks), bb = *(const LAS bf16x8*)(Bsrc + 32 * ks); acc = __builtin_amdgcn_mfma_f32_32x32x16_bf16(a, bb, acc, 0, 0, 0); }
            const int m = 32 * nt + r; const float gcm = GC[m];
#pragma unroll
            for (int i = 0; i < 16; ++i) {
                const int c = 32 * mt + (i & 3) + 8 * (i >> 2) + 4 * hh;
                if (mat == 0) AS[c * 64 + m] = (m < c) ? GC[64 + c] * acc[i] * __expf(fminf(GC[c] - gcm, 0.f)) : 0.f;
                else { const float v = (m <= c) ? acc[i] * __expf(fminf(GC[c] - gcm, 0.f)) : 0.f; ATT[c * 64 + kpos(m)] = (unsigned short)(pkn(v, 0.f) & 0xffffu); }
            }
            const int c = tid >> 3, p0 = (tid & 7) * 16; const float eg = GC[128 + c];
            const LAS unsigned short* qrow = (const LAS unsigned short*)(QB16 + c * WIMG_STRIDE);
            float qv[16];
#pragma unroll
            for (int pp = 0; pp < 16; ++pp) qv[pp] = __uint_as_float((unsigned)qrow[p0 + 8 * ((pp & 7) >> 2) + 4 * (pp >> 3) + (pp & 3)] << 16) * eg;
            v4u o0, o1; o0.x = pkn(qv[0], qv[1]); o0.y = pkn(qv[2], qv[3]); o0.z = pkn(qv[4], qv[5]); o0.w = pkn(qv[6], qv[7]); o1.x = pkn(qv[8], qv[9]); o1.y = pkn(qv[10], qv[11]); o1.z = pkn(qv[12], qv[13]); o1.w = pkn(qv[14], qv[15]);
            v4u* qd = (v4u*)((bf16*)(F.ws + WS_QD) + (size_t)ch * 64 * 128 + c * 128 + p0); qd[0] = o0; qd[1] = o1;
        }
        LDS_WAIT(); __syncthreads();
        typedef short s16x4 __attribute__((ext_vector_type(4)));
        LAS float* DINV = GC + 256;
        if (wave == 0) {
            const int bi = lane >> 4, jc = lane & 15; const LAS float* Ab = AS + (16 * bi) * 64 + 16 * bi;
            float y[16];
#pragma unroll
            for (int rr = 0; rr < 16; ++rr) { float v = (rr == jc) ? 1.f : 0.f;
#pragma unroll
                for (int s4 = 0; s4 < (rr + 3) / 4; ++s4) { const f32x4 a = *(const LAS f32x4*)(Ab + rr * 64 + 4 * s4);
#pragma unroll
                    for (int ii = 0; ii < 4; ++ii) if (4 * s4 + ii < rr) v -= a[ii] * y[4 * s4 + ii]; }
                y[rr] = v; DINV[(bi * 16 + rr) * 16 + jc] = v; }
        } else if (wave >= 4) {
            int t = tid - 256; asm volatile("" : "+v"(t));
            const int d = t & 127, ph = t >> 7;
#pragma unroll
            for (int q8 = 0; q8 < 4; ++q8) { const int p0 = 32 * ph + 8 * q8; float kv[8];
#pragma unroll
                for (int jj = 0; jj < 8; ++jj) { const int c = (p0 & ~15) + 8 * (jj >> 2) + 4 * ((p0 >> 3) & 1) + (jj & 3); kv[jj] = KS[c * 128 + d] * GC[192 + c]; }
                v4u o; o.x = pkn(kv[0], kv[1]); o.y = pkn(kv[2], kv[3]); o.z = pkn(kv[4], kv[5]); o.w = pkn(kv[6], kv[7]);
                *(LAS v4u*)(IMG + KDIMG_OFF + d * KDIMG_STRIDE + 2 * p0) = o; }
            const LAS v4u* as = (const LAS v4u*)ATT + 2 * t; v4u* ag = (v4u*)((bf16*)(F.ws + WS_ATTN) + (size_t)ch * 4096) + 2 * t; ag[0] = as[0]; ag[1] = as[1];
        }
        LDS_WAIT(); __syncthreads();
        {
            const int fr = lane & 15, fq = lane >> 4; const bool isw = wave >= 4;
            const LAS float* src = (isw ? KS : VS) + ((32 * wave) & 127) + fr;
            s16x4 Xb[4][2];
#pragma unroll
            for (int i = 0; i < 4; ++i) {
                f32x4 T[2];
#pragma unroll
                for (int rr = 0; rr < 4; ++rr) { const int c = 16 * i + 4 * fq + rr; float f = GC[64 + c]; if (isw) f *= GC[128 + c]; T[0][rr] = src[c * 128] * f; T[1][rr] = src[c * 128 + 16] * f; }
#pragma unroll
                for (int j = 0; j < i; ++j) { const f32x4 a4 = *(const LAS f32x4*)(AS + (16 * i + fr) * 64 + 16 * j + 4 * fq);
                    v2u aw; aw.x = pkn(-a4[0], -a4[1]); aw.y = pkn(-a4[2], -a4[3]); const s16x4 a = __builtin_bit_cast(s16x4, aw);
                    T[0] = __builtin_amdgcn_mfma_f32_16x16x16bf16_1k(a, Xb[j][0], T[0], 0, 0, 0); T[1] = __builtin_amdgcn_mfma_f32_16x16x16bf16_1k(a, Xb[j][1], T[1], 0, 0, 0); }
                const f32x4 d4 = *(const LAS f32x4*)(DINV + (16 * i + fr) * 16 + 4 * fq);
                v2u dw; dw.x = pkn(d4[0], d4[1]); dw.y = pkn(d4[2], d4[3]); const s16x4 dfr = __builtin_bit_cast(s16x4, dw);
#pragma unroll
                for (int t2 = 0; t2 < 2; ++t2) {
                    v2u tw; tw.x = pkn(T[t2][0], T[t2][1]); tw.y = pkn(T[t2][2], T[t2][3]);
                    const f32x4 X = __builtin_amdgcn_mfma_f32_16x16x16bf16_1k(dfr, __builtin_bit_cast(s16x4, tw), (f32x4){0.f, 0.f, 0.f, 0.f}, 0, 0, 0);
                    v2u xw; xw.x = pkn(X[0], X[1]); xw.y = pkn(X[2], X[3]); Xb[i][t2] = __builtin_bit_cast(s16x4, xw);
                    const int col = 32 * wave + 16 * t2 + fr;
                    if (!isw) *(f32x4*)((float*)(F.ws + WS_UT) + (size_t)ch * 128 * 64 + col * 64 + 16 * i + 4 * fq) = X;
                    else { LAS unsigned short* wi = (LAS unsigned short*)(IMG) + kpos(col - 128) + (16 * i + 4 * fq) * (WIMG_STRIDE / 2);
#pragma unroll
                        for (int rr = 0; rr < 4; ++rr) wi[rr * (WIMG_STRIDE / 2)] = (unsigned short)(pkn(-X[rr], 0.f) & 0xffffu); }
                }
                __builtin_amdgcn_sched_barrier(0);
            }
        }
        LDS_WAIT(); __syncthreads();
        { v4u* rec = (v4u*)(F.ws + WS_REC + (size_t)ch * REC_BYTES);
            for (int i = tid; i < IMG_USED / 16; i += NTHREADS) rec[i] = *(const LAS v4u*)(IMG + 16 * i); }
        LDS_WAIT(); __syncthreads();
    }
}

__device__ __forceinline__ void gdn_scan_phase(Frame& F) {
    const int j = F.bx; if (j >= 64) return;
    const int bh = j & 15, quarter = j >> 4;
    const int lane = F.lane, wave = F.wave, r = lane & 31, hh = lane >> 5;
    const unsigned char* REC = F.ws + WS_REC + (size_t)bh * 128 * REC_BYTES;
#define SCAN_BAR() do { asm volatile("s_waitcnt lgkmcnt(0)" ::: "memory"); __builtin_amdgcn_s_barrier(); asm volatile("" ::: "memory"); } while (0)
#define SCAN_DMA(n_) do { _Pragma("unroll") for (int k_ = 0; k_ < 6; ++k_) { const int piece_ = (wave - 1) + 6 * k_; \
        __builtin_amdgcn_global_load_lds((const unsigned*)(REC + (size_t)(n_) * REC_BYTES + piece_ * 1024 + lane * 16), (PG8_LAS unsigned*)(F.lds + ((n_) % 3) * REC_BYTES + piece_ * 1024), 16, 0, 0); } } while (0)
    if (wave == 7) {
        const unsigned char* uw = (const unsigned char*)((const float*)(F.ws + WS_UT) + (size_t)bh * 128 * (128 * 64) + (size_t)(32 * quarter) * 64) + lane * 16;
        v4u dummy = {0u, 0u, 0u, 0u};
        SCAN_BAR();
        for (int n = 0; n < 128; ++n) {
            const int nw = n + 3 < 128 ? n + 3 : 127;
            asm volatile("s_waitcnt vmcnt(8)" : "+v"(dummy) :: "memory");
#pragma unroll
            for (int k_ = 0; k_ < 8; ++k_) asm volatile("global_load_dwordx4 %0, %1, off" : "+v"(dummy) : "v"(uw + (size_t)nw * (128 * 64 * 4) + k_ * 1024) : "memory");
            SCAN_BAR();
        }
        asm volatile("s_waitcnt vmcnt(0)" : "+v"(dummy) :: "memory");
    }
    else if (wave >= 1) {
        SCAN_DMA(0); SCAN_DMA(1); VM_WAIT(); SCAN_BAR();
        for (int n = 0; n < 128; ++n) {
            if (n + 2 < 128) { SCAN_DMA(n + 2); asm volatile("s_waitcnt vmcnt(6)" ::: "memory"); }
            else VM_WAIT();
            SCAN_BAR();
        }
    } else {
        const int cw = quarter;
        const float* UT = (const float*)(F.ws + WS_UT) + (size_t)bh * 128 * (128 * 64) + (size_t)(32 * cw + r) * 64 + 4 * hh;
        v4u* SST = (v4u*)(F.ws + WS_SST) + (size_t)bh * 128 * (4 * 8 * 64) + (size_t)cw * (8 * 64) + lane;
        v4u* VST = (v4u*)(F.ws + WS_VST) + (size_t)bh * 128 * (4 * 4 * 64) + (size_t)cw * (4 * 64) + lane;
        const float* EGLp = (const float*)(F.ws + WS_EGL) + bh * 128;
        f32x16 S[4];
#pragma unroll
        for (int t = 0; t < 4; ++t)
#pragma unroll
            for (int i = 0; i < 16; ++i) S[t][i] = 0.f;
        unsigned sbw[8][4];
#pragma unroll
        for (int q = 0; q < 8; ++q)
#pragma unroll
            for (int w = 0; w < 4; ++w) sbw[q][w] = 0u;
#define SB_FRAG(q_) __builtin_bit_cast(bf16x8, (v4u){sbw[q_][0], sbw[q_][1], sbw[q_][2], sbw[q_][3]})
#define SB_PACK_QUARTER(t_, qq_) do { const int s_ = (qq_) >> 1, h_ = (qq_) & 1; \
        sbw[2 * (t_) + s_][2 * h_] = pkn(S[t_][8 * s_ + 4 * h_], S[t_][8 * s_ + 4 * h_ + 1]); sbw[2 * (t_) + s_][2 * h_ + 1] = pkn(S[t_][8 * s_ + 4 * h_ + 2], S[t_][8 * s_ + 4 * h_ + 3]); } while (0)
        SCAN_BAR();
        for (int n = 0; n < 128; ++n) {
            const LAS unsigned char* buf = F.lds + (n % 3) * REC_BYTES;
            f32x4 un[4]; f32x16 acc[2];
            { const float* up = UT + (size_t)n * (128 * 64);
#pragma unroll
                for (int q = 0; q < 4; ++q) un[q] = *(const f32x4*)(up + 8 * q);
#pragma unroll
                for (int q = 0; q < 4; ++q) { const f32x4 v = *(const f32x4*)(up + 32 + 8 * q); acc[1][4 * q] = v[0]; acc[1][4 * q + 1] = v[1]; acc[1][4 * q + 2] = v[2]; acc[1][4 * q + 3] = v[3]; } }
            const float egl = EGLp[n];
            const LAS unsigned char* wb = buf + r * WIMG_STRIDE + 16 * hh;
            const LAS unsigned char* kb = buf + KDIMG_OFF + r * KDIMG_STRIDE + 16 * hh;
#define SCAN_FRAG(i_) ((i_) < 16 ? *(const LAS bf16x8*)(wb + ((i_) >> 3) * 32 * WIMG_STRIDE + 32 * ((i_) & 7)) : *(const LAS bf16x8*)(kb + (((i_) - 16) >> 2) * 32 * KDIMG_STRIDE + 32 * (((i_) - 16) & 3)))
            bf16x8 ring[6];
#pragma unroll
            for (int i = 0; i < 6; ++i) ring[i] = SCAN_FRAG(i);
#pragma unroll
            for (int i = 0; i < 16; ++i) acc[0][i] = 0.f;
            __builtin_amdgcn_sched_barrier(0);
            bf16x8 Vb[4];
#pragma unroll
            for (int i = 0; i < 16; ++i) {
                acc[i >> 3] = __builtin_amdgcn_mfma_f32_32x32x16_bf16(ring[i % 6], SB_FRAG(i & 7), acc[i >> 3], 0, 0, 0);
                ring[i % 6] = SCAN_FRAG(i + 6);
                if (i < 4) SB_PACK_QUARTER(3, i);
                if (i >= 4 && i < 8) {
#pragma unroll
                    for (int e = 0; e < 4; ++e) S[0][4 * (i - 4) + e] *= egl; }
                if (i >= 5 && i < 13) SST[(size_t)n * (4 * 8 * 64) + (i - 5) * 64] = (v4u){sbw[i - 5][0], sbw[i - 5][1], sbw[i - 5][2], sbw[i - 5][3]};
                if (i == 10) {
#pragma unroll
                    for (int q = 0; q < 4; ++q) { acc[0][4 * q] += un[q][0]; acc[0][4 * q + 1] += un[q][1]; acc[0][4 * q + 2] += un[q][2]; acc[0][4 * q + 3] += un[q][3]; } }
                if (i == 12) Vb[0] = pack_step(acc[0], 0);
                if (i == 14) Vb[1] = pack_step(acc[0], 1);
                __builtin_amdgcn_sched_barrier(0);
            }
            Vb[2] = pack_step(acc[1], 0); Vb[3] = pack_step(acc[1], 1);
#pragma unroll
            for (int ks = 0; ks < 4; ++ks) VST[(size_t)n * (4 * 4 * 64) + ks * 64] = __builtin_bit_cast(v4u, Vb[ks]);
            __builtin_amdgcn_sched_barrier(0);
#pragma unroll
            for (int i = 16; i < 32; ++i) { const int t = (i - 16) >> 2, ks = (i - 16) & 3;
                S[t] = __builtin_amdgcn_mfma_f32_32x32x16_bf16(ring[i % 6], Vb[ks], S[t], 0, 0, 0);
                if (i + 6 < 32) ring[i % 6] = SCAN_FRAG(i + 6);
                if (t < 3) {
#pragma unroll
                    for (int e = 0; e < 4; ++e) S[t + 1][4 * ks + e] *= egl; }
                if (t >= 1) SB_PACK_QUARTER(t - 1, ks);
                __builtin_amdgcn_sched_barrier(0);
            }
#undef SCAN_FRAG
            SCAN_BAR();
        }
#undef SB_FRAG
#undef SB_PACK_QUARTER
    }
#undef SCAN_DMA
#undef SCAN_BAR
    VM_WAIT(); __syncthreads();
}

__device__ __forceinline__ void gdn_out_phase(Frame& F, const float* out_norm  ) {
    const bf16* PROJ = (const bf16*)(F.ws + WS_PROJ); bf16* Y = (bf16*)(F.ws + WS_Y);
    const int lane = F.lane, r = lane & 31, hh = lane >> 5;
    LAS float* ot = (LAS float*)(F.lds + F.wave * 16384);
    float gain[8];
    { const f32x4 a = *(const f32x4*)(out_norm + 8 * (lane & 15)), b = *(const f32x4*)(out_norm + 8 * (lane & 15) + 4);
        gain[0] = a[0]; gain[1] = a[1]; gain[2] = a[2]; gain[3] = a[3]; gain[4] = b[0]; gain[5] = b[1]; gain[6] = b[2]; gain[7] = b[3]; }
    for (int wu = F.gw; wu < 4096; wu += F.NGW) {
        const int ch = wu >> 1, mt = wu & 1, n = ch & 127, bh = ch >> 7, b = bh >> 3, h = bh & 7, m0 = b * SEQ + n * 64 + 32 * mt;
        const bf16* qd = (const bf16*)(F.ws + WS_QD) + (size_t)ch * 64 * 128 + (32 * mt + r) * 128 + 8 * hh;
        const bf16* at = (const bf16*)(F.ws + WS_ATTN) + (size_t)ch * 4096 + (32 * mt + r) * 64 + 8 * hh;
        const v4u* sst = (const v4u*)(F.ws + WS_SST) + (size_t)ch * (4 * 8 * 64) + lane;
        const v4u* vst = (const v4u*)(F.ws + WS_VST) + (size_t)ch * (4 * 4 * 64) + lane;
        bf16x8 qa[8], aa[4];
#pragma unroll
        for (int ks = 0; ks < 8; ++ks) qa[ks] = __builtin_bit_cast(bf16x8, *(const v4u*)(qd + 16 * ks));
#pragma unroll
        for (int ks = 0; ks < 4; ++ks) aa[ks] = __builtin_bit_cast(bf16x8, *(const v4u*)(at + 16 * ks));
        v4u bcur[12], bnxt[12];
#pragma unroll
        for (int ks = 0; ks < 8; ++ks) bcur[ks] = sst[ks * 64];
#pragma unroll
        for (int ks = 0; ks < 4; ++ks) bcur[8 + ks] = vst[ks * 64];
#pragma unroll
        for (int nt = 0; nt < 4; ++nt) {
            if (nt < 3) {
#pragma unroll
                for (int ks = 0; ks < 8; ++ks) bnxt[ks] = sst[(nt + 1) * (8 * 64) + ks * 64];
#pragma unroll
                for (int ks = 0; ks < 4; ++ks) bnxt[8 + ks] = vst[(nt + 1) * (4 * 64) + ks * 64];
            }
            __builtin_amdgcn_sched_barrier(0);
            f32x16 acc;
#pragma unroll
            for (int i = 0; i < 16; ++i) acc[i] = 0.f;
#pragma unroll
            for (int ks = 0; ks < 8; ++ks) acc = __builtin_amdgcn_mfma_f32_32x32x16_bf16(qa[ks], __builtin_bit_cast(bf16x8, bcur[ks]), acc, 0, 0, 0);
#pragma unroll
            for (int ks = 0; ks < 4; ++ks) acc = __builtin_amdgcn_mfma_f32_32x32x16_bf16(aa[ks], __builtin_bit_cast(bf16x8, bcur[8 + ks]), acc, 0, 0, 0);
#pragma unroll
            for (int i = 0; i < 16; ++i) ot[((i & 3) + 8 * (i >> 2) + 4 * hh) * 128 + 32 * nt + r] = acc[i];
#pragma unroll
            for (int q = 0; q < 12; ++q) bcur[q] = bnxt[q];
            __builtin_amdgcn_sched_barrier(0);
        }
        LDS_WAIT();
#pragma unroll 2
        for (int k = 0; k < 8; ++k) {
            const int row = 4 * k + (lane >> 4), chunk = lane & 15;
            const f32x4 o0 = *(const LAS f32x4*)(ot + row * 128 + 8 * chunk), o1 = *(const LAS f32x4*)(ot + row * 128 + 8 * chunk + 4);
            float zz[8]; unpack8(*(const v4u*)(PROJ + (size_t)(m0 + row) * NMIX + PC_Z + h * GD + 8 * chunk), zz);
            float ss = (o0[0] * o0[0] + o0[1] * o0[1]) + (o0[2] * o0[2] + o0[3] * o0[3]) + (o1[0] * o1[0] + o1[1] * o1[1]) + (o1[2] * o1[2] + o1[3] * o1[3]);
            ss += __shfl_xor(ss, 1); ss += __shfl_xor(ss, 2); ss += __shfl_xor(ss, 4); ss += __shfl_xor(ss, 8);
            const float rstd = pg8::rsq_f(ss * (1.0f / GD) + EPS);
            float y[8];
#pragma unroll
            for (int e = 0; e < 4; ++e) { y[e] = o0[e] * rstd * gain[e] * silu_f(zz[e]); y[4 + e] = o1[e] * rstd * gain[4 + e] * silu_f(zz[4 + e]); }
            v4u w; w.x = pkn(y[0], y[1]); w.y = pkn(y[2], y[3]); w.z = pkn(y[4], y[5]); w.w = pkn(y[6], y[7]);
            *(v4u*)(Y + (size_t)(m0 + row) * D + h * GD + 8 * chunk) = w;
        }
        LDS_WAIT();
    }
}

#ifndef GDN_REF
#define GDN_REF 0
#endif
#ifndef REPMASK
#define REPMASK 0u
#endif
__device__ __forceinline__ int nrep_opaque(int n) { asm volatile("" : "+s"(n)); return n; }
#define NREP(k) (((((REPMASK) >> (k)) & 1)) ? nrep_opaque(2) : 1)
#ifndef PHMASK
#define PHMASK 0xFFFFFFFFu
#endif
#ifndef WGM_BIG
#define WGM_BIG 4
#endif
#ifndef WGM_RES
#define WGM_RES 4
#endif
#ifndef WGM_ATT
#define WGM_ATT 4
#endif
#ifndef WGM_DOWN
#define WGM_DOWN 4
#endif
constexpr int PRENORM_SPLIT = 9216;
struct Args { const float* in[21]; float* out; unsigned char* ws; int pro_lo, pro_hi, l_lo, l_hi, ph_lo, ph_hi, one, fin; };
enum { PH_MIXIN = 3, PH_GDNPRE, PH_GDNSCAN, PH_OUTGATE, PH_MIXOUT, PH_SCORES, PH_ATTOUT, PH_UP, PH_SWIGLU, PH_DOWN, PH_END };

typedef const __attribute__((address_space(4))) Args* KArgP;
__device__ __forceinline__ KArgP kargs() { KArgP ap = (KArgP)__builtin_amdgcn_kernarg_segment_ptr(); asm volatile("" : "+s"(ap)); return ap; }
__device__ __forceinline__ int lane_id() { int l; asm volatile("v_mbcnt_lo_u32_b32 %0, -1, 0\n\tv_mbcnt_hi_u32_b32 %0, -1, %0" : "=v"(l)); return l; }
__device__ __forceinline__ Frame mkframe(KArgP ap, LAS unsigned char* lds, int wave_s) {
    Frame F; int t = (wave_s << 6) | lane_id(); asm volatile("" : "+v"(t));
    F.lds = lds; F.tid = t; F.lane = t & 63; F.wave = __builtin_amdgcn_readfirstlane(t >> 6);
    int bx = blockIdx.x; asm volatile("" : "+s"(bx));
    F.bx = bx; F.G = gridDim.x; F.gw = bx * NWAVES + F.wave; F.NGW = F.G * NWAVES; F.ws = ap->ws;
    return F;
}
#ifndef SKEW_TICKS
#define SKEW_TICKS 250
#endif
__device__ __forceinline__ void phase_skew(int slot, int ticks) { const unsigned long long t0 = __builtin_amdgcn_s_memrealtime(); const unsigned long long d = (unsigned long long)slot * ticks;
    while (__builtin_amdgcn_s_memrealtime() - t0 < d) __builtin_amdgcn_s_sleep(8); }
__global__ void __launch_bounds__(NTHREADS, 2) trunk_fwd(Args args) {
    extern __shared__ __attribute__((aligned(16))) unsigned char lds_raw[];
    LAS unsigned char* const lds = (LAS unsigned char*)lds_raw;
    for (int u = threadIdx.x; u < (LDS_BYTES - LDSCTL_OFF) / 4; u += NTHREADS) ((LAS unsigned*)(lds + LDSCTL_OFF))[u] = 0u;
    __syncthreads();
    const int wave_s = __builtin_amdgcn_readfirstlane((int)threadIdx.x >> 6);
    XcdBarrier bar; bar.bar = (unsigned*)(args.ws + WS_CTL) + CW_BAR; bar.x = 0; bar.st = nullptr;
    const bool one = args.one != 0;
    if (one) bar = xcd_barrier_post((unsigned*)(args.ws + WS_CTL) + CW_BAR, (volatile LAS unsigned*)(lds + MISC_OFF) + 8);
#define SEAM() do { if (kargs()->one != 0) xcd_barrier(bar, wave_s == 0 && lane_id() == 0); } while (0)
#define PHASE_BEGIN() KArgP ap = kargs(); Frame F = mkframe(ap, lds, wave_s); PG8_LAS unsigned char* ring = (PG8_LAS unsigned char*)(lds + RING_OFF); (void)ring; \
    bf16* const HA = (bf16*)(F.ws + WS_H); (void)HA; bf16* const HB = (bf16*)(F.ws + WS_HB); (void)HB; unsigned char* const XQ = F.ws + WS_XQ; (void)XQ; float* const SSQ = (float*)(F.ws + WS_SSQ); (void)SSQ
#define PRO(k) ((((PHMASK) >> (k)) & 1) && args.pro_lo <= (k) && (k) < args.pro_hi)

    if (PRO(0)) {
        PHASE_BEGIN();
        p0_weights_x(F, 0, 0, DEPTH, F.gw, F.NGW, ap->in[IN_W_XQ], ap->in[IN_W_XK], ap->in[IN_W_XV], ap->in[IN_W_XO], ap->in[IN_XATTN_NORM]);
        p0_weights_x(F, 1, 0, 1, F.gw, F.NGW, ap->in[IN_W_XQ], ap->in[IN_W_XK], ap->in[IN_W_XV], ap->in[IN_W_XO], ap->in[IN_XATTN_NORM]);
        p0_memn(F, ap->in[IN_MEM], ap->in[IN_MEM_NORM]);
        SEAM();
    }
    if (PRO(1)) {
        PHASE_BEGIN();
        if (F.bx < 128) {
            KvOrder S{128, F.bx, (const bf16*)(F.ws + WS_MEMN), (const bf16*)(F.ws + WS_WXK), (const bf16*)(F.ws + WS_WXV)};
            pg8::Gemm g{nullptr, nullptr, D, D, D};
            pg8::EpiBf16<LocKv, false> E{LocKv{(bf16*)(F.ws + WS_KX), (bf16*)(F.ws + WS_VX)}, 1.0f, nullptr};
            pg8::gemm_phase<pg8::EpiBf16<LocKv, false>, KvOrder, true>(ring, g, S, E, F.tid);
            prenorm_phase(F, ap->in[IN_X], HB, XQ, SSQ, F.gw, 128 * NWAVES, PRENORM_SPLIT, M);
        } else {
            p0_weights_main(F, 0, F.gw - 128 * NWAVES, F.NGW - 128 * NWAVES, ap->in[IN_W_MIX_IN], ap->in[IN_W_MIX_OUT], ap->in[IN_W_UP], ap->in[IN_W_DOWN], ap->in[IN_MIX_NORM], ap->in[IN_FFN_NORM]);
            prenorm_phase(F, ap->in[IN_X], HB, XQ, SSQ, F.gw - 128 * NWAVES, F.NGW - 128 * NWAVES, 0, PRENORM_SPLIT); }
        SEAM();
    }
    const int lo = args.ph_lo, hi = args.ph_hi;
#define IN(k) ((((PHMASK) >> (k)) & 1) && lo <= (k) && (k) < hi)
    for (int l = args.l_lo; l < args.l_hi; ++l) {
        if (IN(PH_MIXIN)) {
            PHASE_BEGIN();
            ba_phase(F, HB, SSQ + (size_t)(3 * l) * M, (const bf16*)(F.ws + WS_WBA) + (size_t)l * 16 * D, ap->in[IN_A_LOG] + l * GH, ap->in[IN_DT_BIAS] + l * GH);
            pg8::Gemm g{HB, (const bf16*)(F.ws + WS_WMIX) + (size_t)l * NMIX * D, D, D, D}; pg8::StaticOrder S; S.init(M, NMIX, F.G, F.bx, WGM_BIG);
            pg8::EpiBf16<pg8::LocPlain, true> E{pg8::LocPlain{(bf16*)(F.ws + WS_PROJ), NMIX}, 1.0f, SSQ + (size_t)(3 * l) * M};
#ifndef PROBE_K
#define PROBE_K 2048
#endif
            for (int rep = 0; rep < NREP(3); ++rep) { if (rep) SEAM(); g.K = (NREP(3) > 1 && rep == 0) ? PROBE_K : D;
            pg8::gemm_phase<pg8::EpiBf16<pg8::LocPlain, true>, pg8::StaticOrder, true>(ring, g, S, E, F.tid); }
            SEAM();
        }
        if (IN(PH_GDNPRE)) { PHASE_BEGIN(); for (int rep = 0; rep < NREP(4); ++rep) { if (rep) SEAM(); gdn_prep_phase(F, ap->in[IN_GDN_CONV] + (size_t)l * 4 * 3 * GW); } SEAM(); }
        if (IN(PH_GDNSCAN)) {
            PHASE_BEGIN();
            if (F.bx < 64 || F.G <= 64) gdn_scan_phase(F);
            if (F.bx >= 64 && F.bx < 192) {
                PreOrder S{l, F.bx - 64, (const bf16*)(F.ws + WS_KX), (const bf16*)(F.ws + WS_VX), (const bf16*)(F.ws + WS_WXQ), (const bf16*)(F.ws + WS_WXO)};
                pg8::Gemm g{nullptr, nullptr, D, D, XD};
                pg8::EpiBf16<LocPre, false> E{LocPre{(bf16*)(F.ws + WS_WQK), (bf16*)(F.ws + WS_VWO)}, 1.0f, nullptr};
                pg8::gemm_phase<pg8::EpiBf16<LocPre, false>, PreOrder, true>(ring, g, S, E, F.tid);
            }
            if (F.G <= 64) shortconv_phase(F, ap->in[IN_SC_CONV] + (size_t)l * 3 * SCW, F.gw, F.NGW);
            else if (F.bx >= 64) shortconv_phase(F, ap->in[IN_SC_CONV] + (size_t)l * 3 * SCW, F.gw - 64 * NWAVES, F.NGW - 64 * NWAVES);
            if (l + 1 < DEPTH) { if (F.G <= 64) p0_weights_main(F, l + 1, F.gw, F.NGW, ap->in[IN_W_MIX_IN], ap->in[IN_W_MIX_OUT], ap->in[IN_W_UP], ap->in[IN_W_DOWN], ap->in[IN_MIX_NORM] + (l + 1) * D, ap->in[IN_FFN_NORM] + (l + 1) * D);
                else if (F.bx >= 64) { p0_weights_main(F, l + 1, F.gw - 64 * NWAVES, F.NGW - 64 * NWAVES, ap->in[IN_W_MIX_IN], ap->in[IN_W_MIX_OUT], ap->in[IN_W_UP], ap->in[IN_W_DOWN], ap->in[IN_MIX_NORM] + (l + 1) * D, ap->in[IN_FFN_NORM] + (l + 1) * D);
                    p0_weights_x(F, 1, l + 1, l + 2, F.gw - 64 * NWAVES, F.NGW - 64 * NWAVES, ap->in[IN_W_XQ], ap->in[IN_W_XK], ap->in[IN_W_XV], ap->in[IN_W_XO], ap->in[IN_XATTN_NORM]); } }
            SEAM(); }
        if (IN(PH_OUTGATE)) { PHASE_BEGIN(); for (int rep = 0; rep < NREP(6); ++rep) { if (rep) SEAM(); gdn_out_phase(F, ap->in[IN_OUT_NORM] + (size_t)l * GD); } SEAM(); }
        if (IN(PH_MIXOUT)) {
            PHASE_BEGIN();
            pg8::Gemm g{(const bf16*)(F.ws + WS_Y), (const bf16*)(F.ws + WS_WOUT) + (size_t)l * D * D, D, D, D}; pg8::StaticOrder S; S.init(M, D, F.G, F.bx, WGM_RES);
            pg8::EpiResNorm E{HB, XQ, HA, XQ, D, SSQ + (size_t)(3 * l + 1) * M};
            pg8::gemm_phase<pg8::EpiResNorm, pg8::StaticOrder, true>(ring, g, S, E, F.tid);
            SEAM();
        }
        if (IN(PH_SCORES)) {
            PHASE_BEGIN();
            pg8::Gemm g{HA, (const bf16*)(F.ws + WS_WQK) + (size_t)l * 2 * (XH * NMEM) * D, D, D, D}; SOrder S{F.G, F.bx};
            pg8::EpiSoftmax E{(bf16*)(F.ws + WS_PB), XH * NMEM, 0.044194173824159216f * 1.4426950408889634f, SSQ + (size_t)(3 * l + 1) * M};
            for (int rep = 0; rep < NREP(8); ++rep) { if (rep) SEAM();
            pg8::gemm_phase<pg8::EpiSoftmax, SOrder, false>(ring, g, S, E, F.tid); }
            SEAM();
        }
        if (IN(PH_ATTOUT)) {
            PHASE_BEGIN();
            pg8::Gemm g{(const bf16*)(F.ws + WS_PB), (const bf16*)(F.ws + WS_VWO) + (size_t)l * 2 * D * (XH * NMEM), XH * NMEM, XH * NMEM, XH * NMEM};
            BatchOrder S; S.init(M, D, F.G, F.bx, WGM_ATT); S.bstride = (size_t)D * (XH * NMEM);
            pg8::EpiResNorm E{HA, XQ, HA, XQ, D, SSQ + (size_t)(3 * l + 2) * M};
            pg8::gemm_phase<pg8::EpiResNorm, BatchOrder, true>(ring, g, S, E, F.tid);
            SEAM();
        }
        if (IN(PH_UP)) {
            PHASE_BEGIN();
            pg8::Gemm g{HA, (const bf16*)(F.ws + WS_WUP) + (size_t)l * 2 * DFF * D, D, D, D}; pg8::StaticOrder S; S.init(M, 2 * DFF, F.G, F.bx, WGM_BIG);
            pg8::EpiSwiglu E{(bf16*)(F.ws + WS_ACT), (float*)(F.ws + WS_PART), (float*)(F.ws + WS_HALO), ap->in[IN_FFN_CONV] + (size_t)l * 3 * 2 * DFF, SSQ + (size_t)(3 * l + 2) * M, (PG8_LAS float*)(lds + XB_OFF), DFF};
            for (int rep = 0; rep < NREP(10); ++rep) { if (rep) SEAM();
            pg8::gemm_phase<pg8::EpiSwiglu, pg8::StaticOrder, true>(ring, g, S, E, F.tid); }
            SEAM();
        }
        if (IN(PH_DOWN)) {
            PHASE_BEGIN();
            pg8::Gemm g{(const bf16*)(F.ws + WS_ACT), (const bf16*)(F.ws + WS_WDN) + (size_t)l * D * DFF, DFF, DFF, DFF}; pg8::StaticOrder S; S.init(M, D, F.G, F.bx, WGM_DOWN);
            { pg8::Unit fu; for (int i = 0; S.next(i, fu); ++i) swiglu_fix_phase(F, ap->in[IN_FFN_CONV] + (size_t)l * 3 * 2 * DFF, fu.pm); }
            VM_WAIT(); __syncthreads();
            pg8::EpiResNorm E{HA, XQ, HB, XQ, D, SSQ + (size_t)(3 * (l + 1)) * M};
            pg8::gemm_phase<pg8::EpiResNorm, pg8::StaticOrder, true>(ring, g, S, E, F.tid);
            SEAM();
        }
    }
    if ((((PHMASK) >> 30) & 1) && args.fin) { PHASE_BEGIN(); final_norm_phase(F, HB, XQ, ap->in[IN_FINAL_NORM], ap->out); }
#undef IN
#undef PRO
#undef SEAM
#undef PHASE_BEGIN
}

extern "C" void kernel_launch(void* const* d_in, const int* in_sizes, int n_in, void* d_out, int out_size, void* d_ws, size_t ws_size, hipStream_t stream) {
    static int grid = 0;
    if (grid == 0) {
        if (n_in != 21 || in_sizes[0] != M * D || out_size != M * D || ws_size < WS_END) { fprintf(stderr, "kernel_launch: unexpected shapes / workspace (n_in %d, in0 %d, out %d, ws %zu < %zu); nothing launched\n", n_in, n_in > 0 ? in_sizes[0] : -1, out_size, ws_size, (size_t)WS_END); grid = -1; return; }
        int dev = 0, cus = 0, per_cu = 0;
        if (hipGetDevice(&dev) != hipSuccess || hipDeviceGetAttribute(&cus, hipDeviceAttributeMultiprocessorCount, dev) != hipSuccess) { fprintf(stderr, "kernel_launch: device query failed\n"); grid = -1; return; }
        if (hipFuncSetAttribute((const void*)trunk_fwd, hipFuncAttributeMaxDynamicSharedMemorySize, LDS_BYTES) != hipSuccess) { fprintf(stderr, "kernel_launch: hipFuncSetAttribute failed\n"); grid = -1; return; }
        if (hipOccupancyMaxActiveBlocksPerMultiprocessor(&per_cu, (const void*)trunk_fwd, NTHREADS, LDS_BYTES) != hipSuccess || per_cu < 1)
            fprintf(stderr, "kernel_launch: note: occupancy query reports %d workgroups per CU\n", per_cu);
        (void)hipGetLastError();
        if (cus != 256) { fprintf(stderr, "kernel_launch: built for 256 CUs, device has %d; nothing launched\n", cus); grid = -1; return; }
        grid = cus;
    }
    if (grid < 0) return;
    if (hipMemsetAsync((char*)d_ws + WS_CTL, 0, CTL_ZERO_BYTES, stream) != hipSuccess) { fprintf(stderr, "kernel_launch: memset failed\n"); return; }
    Args a{};
    for (int i = 0; i < 21; ++i) a.in[i] = (const float*)d_in[i];
    a.out = (float*)d_out; a.ws = (unsigned char*)d_ws;
#if MK_ONE_LAUNCH
    a.pro_lo = 0; a.pro_hi = 2; a.l_lo = 0; a.l_hi = DEPTH; a.ph_lo = PH_MIXIN; a.ph_hi = PH_END; a.one = 1; a.fin = 1;
    hipLaunchKernelGGL(trunk_fwd, dim3(grid), dim3(NTHREADS), LDS_BYTES, stream, a);
#else
    a.one = 0; a.fin = 0; a.l_lo = 0; a.l_hi = 0; a.ph_lo = 0; a.ph_hi = 0;
    for (int p = 0; p < 2; ++p) { a.pro_lo = p; a.pro_hi = p + 1; hipLaunchKernelGGL(trunk_fwd, dim3(grid), dim3(NTHREADS), LDS_BYTES, stream, a); }
    a.pro_lo = 0; a.pro_hi = 0;
    for (int l = 0; l < DEPTH; ++l)
        for (int p = PH_MIXIN; p < PH_END; ++p) { a.l_lo = l; a.l_hi = l + 1; a.ph_lo = p; a.ph_hi = p + 1;
            hipLaunchKernelGGL(trunk_fwd, dim3(grid), dim3(NTHREADS), LDS_BYTES, stream, a); }
    a.l_lo = 0; a.l_hi = 0; a.fin = 1;
    hipLaunchKernelGGL(trunk_fwd, dim3(grid), dim3(NTHREADS), LDS_BYTES, stream, a);
#endif
    const hipError_t le = hipPeekAtLastError();
    if (le != hipSuccess) fprintf(stderr, "kernel_launch: launch failed: %s\n", hipGetErrorName(le));
}
```

```cpp
#include <hip/hip_runtime.h>
#define MK_ONE_LAUNCH 1
#include <cstdio>
#include <cstdint>

#ifndef MK_ONE_LAUNCH
#define MK_ONE_LAUNCH 1
#endif

namespace pg8 {
#define PG8_LAS __attribute__((address_space(3)))
typedef unsigned short bf16_t;
typedef short bf16x8 __attribute__((ext_vector_type(8)));
typedef float f32x4 __attribute__((ext_vector_type(4)));
typedef float f32x2 __attribute__((ext_vector_type(2)));
typedef unsigned u32x4 __attribute__((ext_vector_type(4)));
constexpr int BM = 256, BK = 64, HALF = 128, HTB = HALF * BK * 2  , STAGE_BYTES = 8 * HTB, NXCD = 8, WGM = 4;

__host__ __device__ __forceinline__ int lds_byte(int r, int c) { const int st = (r >> 4) * 2 + (c >> 5), rr = r & 15, cc = c & 31, ob = rr * 64 + cc * 2; return st * 1024 + (ob ^ (((ob >> 9) & 1) << 5)); }
__host__ __device__ __forceinline__ void stage_rc(int b, int& R, int& C) { const int st = b / 1024, sb = b % 1024, swz = sb ^ (((sb >> 9) & 1) << 5); R = (st >> 1) * 16 + swz / 64; C = (st & 1) * 32 + (swz % 64) / 2; }
__host__ __device__ __forceinline__ int perm32(int rho) { const int n = rho >> 4, i = rho & 15; return 8 * (i >> 2) + 4 * n + (i & 3); }

struct Unit { int pm, pn; };
struct Gemm { const bf16_t* A; const bf16_t* Bt; int lda, ldb, K; };

struct StaticOrder {
    int nM, nN, nwg, G, c, wgm;
    __host__ __device__ void init(int M, int N, int G_, int c_, int wgm_ = WGM) { nM = M / BM; nN = N / BM; nwg = nM * nN; G = G_; c = c_; wgm = wgm_; }
    __host__ __device__ bool next(int i, Unit& u) const {
        const long L = (long)i * G + c; if (L >= nwg) return false;
        int wgid = (int)L; { const int q = nwg / NXCD, r = nwg % NXCD, xcd = wgid % NXCD, off = wgid / NXCD; wgid = (xcd < r ? xcd * (q + 1) : r * (q + 1) + (xcd - r) * q) + off; }
        const int nig = wgm * nN, gid = wgid / nig, fm = gid * wgm, gsz = (nM - fm) < wgm ? (nM - fm) : wgm;
        u.pm = fm + ((wgid % nig) % gsz); u.pn = (wgid % nig) / gsz; return true;
    }
    __device__ __forceinline__ const char* pa(const Gemm& g, const Unit& u) const { return (const char*)g.A + (size_t)u.pm * BM * g.lda * 2; }
    __device__ __forceinline__ const char* pb(const Gemm& g, const Unit& u) const { return (const char*)g.Bt + (size_t)u.pn * BM * g.ldb * 2; }
};

__device__ __forceinline__ float rcp_f(float x) { return __builtin_amdgcn_rcpf(x); }
__device__ __forceinline__ float rsq_f(float x) { return __builtin_amdgcn_rsqf(x); }
__device__ __forceinline__ unsigned cvt_pk_bf16(float lo, float hi) { unsigned r; asm volatile("v_cvt_pk_bf16_f32 %0, %1, %2" : "=v"(r) : "v"(lo), "v"(hi)); return r; }
typedef unsigned u32x2 __attribute__((ext_vector_type(2)));
__device__ __forceinline__ void xs_decode8(const u32x4 h, const u32x2 q, f32x2 (&x)[4]) {
#pragma unroll
    for (int e = 0; e < 8; ++e) { const unsigned sel = 0x0504000cu + 0x02020000u * (e & 1) + 0x100u * (e & 3);
        x[e >> 1][e & 1] = __uint_as_float(__builtin_amdgcn_perm(h[e >> 1], q[e >> 2], sel) - 0x8000u); }
}
__device__ __forceinline__ void xs_encode8(const f32x2 (&x)[4], u32x4& h, u32x2& q) {
    unsigned t[8];
#pragma unroll
    for (int e = 0; e < 8; ++e) t[e] = __float_as_uint(x[e >> 1][e & 1]) + 0x8080u;
#pragma unroll
    for (int k = 0; k < 4; ++k) h[k] = __builtin_amdgcn_perm(t[2 * k + 1], t[2 * k], 0x07060302u);
#pragma unroll
    for (int k = 0; k < 2; ++k) { const unsigned p01 = __builtin_amdgcn_perm(t[4 * k + 1], t[4 * k], 0x0c0c0501u), p23 = __builtin_amdgcn_perm(t[4 * k + 3], t[4 * k + 2], 0x0c0c0501u);
        q[k] = __builtin_amdgcn_perm(p23, p01, 0x05040100u); }
}
__device__ __forceinline__ float xs_sumsq8(const f32x2 (&x)[4]) { f32x2 s = x[0] * x[0]; s = x[1] * x[1] + s; s = x[2] * x[2] + s; s = x[3] * x[3] + s; return s[0] + s[1]; }


template <class Loc, bool RS  > struct EpiBf16 {
    static constexpr bool PERM = true, APERM = false, AFTER_DRAIN = false, ROWSCALE = RS;
    Loc loc; float scale; const float* ssq;
    __device__ __forceinline__ void operator()(const f32x4 (&acc)[2][2][4][2], const Unit& u, int wr, int wc, int fr, int fq, const PG8_LAS float* rows = nullptr) const {
        bf16_t* base; int ldc; loc(u, base, ldc);
        const int row0 = wr * 64 + fr, col0 = wc * 32 + 8 * fq;
        float sc[2][4];
#pragma unroll
        for (int ai = 0; ai < 2; ++ai)
#pragma unroll
            for (int m = 0; m < 4; ++m) sc[ai][m] = RS ? rows[row0 + ai * HALF + m * 16] : 0.f;
#pragma unroll
        for (int ai = 0; ai < 2; ++ai)
#pragma unroll
            for (int m = 0; m < 4; ++m) sc[ai][m] = RS ? this->scale * (rsq_f(sc[ai][m] * (1.0f / 2048.0f) + 1e-6f)) : this->scale;
#pragma unroll
        for (int ai = 0; ai < 2; ++ai)
#pragma unroll
            for (int m = 0; m < 4; ++m) { bf16_t* rowp = base + (size_t)(row0 + ai * HALF + m * 16) * ldc + col0;
                const float scale = sc[ai][m];
#pragma unroll
                for (int bj = 0; bj < 2; ++bj) { f32x4 v0 = acc[ai][bj][m][0] * scale, v1 = acc[ai][bj][m][1] * scale;
                    u32x4 w; w.x = cvt_pk_bf16(v0[0], v0[1]); w.y = cvt_pk_bf16(v0[2], v0[3]); w.z = cvt_pk_bf16(v1[0], v1[1]); w.w = cvt_pk_bf16(v1[2], v1[3]);
                    *(u32x4*)(rowp + bj * HALF) = w; } }
    }
};
struct EpiNull { static constexpr bool PERM = true, APERM = false, AFTER_DRAIN = false, ROWSCALE = false;
    __device__ __forceinline__ void operator()(const f32x4 (&acc)[2][2][4][2], const Unit&, int, int, int, int) const {
#pragma unroll
        for (int ai = 0; ai < 2; ++ai)
#pragma unroll
            for (int bj = 0; bj < 2; ++bj)
#pragma unroll
                for (int m = 0; m < 4; ++m)
#pragma unroll
                    for (int n = 0; n < 2; ++n) asm volatile("" :: "v"(acc[ai][bj][m][n])); } };
struct LocDummy { bf16_t* O; __device__ __forceinline__ void operator()(const Unit& u, bf16_t*& base, int& ld) const { base = O + (size_t)u.pm * BM * BM; ld = BM; } };
struct LocPlain { bf16_t* O; int ldc; __device__ __forceinline__ void operator()(const Unit& u, bf16_t*& base, int& ld) const { base = O + (size_t)u.pm * BM * ldc + (size_t)u.pn * BM; ld = ldc; } };

struct EpiResNorm {
    static constexpr bool PERM = true, APERM = false, AFTER_DRAIN = false, ROWSCALE = false;
    const bf16_t* rh; const unsigned char* rq; bf16_t* oh; unsigned char* oq; int ldc; float* ssq;
    __device__ __forceinline__ void operator()(const f32x4 (&acc)[2][2][4][2], const Unit& u, int wr, int wc, int fr, int fq) const {
        const int row0 = u.pm * BM + wr * 64 + fr, col0 = u.pn * BM + wc * 32 + 8 * fq;
        float ssv[8];
#pragma unroll
        for (int pr = 0; pr < 2; ++pr) {
            u32x4 hb[4][2]; u32x2 qb[4][2];
#pragma unroll
            for (int q = 0; q < 4; ++q) { const int it = 4 * pr + q; const size_t offq = (size_t)(row0 + (it >> 2) * HALF + (it & 3) * 16) * ldc + col0;
#pragma unroll
                for (int bj = 0; bj < 2; ++bj) { hb[q][bj] = *(const u32x4*)(rh + offq + bj * HALF); qb[q][bj] = *(const u32x2*)(rq + offq + bj * HALF); } }
            __builtin_amdgcn_sched_barrier(0);
#pragma unroll
            for (int q = 0; q < 4; ++q) { const int it = 4 * pr + q, ai = it >> 2, m = it & 3; const int row = row0 + ai * HALF + m * 16; const size_t off = (size_t)row * ldc + col0;
                float ss = 0.f;
#pragma unroll
                for (int bj = 0; bj < 2; ++bj) { f32x2 x[4]; xs_decode8(hb[q][bj], qb[q][bj], x);
#pragma unroll
                    for (int k = 0; k < 4; ++k) x[k] += (k & 1) ? acc[ai][bj][m][k >> 1].zw : acc[ai][bj][m][k >> 1].xy;
                    ss += xs_sumsq8(x);
                    u32x4 ho; u32x2 qo; xs_encode8(x, ho, qo);
                    *(u32x4*)(oh + off + bj * HALF) = ho; *(u32x2*)(oq + off + bj * HALF) = qo; }
                ss += __shfl_xor(ss, 16); ss += __shfl_xor(ss, 32);
                ssv[it] = ss;
            }
            __builtin_amdgcn_sched_barrier(0);
        }
        if (fq == 0) {
#pragma unroll
            for (int it = 0; it < 8; ++it) atomicAdd(ssq + row0 + (it >> 2) * HALF + (it & 3) * 16, ssv[it]);
        }
    }
};

struct EpiSoftmax {
    static constexpr bool PERM = true, APERM = false, AFTER_DRAIN = true, ROWSCALE = false;
    bf16_t* P; int ldc; float sl2e; const float* ssq;
    __device__ __forceinline__ void fused(f32x4 (&acc)[2][2][4][2], const Unit& u, int wr, int wc, int fr, int fq, PG8_LAS unsigned char* lds, int wid, int lane) const {
        PG8_LAS float* Pm = (PG8_LAS float*)lds;
        PG8_LAS float* Ps = (PG8_LAS float*)(lds + 4096);
        float rs[2][4];
#pragma unroll
        for (int ai = 0; ai < 2; ++ai)
#pragma unroll
            for (int m = 0; m < 4; ++m) rs[ai][m] = ssq[u.pm * BM + ai * HALF + wr * 64 + m * 16 + fr];
#pragma unroll
        for (int ai = 0; ai < 2; ++ai)
#pragma unroll
            for (int m = 0; m < 4; ++m) {
                float mx = -3.0e38f;
#pragma unroll
                for (int bj = 0; bj < 2; ++bj)
#pragma unroll
                    for (int n = 0; n < 2; ++n) { const f32x4 x = acc[ai][bj][m][n]; mx = fmaxf(mx, fmaxf(fmaxf(x[0], x[1]), fmaxf(x[2], x[3]))); }
                mx = fmaxf(mx, __shfl_xor(mx, 16)); mx = fmaxf(mx, __shfl_xor(mx, 32));
                if (fq == 0) Pm[(ai * HALF + wr * 64 + m * 16 + fr) * 4 + wc] = mx;
            }
        asm volatile("s_waitcnt lgkmcnt(0)" ::: "memory"); __builtin_amdgcn_s_barrier(); asm volatile("" ::: "memory");
#pragma unroll
        for (int ai = 0; ai < 2; ++ai)
#pragma unroll
            for (int m = 0; m < 4; ++m) {
                const int row = ai * HALF + wr * 64 + m * 16 + fr;
                const f32x4 pm4 = *(const PG8_LAS f32x4*)(Pm + row * 4);
                const float gm = fmaxf(fmaxf(pm4[0], pm4[1]), fmaxf(pm4[2], pm4[3]));
                const float sl2e = this->sl2e * (rsq_f(rs[ai][m] * (1.0f / 2048.0f) + 1e-6f));
                float s = 0.f;
#pragma unroll
                for (int bj = 0; bj < 2; ++bj)
#pragma unroll
                    for (int n = 0; n < 2; ++n) { f32x4 x = acc[ai][bj][m][n];
#pragma unroll
                        for (int j = 0; j < 4; ++j) { x[j] = __builtin_amdgcn_exp2f((x[j] - gm) * sl2e); s += x[j]; }
                        acc[ai][bj][m][n] = x; }
                s += __shfl_xor(s, 16); s += __shfl_xor(s, 32);
                if (fq == 0) Ps[row * 4 + wc] = s;
            }
        asm volatile("s_waitcnt lgkmcnt(0)" ::: "memory"); __builtin_amdgcn_s_barrier(); asm volatile("" ::: "memory");
        bf16_t* base = P + (size_t)u.pm * BM * ldc + (size_t)u.pn * BM;
#pragma unroll
        for (int ai = 0; ai < 2; ++ai)
#pragma unroll
            for (int m = 0; m < 4; ++m) {
                const int row = ai * HALF + wr * 64 + m * 16 + fr;
                const f32x4 ps4 = *(const PG8_LAS f32x4*)(Ps + row * 4);
                const float inv = rcp_f((ps4[0] + ps4[1]) + (ps4[2] + ps4[3]));
                bf16_t* rowp = base + (size_t)row * ldc + wc * 32 + 8 * fq;
#pragma unroll
                for (int bj = 0; bj < 2; ++bj) { const f32x4 v0 = acc[ai][bj][m][0] * inv, v1 = acc[ai][bj][m][1] * inv;
                    u32x4 w; w.x = cvt_pk_bf16(v0[0], v0[1]); w.y = cvt_pk_bf16(v0[2], v0[3]); w.z = cvt_pk_bf16(v1[0], v1[1]); w.w = cvt_pk_bf16(v1[2], v1[3]);
                    *(u32x4*)(rowp + bj * HALF) = w; }
            }
    }
};

__device__ __forceinline__ float dpp_shr1(float old, float v) { return __builtin_bit_cast(float, __builtin_amdgcn_update_dpp(__builtin_bit_cast(int, old), __builtin_bit_cast(int, v), 0x111, 0xf, 0xf, false)); }
struct EpiSwiglu {
    static constexpr bool PERM = true, APERM = true, AFTER_DRAIN = false, ROWSCALE = true;
    bf16_t* act; float* part; float* halo; const float* cw; const float* ssq; PG8_LAS float* xb; int dff;
    __device__ __forceinline__ void operator()(f32x4 (&acc)[2][2][4][2], const Unit& u, int wr, int wc, int fr, int fq, const PG8_LAS float* rows) const {
        const int ccol = wc * 32 + 8 * fq;
#pragma unroll
        for (int ai = 0; ai < 2; ++ai) { const f32x4 s4 = *(const PG8_LAS f32x4*)(rows + ai * HALF + wr * 64 + 4 * fr);
#pragma unroll
            for (int m = 0; m < 4; ++m) { const float sc = rsq_f(s4[m] * (1.0f / 2048.0f) + 1e-6f);
#pragma unroll
                for (int bj = 0; bj < 2; ++bj)
#pragma unroll
                    for (int n = 0; n < 2; ++n) acc[ai][bj][m][n] = acc[ai][bj][m][n] * sc; } }
        if (fr == 15) {
#pragma unroll
            for (int ai = 0; ai < 2; ++ai)
#pragma unroll
                for (int bj = 0; bj < 2; ++bj)
#pragma unroll
                    for (int n = 0; n < 2; ++n)
#pragma unroll
                        for (int k = 0; k < 2; ++k) { *(PG8_LAS f32x4*)(xb + ((wr * 2 + ai) * 2 + k) * 256 + bj * HALF + ccol + 4 * n) = acc[ai][bj][2 + k][n];
                            if (wr == 1 && ai == 1) *(f32x4*)(halo + ((size_t)(u.pm * 2 + k) * 2 + bj) * dff + u.pn * HALF + ccol + 4 * n) = acc[1][bj][2 + k][n]; }
        }
        asm volatile("s_waitcnt lgkmcnt(0)" ::: "memory"); __builtin_amdgcn_s_barrier(); asm volatile("" ::: "memory");
        u32x2 wsave[2][4];
#pragma unroll
        for (int n = 0; n < 2; ++n) {
            const int ch = u.pn * HALF + ccol + 4 * n;
            f32x4 wg[3], wu[3];
#pragma unroll
            for (int t = 0; t < 3; ++t) { wg[t] = *(const f32x4*)(cw + (size_t)t * 2 * dff + ch); wu[t] = *(const f32x4*)(cw + (size_t)t * 2 * dff + dff + ch); }
#pragma unroll
            for (int ai = 0; ai < 2; ++ai) {
                f32x4 e0g = {0.f, 0.f, 0.f, 0.f}, e1g = e0g, e0u = e0g, e1u = e0g;
                if (ai + wr > 0) { const int sw = wr ^ 1, sa = wr == 0 ? ai - 1 : ai; const PG8_LAS float* xp = xb + ((sw * 2 + sa) * 2) * 256 + ccol + 4 * n;
                    e0g = *(const PG8_LAS f32x4*)(xp); e1g = *(const PG8_LAS f32x4*)(xp + 256); e0u = *(const PG8_LAS f32x4*)(xp + HALF); e1u = *(const PG8_LAS f32x4*)(xp + 256 + HALF); }
                f32x4 p3g, p2g, p3u, p2u;
#pragma unroll
                for (int j = 0; j < 4; ++j) { p3g[j] = dpp_shr1(e1g[j], acc[ai][0][3][n][j]); p2g[j] = dpp_shr1(e0g[j], acc[ai][0][2][n][j]);
                    p3u[j] = dpp_shr1(e1u[j], acc[ai][1][3][n][j]); p2u[j] = dpp_shr1(e0u[j], acc[ai][1][2][n][j]); }
#pragma unroll
                for (int m = 0; m < 4; ++m) {
                    const f32x4 G = acc[ai][0][m][n], U = acc[ai][1][m][n];
                    const f32x4 g1 = m >= 1 ? acc[ai][0][m >= 1 ? m - 1 : 0][n] : p3g, g2 = m >= 2 ? acc[ai][0][m >= 2 ? m - 2 : 0][n] : (m == 1 ? p3g : p2g);
                    const f32x4 u1 = m >= 1 ? acc[ai][1][m >= 1 ? m - 1 : 0][n] : p3u, u2 = m >= 2 ? acc[ai][1][m >= 2 ? m - 2 : 0][n] : (m == 1 ? p3u : p2u);
                    const f32x4 cg = wg[2] * G + wg[1] * g1 + wg[0] * g2, cu = wu[2] * U + wu[1] * u1 + wu[0] * u2;
                    const int row = u.pm * BM + ai * HALF + wr * 64 + 4 * fr + m;
                    if (m < 2 && ai == 0 && wr == 0 && fr == 0) {
                        *(f32x4*)(part + ((size_t)(u.pm * 2 + m) * 2 + 0) * dff + ch) = cg; *(f32x4*)(part + ((size_t)(u.pm * 2 + m) * 2 + 1) * dff + ch) = cu;
                    } else {
                        f32x4 e;
#pragma unroll
                        for (int j = 0; j < 4; ++j) e[j] = rcp_f(1.0f + __expf(-cg[j]));
                        const f32x4 a = cg * cu * e;
                        u32x2 w; w.x = cvt_pk_bf16(a[0], a[1]); w.y = cvt_pk_bf16(a[2], a[3]);
                        if (n == 0) wsave[ai][m] = w;
                        else { u32x4 w4; w4.x = wsave[ai][m].x; w4.y = wsave[ai][m].y; w4.z = w.x; w4.w = w.y; *(u32x4*)(act + (size_t)row * dff + ch - 4) = w4; }
                    }
                }
                __builtin_amdgcn_sched_barrier(0);
            }
        }
    }
};

template <class Epi, class Sched, bool ALIGN_EPI = false>
__device__ __forceinline__ void gemm_phase(PG8_LAS unsigned char* lds, const Gemm g, const Sched& S, const Epi& E, int tid_in) {
    int tid_ = tid_in; asm volatile("" : "+v"(tid_));
    const int tid = tid_, wid = __builtin_amdgcn_readfirstlane(tid >> 6), lane = tid & 63, wr = wid >> 2, wc = wid & 3, fr = lane & 15, fq = lane >> 4;
    const int K = g.K, nt = K / BK;
    unsigned voffA[2], voffB[2];
#pragma unroll
    for (int i = 0; i < 2; ++i) { int R, C; stage_rc(tid * 16 + i * 8192, R, C); const int Rb = Epi::PERM ? ((R & ~31) + perm32(R & 31)) : R;
        const int Ra = Epi::APERM ? ((R & ~63) + 4 * (R & 15) + ((R >> 4) & 3)) : R;
        voffA[i] = (unsigned)(Ra * g.lda + C) * 2u; voffB[i] = (unsigned)(Rb * g.ldb + C) * 2u; }
    const size_t kstep = (size_t)(BK * 2);
    const size_t hstepA = (size_t)HALF * g.lda * 2, hstepB = (size_t)HALF * g.ldb * 2;
    const unsigned ldsw = (unsigned)wid * 1024u;
    const int aoff = lds_byte(wr * 64 + fr, fq * 8), boff = lds_byte(wc * 32 + fr, fq * 8);
#define PG8_SA(b, h) (((b) * 2 + (h)) * HTB)
#define PG8_SB(b, h) ((4 + (b) * 2 + (h)) * HTB)
#define PG8_STAGE(bufoff, gbase, voff) do { _Pragma("unroll") for (int _i = 0; _i < 2; ++_i) \
        __builtin_amdgcn_global_load_lds((const unsigned*)((const char*)(gbase) + (voff)[_i]), (PG8_LAS unsigned*)(lds + (bufoff) + ldsw + _i * 8192), 16, 0, 0); } while (0)
#define PG8_LDA(dst, b, h) do { _Pragma("unroll") for (int m = 0; m < 4; ++m) _Pragma("unroll") for (int k = 0; k < 2; ++k) dst[m][k] = *(const PG8_LAS bf16x8*)(lds + PG8_SA(b, h) + aoff + m * 2048 + k * 1024); } while (0)
#define PG8_LDB(dst, b, h) do { _Pragma("unroll") for (int n = 0; n < 2; ++n) _Pragma("unroll") for (int k = 0; k < 2; ++k) dst[n][k] = *(const PG8_LAS bf16x8*)(lds + PG8_SB(b, h) + boff + n * 2048 + k * 1024); } while (0)
#define PG8_MMA(ai, bj, At, Bt) do { __builtin_amdgcn_s_setprio(1); _Pragma("unroll") for (int m = 0; m < 4; ++m) _Pragma("unroll") for (int n = 0; n < 2; ++n) _Pragma("unroll") for (int k = 0; k < 2; ++k) \
        acc[ai][bj][m][n] = __builtin_amdgcn_mfma_f32_16x16x32_bf16(Bt[n][k], At[m][k], acc[ai][bj][m][n], 0, 0, 0); __builtin_amdgcn_s_setprio(0); } while (0)
#define PG8_WAIT_V(n) asm volatile("s_waitcnt vmcnt(" #n ")" ::: "memory")
#define PG8_WAIT_L(n) asm volatile("s_waitcnt lgkmcnt(" #n ")" ::: "memory")
#define PG8_BAR __builtin_amdgcn_s_barrier()
#define PG8_SCHED __builtin_amdgcn_sched_barrier(0)
    Unit cur, nxt; int ui = 0;
    if (!S.next(0, cur)) return;
    f32x4 acc[2][2][4][2];
#pragma unroll
    for (int a = 0; a < 2; ++a)
#pragma unroll
        for (int b = 0; b < 2; ++b)
#pragma unroll
            for (int m = 0; m < 4; ++m)
#pragma unroll
                for (int n = 0; n < 2; ++n) acc[a][b][m][n] = (f32x4){0.f, 0.f, 0.f, 0.f};
    bf16x8 At[4][2], B0[2][2], B1[2][2];
    const char* cA = S.pa(g, cur); const char* cB = S.pb(g, cur);
#define PG8_ROWS(ui_) ((const PG8_LAS float*)(lds + STAGE_BYTES + 1024 + 8192 + ((ui_) & 1) * 1024))
#define PG8_ROWFETCH(unit_, ui_) do { if constexpr (Epi::ROWSCALE) { if (wid < 4) __builtin_amdgcn_global_load_lds((const unsigned*)(E.ssq + (unit_).pm * BM + wid * 64 + lane), \
        (PG8_LAS unsigned*)(lds + STAGE_BYTES + 1024 + 8192 + ((ui_) & 1) * 1024 + wid * 256), 4, 0, 0); } } while (0)
    PG8_ROWFETCH(cur, 0);
    PG8_STAGE(PG8_SB(0, 0), cB, voffB); PG8_STAGE(PG8_SB(0, 1), cB + hstepB, voffB); PG8_STAGE(PG8_SA(0, 0), cA, voffA); PG8_STAGE(PG8_SA(0, 1), cA + hstepA, voffA);
    if (wr == 1) PG8_BAR;
    PG8_WAIT_V(2); PG8_BAR;
    PG8_STAGE(PG8_SB(1, 0), cB + kstep, voffB); PG8_STAGE(PG8_SA(1, 0), cA + kstep, voffA); PG8_STAGE(PG8_SB(1, 1), cB + hstepB + kstep, voffB);
    PG8_WAIT_V(6); PG8_BAR;
    for (;;) {
        const bool has_next = S.next(ui + 1, nxt);
        const char* nA = has_next ? S.pa(g, nxt) : cA; const char* nB = has_next ? S.pb(g, nxt) : cB;
#pragma nounroll
        for (int t = 0; t < nt; t += 2) {
            const bool last = (t == nt - 2);
            const char* a1 = cA + (size_t)(t + 1) * kstep;
            const char* a2 = last ? nA : cA + (size_t)(t + 2) * kstep; const char* b2 = last ? nB : cB + (size_t)(t + 2) * kstep;
            const char* a3 = a2 + kstep; const char* b3 = b2 + kstep;
            PG8_LDB(B0, 0, 0); PG8_LDB(B1, 0, 1); PG8_SCHED; PG8_LDA(At, 0, 0); PG8_STAGE(PG8_SA(1, 1), a1 + hstepA, voffA);
            PG8_WAIT_V(8); PG8_WAIT_L(0); PG8_BAR; PG8_MMA(0, 0, At, B0); PG8_MMA(0, 1, At, B1); PG8_BAR; PG8_SCHED;
            PG8_LDA(At, 0, 1); PG8_STAGE(PG8_SB(0, 0), b2, voffB); PG8_STAGE(PG8_SB(0, 1), b2 + hstepB, voffB); PG8_STAGE(PG8_SA(0, 0), a2, voffA);
            PG8_WAIT_V(8); PG8_WAIT_L(0); PG8_BAR; PG8_MMA(1, 0, At, B0); PG8_MMA(1, 1, At, B1); PG8_BAR; PG8_SCHED;
            PG8_LDB(B0, 1, 0); PG8_LDB(B1, 1, 1); PG8_SCHED; PG8_LDA(At, 1, 0); PG8_STAGE(PG8_SA(0, 1), a2 + hstepA, voffA);
            PG8_WAIT_V(8); PG8_WAIT_L(0); PG8_BAR; PG8_MMA(0, 0, At, B0); PG8_MMA(0, 1, At, B1); PG8_BAR; PG8_SCHED;
            PG8_LDA(At, 1, 1); PG8_STAGE(PG8_SB(1, 0), b3, voffB); PG8_STAGE(PG8_SB(1, 1), b3 + hstepB, voffB); PG8_STAGE(PG8_SA(1, 0), a3, voffA);
            PG8_WAIT_V(8); PG8_WAIT_L(0); PG8_BAR; PG8_MMA(1, 0, At, B0); PG8_MMA(1, 1, At, B1); PG8_BAR; PG8_SCHED;
        }
        if constexpr (ALIGN_EPI) { if (wr == 0) PG8_BAR; }
        if constexpr (!Epi::AFTER_DRAIN) { if constexpr (Epi::ROWSCALE) E(acc, cur, wr, wc, fr, fq, PG8_ROWS(ui)); else E(acc, cur, wr, wc, fr, fq); }
        if (!has_next) break;
#pragma unroll
        for (int a = 0; a < 2; ++a)
#pragma unroll
            for (int b = 0; b < 2; ++b)
#pragma unroll
                for (int m = 0; m < 4; ++m)
#pragma unroll
                    for (int n = 0; n < 2; ++n) acc[a][b][m][n] = (f32x4){0.f, 0.f, 0.f, 0.f};
        cur = nxt; cA = nA; cB = nB; ++ui;
        PG8_ROWFETCH(cur, ui);
        if constexpr (ALIGN_EPI) { if (wr == 1) PG8_BAR; }
    }
    PG8_WAIT_V(0);
    if constexpr (!ALIGN_EPI) { if (wr == 0) PG8_BAR; }
    PG8_BAR;
    if constexpr (Epi::AFTER_DRAIN) { E.fused(acc, cur, wr, wc, fr, fq, lds, wid, lane); }
#undef PG8_ROWS
#undef PG8_ROWFETCH
#undef PG8_SA
#undef PG8_SB
#undef PG8_STAGE
#undef PG8_LDA
#undef PG8_LDB
#undef PG8_MMA
#undef PG8_WAIT_V
#undef PG8_WAIT_L
#undef PG8_BAR
#undef PG8_SCHED
}
}

constexpr int BATCH = 2, SEQ = 8192, D = 2048, DEPTH = 4, M = BATCH * SEQ;
constexpr int GW = 1024, GH = 8, GD = 128, SCW = 1024, NMEM = 256, XH = 4, XD = 512, DFF = 5632;
constexpr int NMIX_SRC = 7184, NMIX = 7168;
constexpr int PC_Q = 0, PC_K = 1024, PC_V = 2048, PC_Z = 3072, PC_B = 4096, PC_C = 5120, PC_H = 6144;
constexpr float EPS = 1e-6f;
constexpr int NWAVES = 8, NTHREADS = 512;

constexpr size_t MiB = 1u << 20;
constexpr size_t WS_CTL = 0, CTL_ZERO_BYTES = 1 * MiB;
constexpr size_t WS_WMIX = 1 * MiB;
constexpr size_t WS_WOUT = WS_WMIX + 112 * MiB;
constexpr size_t WS_WXQ  = WS_WOUT + 32 * MiB;
constexpr size_t WS_WXK  = WS_WXQ + 32 * MiB;
constexpr size_t WS_WXV  = WS_WXK + 32 * MiB;
constexpr size_t WS_WXO  = WS_WXV + 32 * MiB;
constexpr size_t WS_WUP  = WS_WXO + 32 * MiB;
constexpr size_t WS_WDN  = WS_WUP + 176 * MiB;
constexpr size_t WS_MEMN = WS_WDN + 88 * MiB;
constexpr size_t WS_KX   = WS_MEMN + 8 * MiB;
constexpr size_t WS_VX   = WS_KX + 8 * MiB;
constexpr size_t WS_BETA = WS_VX + 8 * MiB;
constexpr size_t WS_WBA  = WS_BETA + 512 * 1024;
constexpr size_t WS_G    = WS_BETA + 1 * MiB;
constexpr size_t WS_H    = WS_G + 1 * MiB;
constexpr size_t WS_OG   = WS_H + 64 * MiB;
constexpr size_t WS_Y    = WS_OG + 64 * MiB;
constexpr size_t WS_PB   = WS_OG;
constexpr size_t WS_HB   = WS_Y + 64 * MiB;
constexpr size_t WS_BIG  = WS_HB + 64 * MiB;
constexpr size_t WS_PROJ = WS_BIG;
constexpr size_t WS_GS   = WS_BIG + 224 * MiB;
constexpr size_t WS_ACT  = WS_BIG;
constexpr size_t WS_HALO = WS_BIG + 192 * MiB;
constexpr size_t WS_PART = WS_BIG + 200 * MiB;
constexpr size_t WS_WQK  = WS_BIG + 416 * MiB;
constexpr size_t WS_VWO  = WS_WQK + 32 * MiB;
constexpr size_t WS_XQ   = WS_VWO + 32 * MiB;
constexpr size_t WS_END  = WS_XQ + 32 * MiB;
constexpr size_t WS_SSQ  = 65536;
static_assert(WS_SSQ + (size_t)(DEPTH * 3 + 1) * M * 4 <= CTL_ZERO_BYTES, "ssq arrays inside the zeroed region");
constexpr int CW_BAR = 4096;

constexpr int RING_OFF = 0, RING_BYTES = 131072;
constexpr int LDSCTL_OFF = RING_BYTES, MISC_OFF = LDSCTL_OFF + 320, XB_OFF = LDSCTL_OFF + 1024;
constexpr int LDS_BYTES = 147456;

#define GAS __attribute__((address_space(1)))
#define LAS __attribute__((address_space(3)))
typedef unsigned short bf16;
typedef unsigned v4u __attribute__((ext_vector_type(4)));
typedef unsigned v2u __attribute__((ext_vector_type(2)));
typedef float f32x4 __attribute__((ext_vector_type(4)));
typedef short bf16x8 __attribute__((ext_vector_type(8)));
#define LDS_WAIT() asm volatile("s_waitcnt lgkmcnt(0)" ::: "memory")
#define VM_WAIT() asm volatile("s_waitcnt vmcnt(0)" ::: "memory")
__device__ __forceinline__ unsigned pk2(float lo, float hi) { return pg8::cvt_pk_bf16(lo, hi); }
__device__ __forceinline__ float bf_lo(unsigned w) { return __uint_as_float(w << 16); }
__device__ __forceinline__ float bf_hi(unsigned w) { return __uint_as_float(w & 0xffff0000u); }
__device__ __forceinline__ float wave_sum(float v) {
#pragma unroll
    for (int o = 1; o < 64; o <<= 1) v += __shfl_xor(v, o);
    return v;
}
__device__ __forceinline__ float silu_f(float y) { return y * pg8::rcp_f(1.0f + __expf(-y)); }
__device__ __forceinline__ float sigmoid_f(float y) { return pg8::rcp_f(1.0f + __expf(-y)); }

#define XB_TMO      128
#define XB_XCNT(j)  (256  + 64 * (j))
#define XB_XSUB(j)  (1280 + 64 * (j))
#define XB_XGEN(j)  (2304 + 64 * (j))
#define XB_TOP      3328
#define XB_TOPGEN   3392
#define XCD_BAR_WORDS 3456
#define XB_SPIN_CAP (1u << 18)

__device__ __forceinline__ unsigned xb_ld(unsigned* p)              { return __hip_atomic_load(p, __ATOMIC_RELAXED, __HIP_MEMORY_SCOPE_AGENT); }
__device__ __forceinline__ unsigned xb_add(unsigned* p, unsigned v) { return __hip_atomic_fetch_add(p, v, __ATOMIC_RELAXED, __HIP_MEMORY_SCOPE_AGENT); }
__device__ __forceinline__ unsigned xb_xcc_id() { return (unsigned)__builtin_amdgcn_s_getreg((3 << 11) | 20) & 0xFu; }
#define XB_SPIN(cond, bar) do { unsigned _sp = 0; while (cond) { __builtin_amdgcn_s_sleep(1); \
    if ((++_sp & 255u) == 0u) { if (xb_ld(&(bar)[XB_TMO])) break; if (_sp > XB_SPIN_CAP) { atomicAdd(&(bar)[XB_TMO], 1u); break; } } } } while (0)

struct XcdBarrier {
    unsigned* bar; unsigned x;
    volatile LAS unsigned* st;
};

__device__ __forceinline__ XcdBarrier xcd_barrier_post(unsigned* bar, volatile LAS unsigned* st) {
    XcdBarrier b; b.bar = bar; b.x = xb_xcc_id(); b.st = st;
    if (threadIdx.x == 0) (void)xb_add(&bar[XB_XCNT(b.x)], 1u);
    return b;
}
__device__ __forceinline__ void xcd_barrier_complete(unsigned* bar, unsigned x, unsigned& nloc, unsigned& nx) {
    const unsigned G = gridDim.x * gridDim.y * gridDim.z;
    unsigned sum, cnt, mine, sp = 0u;
    for (;;) {
        sum = 0u; cnt = 0u; mine = 0u;
#pragma unroll
        for (unsigned j = 0; j < 16; ++j) { const unsigned c = xb_ld(&bar[XB_XCNT(j)]); sum += c; cnt += (c > 0u) ? 1u : 0u; mine = (j == x) ? c : mine; }
        if (sum == G) break;
        __builtin_amdgcn_s_sleep(1);
        if ((++sp & 255u) == 0u) { if (xb_ld(&bar[XB_TMO])) break; if (sp > XB_SPIN_CAP) { atomicAdd(&bar[XB_TMO], 1u); break; } }
    }
    nloc = mine > 0u ? mine : 1u; nx = cnt > 0u ? cnt : 1u;
}

__device__ __forceinline__ void xcd_barrier(const XcdBarrier& b, bool t0) {
    asm volatile("s_waitcnt vmcnt(0)" ::: "memory");
    __syncthreads();
    if (t0) {
        unsigned* bar = b.bar;
        __builtin_amdgcn_s_waitcnt(0);
        unsigned nloc = b.st[0], nx = b.st[1];
        if (nloc == 0u) { xcd_barrier_complete(bar, b.x, nloc, nx); b.st[0] = nloc; b.st[1] = nx; }
        const unsigned old = xb_add(&bar[XB_XSUB(b.x)], 1u);
        const unsigned gen = old / nloc;
        if (old + 1u == (gen + 1u) * nloc) {
            __builtin_amdgcn_fence(__ATOMIC_RELEASE, "agent");
            asm volatile("s_waitcnt vmcnt(0)" ::: "memory");
            const unsigned og = xb_add(&bar[XB_TOP], 1u);
            const unsigned tg = og / nx;
            if (og + 1u == (tg + 1u) * nx) xb_add(&bar[XB_TOPGEN], 1u);
            else XB_SPIN(xb_ld(&bar[XB_TOPGEN]) == tg, bar);
            __builtin_amdgcn_fence(__ATOMIC_ACQUIRE, "agent");
            xb_add(&bar[XB_XGEN(b.x)], 1u);
            asm volatile("s_waitcnt vmcnt(0)" ::: "memory");
        } else {
            XB_SPIN(xb_ld(&bar[XB_XGEN(b.x)]) == gen, bar);
            __builtin_amdgcn_fence(__ATOMIC_ACQUIRE, "agent");
            asm volatile("s_waitcnt vmcnt(0)" ::: "memory");
        }
    }
    __syncthreads();
}


struct Frame {
    LAS unsigned char* lds;
    int tid, lane, wave, G, gw, NGW, bx;
    unsigned char* ws;
};
#define IN_X 0
#define IN_MEM 1
#define IN_MIX_NORM 2
#define IN_W_MIX_IN 3
#define IN_GDN_CONV 4
#define IN_A_LOG 5
#define IN_DT_BIAS 6
#define IN_OUT_NORM 7
#define IN_SC_CONV 8
#define IN_W_MIX_OUT 9
#define IN_XATTN_NORM 10
#define IN_MEM_NORM 11
#define IN_W_XQ 12
#define IN_W_XK 13
#define IN_W_XV 14
#define IN_W_XO 15
#define IN_FFN_NORM 16
#define IN_W_UP 17
#define IN_FFN_CONV 18
#define IN_W_DOWN 19
#define IN_FINAL_NORM 20

template <bool SCALE>
__device__ __forceinline__ void xpose_item(const float* src  , size_t ld, bf16* dst  , size_t K, int lane, LAS unsigned char* T, const float* gk = nullptr  ) {
    const int n4 = lane & 15, ksub = lane >> 4;
    const float* s = src + (size_t)(16 * ksub) * ld + 4 * n4;
    f32x4 v[16];
#pragma unroll
    for (int i = 0; i < 16; ++i) v[i] = *(const f32x4*)(s + (size_t)i * ld);
    if constexpr (SCALE) { f32x4 g[4];
#pragma unroll
        for (int i = 0; i < 4; ++i) g[i] = *(const f32x4*)(gk + 16 * ksub + 4 * i);
#pragma unroll
        for (int i = 0; i < 16; ++i) v[i] = v[i] * g[i >> 2][i & 3]; }
#pragma unroll
    for (int j = 0; j < 4; ++j) { v4u a, b; a.x = pk2(v[0][j], v[1][j]); a.y = pk2(v[2][j], v[3][j]); a.z = pk2(v[4][j], v[5][j]); a.w = pk2(v[6][j], v[7][j]);
        b.x = pk2(v[8][j], v[9][j]); b.y = pk2(v[10][j], v[11][j]); b.z = pk2(v[12][j], v[13][j]); b.w = pk2(v[14][j], v[15][j]);
        LAS v4u* t = (LAS v4u*)(T + (4 * n4 + j) * 144 + 32 * ksub); t[0] = a; t[1] = b; }
    LDS_WAIT(); asm volatile("" ::: "memory");
#pragma unroll
    for (int i = 0; i < 8; ++i) { const int n = 8 * i + (lane >> 3), c = lane & 7; *(v4u*)(dst + (size_t)n * K + 8 * c) = *(const LAS v4u*)(T + n * 144 + 16 * c); }
    LDS_WAIT(); asm volatile("" ::: "memory");
}
__device__ __forceinline__ void convert_item(const float* src, bf16* dst, int lane, float g0, float g1) {
#pragma unroll
    for (int k = 0; k < 8; ++k) { const float g = k < 4 ? g0 : g1; const f32x4 a = *(const f32x4*)(src + k * 512 + 8 * lane) * g, b = *(const f32x4*)(src + k * 512 + 8 * lane + 4) * g;
        v4u o; o.x = pk2(a[0], a[1]); o.y = pk2(a[2], a[3]); o.z = pk2(b[0], b[1]); o.w = pk2(b[2], b[3]); *(v4u*)(dst + k * 512 + 8 * lane) = o; }
}
__device__ __forceinline__ void p0_weights_x(Frame& F, int mode, int l_lo, int l_hi, int gw, int ngw, const float* w_xq, const float* w_xk, const float* w_xv, const float* w_xo, const float* g_xattn  ) {
    constexpr int I_SQ = 32 * 32;
    LAS unsigned char* T = F.lds + RING_OFF + F.wave * 9216;
    for (int it = gw; it < (l_hi - l_lo) * 2 * I_SQ; it += ngw) {
        const int l = l_lo + it / (2 * I_SQ); int r = it % (2 * I_SQ);
        if (mode == 0 || r < I_SQ) { const int f = mode == 0 ? r / I_SQ : 2, rr = r % I_SQ, nb = rr >> 5, kb = rr & 31;
            const float* src = f == 0 ? w_xk : f == 1 ? w_xv : w_xo;
            const size_t dofs = f == 0 ? WS_WXK : f == 1 ? WS_WXV : WS_WXO;
            xpose_item<false>(src + (size_t)l * D * D + (size_t)(kb * 64) * D + nb * 64, D, (bf16*)(F.ws + dofs) + (size_t)l * D * D + (size_t)(nb * 64) * D + kb * 64, D, F.lane, T); continue; }
        r -= I_SQ;
        convert_item(w_xq + (size_t)l * D * D + (size_t)r * 4096, (bf16*)(F.ws + WS_WXQ) + (size_t)l * D * D + (size_t)r * 4096, F.lane, g_xattn[l * D + 2 * r], g_xattn[l * D + 2 * r + 1]);
    }
}
__device__ __forceinline__ void p0_weights_main(Frame& F, int l, int gw, int ngw, const float* w_mix_in, const float* w_mix_out, const float* w_up, const float* w_down, const float* g_mix  , const float* g_ffn) {
    constexpr int I_MIX = 112 * 32, I_SQ = 32 * 32, I_UP = 176 * 32, I_DN = 32 * 88, I_LAYER = I_MIX + I_SQ + I_UP + I_DN;
    LAS unsigned char* T = F.lds + RING_OFF + F.wave * 9216;
    for (int it = gw; it < I_LAYER; it += ngw) {
        int r = it;
        if (r < I_MIX) { const int nb = r >> 5, kb = r & 31, n0 = nb * 64, sc = n0 < 4096 ? n0 : n0 + 16;
            xpose_item<true>(w_mix_in + (size_t)l * D * NMIX_SRC + (size_t)(kb * 64) * NMIX_SRC + sc, NMIX_SRC, (bf16*)(F.ws + WS_WMIX) + (size_t)l * NMIX * D + (size_t)n0 * D + kb * 64, D, F.lane, T, g_mix + kb * 64); continue; }
        r -= I_MIX;
        if (r < I_SQ) { const int nb = r >> 5, kb = r & 31;
            xpose_item<false>(w_mix_out + (size_t)l * D * D + (size_t)(kb * 64) * D + nb * 64, D, (bf16*)(F.ws + WS_WOUT) + (size_t)l * D * D + (size_t)(nb * 64) * D + kb * 64, D, F.lane, T); continue; }
        r -= I_SQ;
        if (r < I_UP) { const int nb = r >> 5, kb = r & 31, n0 = nb * 64, c0 = n0 < DFF ? n0 : n0 - DFF, drow = (c0 >> 7) * 256 + (n0 < DFF ? 0 : 128) + (c0 & 127);
            xpose_item<true>(w_up + (size_t)l * D * 2 * DFF + (size_t)(kb * 64) * 2 * DFF + n0, 2 * DFF, (bf16*)(F.ws + WS_WUP) + (size_t)l * 2 * DFF * D + (size_t)drow * D + kb * 64, D, F.lane, T, g_ffn + kb * 64); continue; }
        r -= I_UP;
        { const int nb = r / 88, kb = r % 88;
            xpose_item<false>(w_down + (size_t)l * DFF * D + (size_t)(kb * 64) * D + nb * 64, D, (bf16*)(F.ws + WS_WDN) + (size_t)l * D * DFF + (size_t)(nb * 64) * DFF + kb * 64, DFF, F.lane, T); }
    }
    for (int i = gw * 64 + F.lane; i < 16 * D; i += ngw * 64) { const int n = i / D, k = i % D;
        ((bf16*)(F.ws + WS_WBA))[(size_t)l * 16 * D + i] = (bf16)(pk2(w_mix_in[(size_t)l * D * NMIX_SRC + (size_t)k * NMIX_SRC + 4096 + n] * g_mix[k], 0.f) & 0xffffu); }
}
__device__ __forceinline__ void p0_memn(Frame& F, const float* mem, const float* mem_norm) {
    for (int m = F.gw; m < BATCH * NMEM; m += F.NGW) {
        const f32x4* xr = (const f32x4*)(mem + (size_t)m * D) + F.lane;
        f32x4 v[8]; float s = 0.f;
#pragma unroll
        for (int j = 0; j < 8; ++j) { v[j] = xr[64 * j]; s += (v[j][0] * v[j][0] + v[j][1] * v[j][1]) + (v[j][2] * v[j][2] + v[j][3] * v[j][3]); }
        const float rstd = pg8::rsq_f(wave_sum(s) * (1.0f / D) + EPS);
#pragma unroll
        for (int l0 = 0; l0 < DEPTH; l0 += 2) {
            f32x4 g4[2][8];
#pragma unroll
            for (int l = 0; l < 2; ++l)
#pragma unroll
                for (int j = 0; j < 8; ++j) g4[l][j] = ((const f32x4*)(mem_norm + (size_t)(l0 + l) * D))[64 * j + F.lane];
#pragma unroll
            for (int l = 0; l < 2; ++l) {
                v2u* o8 = (v2u*)((bf16*)(F.ws + WS_MEMN) + ((size_t)(l0 + l) * 512 + m) * D) + F.lane;
#pragma unroll
                for (int j = 0; j < 8; ++j) { const f32x4 h = v[j] * rstd * g4[l][j]; v2u o; o.x = pk2(h[0], h[1]); o.y = pk2(h[2], h[3]); o8[64 * j] = o; }
            }
        }
    }
}

__device__ __forceinline__ void prenorm_phase(Frame& F, const float* x, bf16* Xh, unsigned char* Xq, float* ssq, int gw, int ngw, int m_lo, int m_hi) {
    for (int m = m_lo + gw; m < m_hi; m += ngw) {
        const float* xr = x + (size_t)m * D + 8 * F.lane;
        f32x4 v[4][2]; float s = 0.f;
#pragma unroll
        for (int j = 0; j < 4; ++j)
#pragma unroll
            for (int h = 0; h < 2; ++h) { v[j][h] = *(const f32x4*)(xr + 512 * j + 4 * h); s += (v[j][h][0] * v[j][h][0] + v[j][h][1] * v[j][h][1]) + (v[j][h][2] * v[j][h][2] + v[j][h][3] * v[j][h][3]); }
        s = wave_sum(s);
        if (F.lane == 0) ssq[m] = s;
#pragma unroll
        for (int j = 0; j < 4; ++j) { const pg8::f32x2 xx[4] = {v[j][0].xy, v[j][0].zw, v[j][1].xy, v[j][1].zw};
            pg8::u32x4 ho; pg8::u32x2 qo; pg8::xs_encode8(xx, ho, qo);
            *(pg8::u32x4*)(Xh + (size_t)m * D + 8 * F.lane + 512 * j) = ho; *(pg8::u32x2*)(Xq + (size_t)m * D + 8 * F.lane + 512 * j) = qo; }
    }
}
__device__ __forceinline__ void ba_phase(Frame& F, const bf16* Hn, const float* ssq, const bf16* wba  , const float* alogp, const float* dtbp) {
    const int lane = F.lane, wave = F.wave, mtile = wave & 3, khalf = wave >> 2, fr = lane & 15, fq = lane >> 4;
    LAS f32x4* red = (LAS f32x4*)(F.lds);
    for (int rb = F.bx; rb < M / 64; rb += F.G) {
        const int row0 = rb * 64 + 16 * mtile;
        const bf16* ap = Hn + (size_t)(row0 + fr) * D + khalf * 1024 + 8 * fq;
        const bf16* bp = wba + (size_t)fr * D + khalf * 1024 + 8 * fq;
        f32x4 acc = {0.f, 0.f, 0.f, 0.f};
        v4u fa[8], fb[8], na[8], nb[8];
#pragma unroll
        for (int s = 0; s < 8; ++s) { fa[s] = *(const v4u*)(ap + 32 * s); fb[s] = *(const v4u*)(bp + 32 * s); }
#pragma unroll
        for (int b8 = 0; b8 < 4; ++b8) {
            if (b8 < 3) {
#pragma unroll
                for (int s = 0; s < 8; ++s) { na[s] = *(const v4u*)(ap + 32 * (8 * (b8 + 1) + s)); nb[s] = *(const v4u*)(bp + 32 * (8 * (b8 + 1) + s)); } }
            __builtin_amdgcn_sched_barrier(0);
#pragma unroll
            for (int s = 0; s < 8; ++s) acc = __builtin_amdgcn_mfma_f32_16x16x32_bf16(__builtin_bit_cast(bf16x8, fa[s]), __builtin_bit_cast(bf16x8, fb[s]), acc, 0, 0, 0);
#pragma unroll
            for (int s = 0; s < 8; ++s) { fa[s] = na[s]; fb[s] = nb[s]; }
            __builtin_amdgcn_sched_barrier(0);
        }
        if (khalf == 1) red[mtile * 64 + lane] = acc;
        LDS_WAIT(); __syncthreads();
        if (khalf == 0) {
            const f32x4 o = red[mtile * 64 + lane]; acc = acc + o;
            const float al = fr >= 8 ? alogp[fr - 8] : 0.f, db = fr >= 8 ? dtbp[fr - 8] : 0.f;
#pragma unroll
            for (int i = 0; i < 4; ++i) { const int row = row0 + 4 * fq + i; const float v = acc[i] * (pg8::rsq_f(ssq[row] * (1.0f / D) + EPS));
                if (fr < 8) ((float*)(F.ws + WS_BETA))[(size_t)row * GH + fr] = sigmoid_f(v);
                else { const float z = v + db; const float sp = fmaxf(z, 0.f) + __logf(1.0f + __expf(-fabsf(z))); ((float*)(F.ws + WS_G))[(size_t)row * GH + fr - 8] = -__expf(al) * sp; } }
        }
        LDS_WAIT(); __syncthreads();
    }
}
__device__ __forceinline__ void final_norm_phase(Frame& F, const bf16* xh, const unsigned char* xq, const float* gain, float* out) {
    f32x4 g4[4][2];
#pragma unroll
    for (int j = 0; j < 4; ++j)
#pragma unroll
        for (int h = 0; h < 2; ++h) g4[j][h] = *(const f32x4*)(gain + 8 * F.lane + 512 * j + 4 * h);
    for (int m0 = F.gw; m0 < M; m0 += 4 * F.NGW) {
        pg8::u32x4 hb[4][4]; pg8::u32x2 qb[4][4]; float s[4];
#pragma unroll
        for (int q = 0; q < 4; ++q) { const int m = m0 + q * F.NGW < M ? m0 + q * F.NGW : m0; const size_t o = (size_t)m * D + 8 * F.lane;
#pragma unroll
            for (int j = 0; j < 4; ++j) { hb[q][j] = *(const pg8::u32x4*)(xh + o + 512 * j); qb[q][j] = *(const pg8::u32x2*)(xq + o + 512 * j); } }
#pragma unroll
        for (int q = 0; q < 4; ++q) { float a = 0.f;
#pragma unroll
            for (int j = 0; j < 4; ++j) { pg8::f32x2 x[4]; pg8::xs_decode8(hb[q][j], qb[q][j], x); a += pg8::xs_sumsq8(x); }
            s[q] = pg8::rsq_f(wave_sum(a) * (1.0f / D) + EPS); }
#pragma unroll
        for (int q = 0; q < 4; ++q) { const int m = m0 + q * F.NGW; if (m < M) { float* o = out + (size_t)m * D + 8 * F.lane;
#pragma unroll
            for (int j = 0; j < 4; ++j) { pg8::f32x2 x[4]; pg8::xs_decode8(hb[q][j], qb[q][j], x);
                f32x4 a = {x[0][0], x[0][1], x[1][0], x[1][1]}, b = {x[2][0], x[2][1], x[3][0], x[3][1]};
                *(f32x4*)(o + 512 * j) = a * s[q] * g4[j][0]; *(f32x4*)(o + 512 * j + 4) = b * s[q] * g4[j][1]; } } }
    }
}

__device__ __forceinline__ void unpack8(const v4u w, float (&f)[8]) {
    f[0] = bf_lo(w.x); f[1] = bf_hi(w.x); f[2] = bf_lo(w.y); f[3] = bf_hi(w.y); f[4] = bf_lo(w.z); f[5] = bf_hi(w.z); f[6] = bf_lo(w.w); f[7] = bf_hi(w.w);
}

__device__ __forceinline__ void shortconv_phase(Frame& F, const float* cw, int gw, int ngw) {
    const bf16* PROJ = (const bf16*)(F.ws + WS_PROJ);
    bf16* Y = (bf16*)(F.ws + WS_Y);
    for (int rb = gw; rb < M / 8; rb += ngw) {
        const int m0 = rb * 8, t0 = m0 % SEQ;
        for (int i = 0; i < 2; ++i) {
            const int ch0 = 8 * (F.lane + 64 * i);
            float w[3][8];
#pragma unroll
            for (int j = 0; j < 3; ++j) { const f32x4 a = *(const f32x4*)(cw + (size_t)j * SCW + ch0), b = *(const f32x4*)(cw + (size_t)j * SCW + ch0 + 4);
                w[j][0] = a[0]; w[j][1] = a[1]; w[j][2] = a[2]; w[j][3] = a[3]; w[j][4] = b[0]; w[j][5] = b[1]; w[j][6] = b[2]; w[j][7] = b[3]; }
            float x0[8], x1[8], x2[8], cg[8], hh[8], bg[8];
            const bf16* p = PROJ + (size_t)m0 * NMIX + ch0;
            const bool hist = t0 >= 2;
            v4u rc[10], rh[10], rbq[8];
#pragma unroll
            for (int q = 0; q < 2; ++q) { const bf16* pq = hist ? p - (size_t)(2 - q) * NMIX : p; rc[q] = *(const v4u*)(pq + PC_C); rh[q] = *(const v4u*)(pq + PC_H); }
#pragma unroll
            for (int q = 0; q < 8; ++q) { rc[2 + q] = *(const v4u*)(p + (size_t)q * NMIX + PC_C); rh[2 + q] = *(const v4u*)(p + (size_t)q * NMIX + PC_H); rbq[q] = *(const v4u*)(p + (size_t)q * NMIX + PC_B); }
            unpack8(rc[0], cg); unpack8(rh[0], hh);
#pragma unroll
            for (int e = 0; e < 8; ++e) x0[e] = hist ? cg[e] * hh[e] : 0.f;
            unpack8(rc[1], cg); unpack8(rh[1], hh);
#pragma unroll
            for (int e = 0; e < 8; ++e) x1[e] = hist ? cg[e] * hh[e] : 0.f;
#pragma unroll
            for (int r = 0; r < 8; ++r) {
                unpack8(rc[2 + r], cg); unpack8(rh[2 + r], hh); unpack8(rbq[r], bg);
                float y[8];
#pragma unroll
                for (int e = 0; e < 8; ++e) { x2[e] = cg[e] * hh[e]; y[e] = bg[e] * (w[0][e] * x0[e] + w[1][e] * x1[e] + w[2][e] * x2[e]); x0[e] = x1[e]; x1[e] = x2[e]; }
                v4u o; o.x = pk2(y[0], y[1]); o.y = pk2(y[2], y[3]); o.z = pk2(y[4], y[5]); o.w = pk2(y[6], y[7]);
                *(v4u*)(Y + (size_t)(m0 + r) * D + GW + ch0) = o;
            }
        }
    }
}
__device__ __forceinline__ void swiglu_fix_phase(Frame& F, const float* cw, int pm) {
    bf16* ACT = (bf16*)(F.ws + WS_ACT); const float* PART = (const float*)(F.ws + WS_PART); const float* HALO = (const float*)(F.ws + WS_HALO);
    for (int idx = F.tid; idx < DFF / 4; idx += NTHREADS) {
        const int ch = 4 * idx;
        f32x4 wg[3], wu[3];
#pragma unroll
        for (int t = 0; t < 3; ++t) { wg[t] = *(const f32x4*)(cw + (size_t)t * 2 * DFF + ch); wu[t] = *(const f32x4*)(cw + (size_t)t * 2 * DFF + DFF + ch); }
        f32x4 g0 = *(const f32x4*)(PART + ((size_t)(pm * 2 + 0) * 2 + 0) * DFF + ch), u0 = *(const f32x4*)(PART + ((size_t)(pm * 2 + 0) * 2 + 1) * DFF + ch);
        f32x4 g1 = *(const f32x4*)(PART + ((size_t)(pm * 2 + 1) * 2 + 0) * DFF + ch), u1 = *(const f32x4*)(PART + ((size_t)(pm * 2 + 1) * 2 + 1) * DFF + ch);
        const bool hist = pm % (SEQ / 256) != 0; const int ph = hist ? pm - 1 : pm;
        f32x4 hg0 = *(const f32x4*)(HALO + ((size_t)(ph * 2 + 0) * 2 + 0) * DFF + ch), hu0 = *(const f32x4*)(HALO + ((size_t)(ph * 2 + 0) * 2 + 1) * DFF + ch);
        f32x4 hg1 = *(const f32x4*)(HALO + ((size_t)(ph * 2 + 1) * 2 + 0) * DFF + ch), hu1 = *(const f32x4*)(HALO + ((size_t)(ph * 2 + 1) * 2 + 1) * DFF + ch);
        const float hm = hist ? 1.f : 0.f; hg0 = hg0 * hm; hu0 = hu0 * hm; hg1 = hg1 * hm; hu1 = hu1 * hm;
        g0 = g0 + wg[1] * hg1 + wg[0] * hg0; u0 = u0 + wu[1] * hu1 + wu[0] * hu0; g1 = g1 + wg[0] * hg1; u1 = u1 + wu[0] * hu1;
        v2u w0, w1; w0.x = pk2(silu_f(g0[0]) * u0[0], silu_f(g0[1]) * u0[1]); w0.y = pk2(silu_f(g0[2]) * u0[2], silu_f(g0[3]) * u0[3]);
        w1.x = pk2(silu_f(g1[0]) * u1[0], silu_f(g1[1]) * u1[1]); w1.y = pk2(silu_f(g1[2]) * u1[2], silu_f(g1[3]) * u1[3]);
        *(v2u*)(ACT + (size_t)(pm * 256) * DFF + ch) = w0; *(v2u*)(ACT + (size_t)(pm * 256 + 1) * DFF + ch) = w1;
    }
}

struct KvOrder {
    int G, c; const bf16 *memn, *wxk, *wxv;
    __device__ __forceinline__ bool next(int i, pg8::Unit& u) const { const long L = (long)i * G + c; if (L >= 128) return false; u.pm = (int)L; u.pn = 0; return true; }
    __device__ __forceinline__ const char* pa(const pg8::Gemm&, const pg8::Unit& u) const { const int l = u.pm >> 5, r = u.pm & 15; return (const char*)(memn + ((size_t)l * 512 + (r >> 3) * 256) * D); }
    __device__ __forceinline__ const char* pb(const pg8::Gemm&, const pg8::Unit& u) const { const int l = u.pm >> 5, r = u.pm & 15;
        const bf16* wk = wxk + ((size_t)l * D + (r & 7) * 256) * D; const bf16* wv = wxv + ((size_t)l * D + (r & 7) * 256) * D; return (const char*)((u.pm & 16) ? wv : wk); }
};
struct LocKv { bf16 *kx, *vx;
    __device__ __forceinline__ void operator()(const pg8::Unit& u, bf16*& base, int& ld) const { const int l = u.pm >> 5, r = u.pm & 15;
        bf16* bk = kx + ((size_t)l * 512 + (r >> 3) * 256) * D + (r & 7) * 256; bf16* bv = vx + ((size_t)l * 512 + (r >> 3) * 256) * D + (r & 7) * 256; base = (u.pm & 16) ? bv : bk; ld = D; } };
struct PreOrder {
    int l, c; const bf16 *kx, *vx, *wxq, *wxo;
    __device__ __forceinline__ bool next(int i, pg8::Unit& u) const { if (i != 0 || c >= 128) return false; u.pm = (c < 64 ? c : 192 + c) + l * 64; u.pn = 0; return true; }
    __device__ __forceinline__ const char* pa(const pg8::Gemm&, const pg8::Unit& u) const { const int jj = u.pm & 255, l = jj >> 6, b = (jj >> 5) & 1, h = (jj >> 3) & 3, t = jj & 7;
        return (const char*)(u.pm < 256 ? kx + ((size_t)l * 512 + b * 256) * D + h * XD : wxo + ((size_t)l * D + t * 256) * D + h * XD); }
    __device__ __forceinline__ const char* pb(const pg8::Gemm&, const pg8::Unit& u) const { const int jj = u.pm & 255, l = jj >> 6, b = (jj >> 5) & 1, h = (jj >> 3) & 3, t = jj & 7;
        return (const char*)(u.pm < 256 ? wxq + ((size_t)l * D + t * 256) * D + h * XD : vx + ((size_t)l * 512 + b * 256) * D + h * XD); }
};
struct LocPre { bf16 *wqk, *vwo;
    __device__ __forceinline__ void operator()(const pg8::Unit& u, bf16*& base, int& ld) const { const int jj = u.pm & 255, l = jj >> 6, b = (jj >> 5) & 1, h = (jj >> 3) & 3, t = jj & 7;
        if (u.pm < 256) { base = wqk + ((size_t)(l * 2 + b) * (XH * NMEM) + h * NMEM) * D + t * 256; ld = D; }
        else { base = vwo + ((size_t)(l * 2 + b) * D + t * 256) * (XH * NMEM) + h * NMEM; ld = XH * NMEM; } } };
struct SOrder {
    int G, c;
    __device__ __forceinline__ bool next(int i, pg8::Unit& u) const { const long L = (long)i * G + c; if (L >= 256) return false; const int w = ((int)L & 7) * 32 + ((int)L >> 3); u.pm = w >> 2; u.pn = w & 3; return true; }
    __device__ __forceinline__ const char* pa(const pg8::Gemm& g, const pg8::Unit& u) const { return (const char*)(g.A + (size_t)u.pm * 256 * D); }
    __device__ __forceinline__ const char* pb(const pg8::Gemm& g, const pg8::Unit& u) const { return (const char*)(g.Bt + (size_t)(u.pm >> 5) * (XH * NMEM) * D + (size_t)u.pn * NMEM * D); }
};
struct BatchOrder : pg8::StaticOrder {
    size_t bstride;
    __device__ __forceinline__ const char* pb(const pg8::Gemm& g, const pg8::Unit& u) const { return (const char*)(g.Bt + (size_t)(u.pm >> 5) * bstride + (size_t)u.pn * pg8::BM * g.ldb); }
};

typedef float f32x16 __attribute__((ext_vector_type(16)));
typedef float f32x2n __attribute__((ext_vector_type(2)));
typedef __bf16 bf16x2n __attribute__((ext_vector_type(2)));
__device__ __forceinline__ unsigned pkn(float a, float b) { f32x2n v = {a, b}; bf16x2n r = __builtin_convertvector(v, bf16x2n); return __builtin_bit_cast(unsigned, r); }
__device__ __forceinline__ int kmap(int p) { const int pp = p & 15, hh = pp >> 3, jj = pp & 7; return (p & ~15) + 8 * (jj >> 2) + 4 * hh + (jj & 3); }
__device__ __forceinline__ int kpos(int d) { const int dd = d & 15; return (d & ~15) + 8 * ((dd >> 2) & 1) + 4 * (dd >> 3) + (dd & 3); }
__device__ __forceinline__ bf16x8 pack_step(const f32x16& x, int s) {
    v4u w; w.x = pkn(x[8 * s], x[8 * s + 1]); w.y = pkn(x[8 * s + 2], x[8 * s + 3]); w.z = pkn(x[8 * s + 4], x[8 * s + 5]); w.w = pkn(x[8 * s + 6], x[8 * s + 7]);
    return __builtin_bit_cast(bf16x8, w);
}
constexpr int REC_BYTES = 36864, WIMG_STRIDE = 272, KDIMG_OFF = 17408, KDIMG_STRIDE = 144, IMG_USED = 35840;
constexpr size_t WS_REC = WS_GS;
constexpr size_t WS_UT = WS_GS + 80 * MiB;
constexpr size_t WS_ATTN = WS_GS + 144 * MiB;
constexpr size_t WS_EGL = WS_GS + 160 * MiB;
constexpr size_t WS_SST = WS_H;
constexpr size_t WS_QD = WS_OG;
constexpr size_t WS_VST = WS_OG + 32 * MiB;

__device__ __forceinline__ void gdn_prep_phase(Frame& F, const float* cw  ) {
    const bf16* PROJ = (const bf16*)(F.ws + WS_PROJ);
    const float* BETA = (const float*)(F.ws + WS_BETA); const float* GG = (const float*)(F.ws + WS_G);
    unsigned o_vs = 32768, o_kb = 65536, o_qb = 82944, o_as = 101376, o_att = 117760, o_gc = 125952;
    asm volatile("" : "+s"(o_vs), "+s"(o_kb), "+s"(o_qb), "+s"(o_as), "+s"(o_att), "+s"(o_gc));
    LAS float* KS = (LAS float*)(F.lds);
    LAS float* VS = (LAS float*)(F.lds + o_vs);
    LAS unsigned char* KB16 = F.lds + o_kb;
    LAS unsigned char* QB16 = F.lds + o_qb;
    LAS unsigned char* IMG = KB16;
    LAS float* AS = (LAS float*)(F.lds + o_as);
    LAS unsigned short* ATT = (LAS unsigned short*)(F.lds + o_att);
    LAS float* GC = (LAS float*)(F.lds + o_gc);
    const int tid = F.tid, lane = F.lane, wave = F.wave;
#ifndef G1_REP
#define G1_REP 1
#endif
    for (int it = 0; it * F.G < 2048 * G1_REP; ++it) {
        const int u = F.bx + F.G * (it / G1_REP);
        const int ch = u, n = ch & 127, bh = ch >> 7, b = bh >> 3, h = bh & 7;
        const int m0 = b * SEQ + n * 64;
        if (tid < 384) {
            const int rb = tid / 48, cgi = tid % 48, tensor = cgi >> 4, cg = cgi & 15;
            const int ch0 = tensor * GW + h * GD + 8 * cg, c0 = rb * 8;
            float w[4][8];
#pragma unroll
            for (int j = 0; j < 4; ++j) { const f32x4 a = *(const f32x4*)(cw + (size_t)j * 3 * GW + ch0), bq = *(const f32x4*)(cw + (size_t)j * 3 * GW + ch0 + 4);
                w[j][0] = a[0]; w[j][1] = a[1]; w[j][2] = a[2]; w[j][3] = a[3]; w[j][4] = bq[0]; w[j][5] = bq[1]; w[j][6] = bq[2]; w[j][7] = bq[3]; }
            float x0[8], x1[8], x2[8], x3[8];
            const bf16* p = PROJ + (size_t)(m0 + c0) * NMIX + ch0;
            const bool hist = n * 64 + c0 >= 3;
            v4u raw[11];
#pragma unroll
            for (int q = 0; q < 3; ++q) raw[q] = *(const v4u*)(hist ? p - (size_t)(3 - q) * NMIX : p);
#pragma unroll
            for (int q = 0; q < 8; ++q) raw[3 + q] = *(const v4u*)(p + (size_t)q * NMIX);
            if (!hist) { raw[0] = (v4u){0u, 0u, 0u, 0u}; raw[1] = raw[0]; raw[2] = raw[0]; }
            unpack8(raw[0], x0); unpack8(raw[1], x1); unpack8(raw[2], x2);
#pragma unroll
            for (int r = 0; r < 8; ++r) {
                unpack8(raw[3 + r], x3);
                float y[8]; float ss = 0.f;
#pragma unroll
                for (int e = 0; e < 8; ++e) { const float c = w[0][e] * x0[e] + w[1][e] * x1[e] + w[2][e] * x2[e] + w[3][e] * x3[e]; y[e] = silu_f(c); ss += y[e] * y[e]; x0[e] = x1[e]; x1[e] = x2[e]; x2[e] = x3[e]; }
                const int c = c0 + r;
                if (tensor < 2) {
                    ss += __shfl_xor(ss, 1); ss += __shfl_xor(ss, 2); ss += __shfl_xor(ss, 4); ss += __shfl_xor(ss, 8);
                    float sc = pg8::rsq_f(ss + EPS); if (tensor == 0) sc *= 0.08838834764831845f;
#pragma unroll
                    for (int e = 0; e < 8; ++e) y[e] *= sc;
                    v4u o; o.x = pkn(y[0], y[1]); o.y = pkn(y[2], y[3]); o.z = pkn(y[4], y[5]); o.w = pkn(y[6], y[7]);
                    *(LAS v4u*)((tensor == 0 ? QB16 : KB16) + c * WIMG_STRIDE + 16 * cg) = o;
                    if (tensor == 1) { *(LAS f32x4*)(KS + c * 128 + 8 * cg) = (f32x4){y[0], y[1], y[2], y[3]}; *(LAS f32x4*)(KS + c * 128 + 8 * cg + 4) = (f32x4){y[4], y[5], y[6], y[7]}; }
                } else { *(LAS f32x4*)(VS + c * 128 + 8 * cg) = (f32x4){y[0], y[1], y[2], y[3]}; *(LAS f32x4*)(VS + c * 128 + 8 * cg + 4) = (f32x4){y[4], y[5], y[6], y[7]}; }
                __builtin_amdgcn_sched_barrier(0);
            }
        } else if (wave == 7) {
            const float g = GG[(size_t)(m0 + lane) * GH + h], be = BETA[(size_t)(m0 + lane) * GH + h];
            float x = g;
#pragma unroll
            for (int o = 1; o < 64; o <<= 1) { const float t = __builtin_bit_cast(float, __builtin_amdgcn_ds_bpermute((lane - o) << 2, __builtin_bit_cast(int, x))); if (lane >= o) x += t; }
            const float gl = __builtin_bit_cast(float, __builtin_amdgcn_readlane(__builtin_bit_cast(int, x), 63));
            GC[lane] = x; GC[64 + lane] = be; GC[128 + lane] = expf(x); GC[192 + lane] = expf(gl - x);
            if (lane == 0) ((float*)(F.ws + WS_EGL))[ch] = expf(gl);
        }
        LDS_WAIT(); __syncthreads();
        {
            const int mat = wave >> 2, mt = (wave >> 1) & 1, nt = wave & 1, r = lane & 31, hh = lane >> 5;
            const LAS unsigned char* Asrc = (mat ? QB16 : KB16) + (32 * mt + r) * WIMG_STRIDE + 16 * hh;
            const LAS unsigned char* Bsrc = KB16 + (32 * nt + r) * WIMG_STRIDE + 16 * hh;
            f32x16 acc;
#pragma unroll
            for (int i = 0; i < 16; ++i) acc[i] = 0.f;
#pragma unroll
            for (int ks = 0; ks < 8; ++ks) { const bf16x8 a = *(const LAS bf16x8*)(Asrc + 32 * ks), bb = *(const LAS bf16x8*)(Bsrc + 32 * ks); acc = __builtin_amdgcn_mfma_f32_32x32x16_bf16(a, bb, acc, 0, 0, 0); }
            const int m = 32 * nt + r; const float gcm = GC[m];
#pragma unroll
            for (int i = 0; i < 16; ++i) {
                const int c = 32 * mt + (i & 3) + 8 * (i >> 2) + 4 * hh;
                if (mat == 0) AS[c * 64 + m] = (m < c) ? GC[64 + c] * acc[i] * __expf(fminf(GC[c] - gcm, 0.f)) : 0.f;
                else { const float v = (m <= c) ? acc[i] * __expf(fminf(GC[c] - gcm, 0.f)) : 0.f; ATT[c * 64 + kpos(m)] = (unsigned short)(pkn(v, 0.f) & 0xffffu); }
            }
            const int c = tid >> 3, p0 = (tid & 7) * 16; const float eg = GC[128 + c];
            const LAS unsigned short* qrow = (const LAS unsigned short*)(QB16 + c * WIMG_STRIDE);
            float qv[16];
#pragma unroll
            for (int pp = 0; pp < 16; ++pp) qv[pp] = __uint_as_float((unsigned)qrow[p0 + 8 * ((pp & 7) >> 2) + 4 * (pp >> 3) + (pp & 3)] << 16) * eg;
            v4u o0, o1; o0.x = pkn(qv[0], qv[1]); o0.y = pkn(qv[2], qv[3]); o0.z = pkn(qv[4], qv[5]); o0.w = pkn(qv[6], qv[7]); o1.x = pkn(qv[8], qv[9]); o1.y = pkn(qv[10], qv[11]); o1.z = pkn(qv[12], qv[13]); o1.w = pkn(qv[14], qv[15]);
            v4u* qd = (v4u*)((bf16*)(F.ws + WS_QD) + (size_t)ch * 64 * 128 + c * 128 + p0); qd[0] = o0; qd[1] = o1;
        }
        LDS_WAIT(); __syncthreads();
        typedef short s16x4 __attribute__((ext_vector_type(4)));
        LAS float* DINV = GC + 256;
        if (wave == 0) {
            const int bi = lane >> 4, jc = lane & 15; const LAS float* Ab = AS + (16 * bi) * 64 + 16 * bi;
            float y[16];
#pragma unroll
            for (int rr = 0; rr < 16; ++rr) { float v = (rr == jc) ? 1.f : 0.f;
#pragma unroll
                for (int s4 = 0; s4 < (rr + 3) / 4; ++s4) { const f32x4 a = *(const LAS f32x4*)(Ab + rr * 64 + 4 * s4);
#pragma unroll
                    for (int ii = 0; ii < 4; ++ii) if (4 * s4 + ii < rr) v -= a[ii] * y[4 * s4 + ii]; }
                y[rr] = v; DINV[(bi * 16 + rr) * 16 + jc] = v; }
        } else if (wave >= 4) {
            int t = tid - 256; asm volatile("" : "+v"(t));
            const int d = t & 127, ph = t >> 7;
#pragma unroll
            for (int q8 = 0; q8 < 4; ++q8) { const int p0 = 32 * ph + 8 * q8; float kv[8];
#pragma unroll
                for (int jj = 0; jj < 8; ++jj) { const int c = (p0 & ~15) + 8 * (jj >> 2) + 4 * ((p0 >> 3) & 1) + (jj & 3); kv[jj] = KS[c * 128 + d] * GC[192 + c]; }
                v4u o; o.x = pkn(kv[0], kv[1]); o.y = pkn(kv[2], kv[3]); o.z = pkn(kv[4], kv[5]); o.w = pkn(kv[6], kv[7]);
                *(LAS v4u*)(IMG + KDIMG_OFF + d * KDIMG_STRIDE + 2 * p0) = o; }
            const LAS v4u* as = (const LAS v4u*)ATT + 2 * t; v4u* ag = (v4u*)((bf16*)(F.ws + WS_ATTN) + (size_t)ch * 4096) + 2 * t; ag[0] = as[0]; ag[1] = as[1];
        }
        LDS_WAIT(); __syncthreads();
        {
            const int fr = lane & 15, fq = lane >> 4; const bool isw = wave >= 4;
            const LAS float* src = (isw ? KS : VS) + ((32 * wave) & 127) + fr;
            s16x4 Xb[4][2];
#pragma unroll
            for (int i = 0; i < 4; ++i) {
                f32x4 T[2];
#pragma unroll
                for (int rr = 0; rr < 4; ++rr) { const int c = 16 * i + 4 * fq + rr; float f = GC[64 + c]; if (isw) f *= GC[128 + c]; T[0][rr] = src[c * 128] * f; T[1][rr] = src[c * 128 + 16] * f; }
#pragma unroll
                for (int j = 0; j < i; ++j) { const f32x4 a4 = *(const LAS f32x4*)(AS + (16 * i + fr) * 64 + 16 * j + 4 * fq);
                    v2u aw; aw.x = pkn(-a4[0], -a4[1]); aw.y = pkn(-a4[2], -a4[3]); const s16x4 a = __builtin_bit_cast(s16x4, aw);
                    T[0] = __builtin_amdgcn_mfma_f32_16x16x16bf16_1k(a, Xb[j][0], T[0], 0, 0, 0); T[1] = __builtin_amdgcn_mfma_f32_16x16x16bf16_1k(a, Xb[j][1], T[1], 0, 0, 0); }
                const f32x4 d4 = *(const LAS f32x4*)(DINV + (16 * i + fr) * 16 + 4 * fq);
                v2u dw; dw.x = pkn(d4[0], d4[1]); dw.y = pkn(d4[2], d4[3]); const s16x4 dfr = __builtin_bit_cast(s16x4, dw);
#pragma unroll
                for (int t2 = 0; t2 < 2; ++t2) {
                    v2u tw; tw.x = pkn(T[t2][0], T[t2][1]); tw.y = pkn(T[t2][2], T[t2][3]);
                    const f32x4 X = __builtin_amdgcn_mfma_f32_16x16x16bf16_1k(dfr, __builtin_bit_cast(s16x4, tw), (f32x4){0.f, 0.f, 0.f, 0.f}, 0, 0, 0);
                    v2u xw; xw.x = pkn(X[0], X[1]); xw.y = pkn(X[2], X[3]); Xb[i][t2] = __builtin_bit_cast(s16x4, xw);
                    const int col = 32 * wave + 16 * t2 + fr;
                    if (!isw) *(f32x4*)((float*)(F.ws + WS_UT) + (size_t)ch * 128 * 64 + col * 64 + 16 * i + 4 * fq) = X;
                    else { LAS unsigned short* wi = (LAS unsigned short*)(IMG) + kpos(col - 128) + (16 * i + 4 * fq) * (WIMG_STRIDE / 2);
#pragma unroll
                        for (int rr = 0; rr < 4; ++rr) wi[rr * (WIMG_STRIDE / 2)] = (unsigned short)(pkn(-X[rr], 0.f) & 0xffffu); }
                }
                __builtin_amdgcn_sched_barrier(0);
            }
        }
        LDS_WAIT(); __syncthreads();
        { v4u* rec = (v4u*)(F.ws + WS_REC + (size_t)ch * REC_BYTES);
            for (int i = tid; i < IMG_USED / 16; i += NTHREADS) rec[i] = *(const LAS v4u*)(IMG + 16 * i); }
        LDS_WAIT(); __syncthreads();
    }
}

__device__ __forceinline__ void gdn_scan_phase(Frame& F) {
    const int j = F.bx; if (j >= 64) return;
    const int bh = j & 15, quarter = j >> 4;
    const int lane = F.lane, wave = F.wave, r = lane & 31, hh = lane >> 5;
    const unsigned char* REC = F.ws + WS_REC + (size_t)bh * 128 * REC_BYTES;
#define SCAN_BAR() do { asm volatile("s_waitcnt lgkmcnt(0)" ::: "memory"); __builtin_amdgcn_s_barrier(); asm volatile("" ::: "memory"); } while (0)
#define SCAN_DMA(n_) do { _Pragma("unroll") for (int k_ = 0; k_ < 6; ++k_) { const int piece_ = (wave - 1) + 6 * k_; \
        __builtin_amdgcn_global_load_lds((const unsigned*)(REC + (size_t)(n_) * REC_BYTES + piece_ * 1024 + lane * 16), (PG8_LAS unsigned*)(F.lds + ((n_) % 3) * REC_BYTES + piece_ * 1024), 16, 0, 0); } } while (0)
    if (wave == 7) {
        const unsigned char* uw = (const unsigned char*)((const float*)(F.ws + WS_UT) + (size_t)bh * 128 * (128 * 64) + (size_t)(32 * quarter) * 64) + lane * 16;
        v4u dummy = {0u, 0u, 0u, 0u};
        SCAN_BAR();
        for (int n = 0; n < 128; ++n) {
            const int nw = n + 3 < 128 ? n + 3 : 127;
            asm volatile("s_waitcnt vmcnt(8)" : "+v"(dummy) :: "memory");
#pragma unroll
            for (int k_ = 0; k_ < 8; ++k_) asm volatile("global_load_dwordx4 %0, %1, off" : "+v"(dummy) : "v"(uw + (size_t)nw * (128 * 64 * 4) + k_ * 1024) : "memory");
            SCAN_BAR();
        }
        asm volatile("s_waitcnt vmcnt(0)" : "+v"(dummy) :: "memory");
    }
    else if (wave >= 1) {
        SCAN_DMA(0); SCAN_DMA(1); VM_WAIT(); SCAN_BAR();
        for (int n = 0; n < 128; ++n) {
            if (n + 2 < 128) { SCAN_DMA(n + 2); asm volatile("s_waitcnt vmcnt(6)" ::: "memory"); }
            else VM_WAIT();
            SCAN_BAR();
        }
    } else {
        const int cw = quarter;
        const float* UT = (const float*)(F.ws + WS_UT) + (size_t)bh * 128 * (128 * 64) + (size_t)(32 * cw + r) * 64 + 4 * hh;
        v4u* SST = (v4u*)(F.ws + WS_SST) + (size_t)bh * 128 * (4 * 8 * 64) + (size_t)cw * (8 * 64) + lane;
        v4u* VST = (v4u*)(F.ws + WS_VST) + (size_t)bh * 128 * (4 * 4 * 64) + (size_t)cw * (4 * 64) + lane;
        const float* EGLp = (const float*)(F.ws + WS_EGL) + bh * 128;
        f32x16 S[4];
#pragma unroll
        for (int t = 0; t < 4; ++t)
#pragma unroll
            for (int i = 0; i < 16; ++i) S[t][i] = 0.f;
        unsigned sbw[8][4];
#pragma unroll
        for (int q = 0; q < 8; ++q)
#pragma unroll
            for (int w = 0; w < 4; ++w) sbw[q][w] = 0u;
#define SB_FRAG(q_) __builtin_bit_cast(bf16x8, (v4u){sbw[q_][0], sbw[q_][1], sbw[q_][2], sbw[q_][3]})
#define SB_PACK_QUARTER(t_, qq_) do { const int s_ = (qq_) >> 1, h_ = (qq_) & 1; \
        sbw[2 * (t_) + s_][2 * h_] = pkn(S[t_][8 * s_ + 4 * h_], S[t_][8 * s_ + 4 * h_ + 1]); sbw[2 * (t_) + s_][2 * h_ + 1] = pkn(S[t_][8 * s_ + 4 * h_ + 2], S[t_][8 * s_ + 4 * h_ + 3]); } while (0)
        SCAN_BAR();
        for (int n = 0; n < 128; ++n) {
            const LAS unsigned char* buf = F.lds + (n % 3) * REC_BYTES;
            f32x4 un[4]; f32x16 acc[2];
            { const float* up = UT + (size_t)n * (128 * 64);
#pragma unroll
                for (int q = 0; q < 4; ++q) un[q] = *(const f32x4*)(up + 8 * q);
#pragma unroll
                for (int q = 0; q < 4; ++q) { const f32x4 v = *(const f32x4*)(up + 32 + 8 * q); acc[1][4 * q] = v[0]; acc[1][4 * q + 1] = v[1]; acc[1][4 * q + 2] = v[2]; acc[1][4 * q + 3] = v[3]; } }
            const float egl = EGLp[n];
            const LAS unsigned char* wb = buf + r * WIMG_STRIDE + 16 * hh;
            const LAS unsigned char* kb = buf + KDIMG_OFF + r * KDIMG_STRIDE + 16 * hh;
#define SCAN_FRAG(i_) ((i_) < 16 ? *(const LAS bf16x8*)(wb + ((i_) >> 3) * 32 * WIMG_STRIDE + 32 * ((i_) & 7)) : *(const LAS bf16x8*)(kb + (((i_) - 16) >> 2) * 32 * KDIMG_STRIDE + 32 * (((i_) - 16) & 3)))
            bf16x8 ring[6];
#pragma unroll
            for (int i = 0; i < 6; ++i) ring[i] = SCAN_FRAG(i);
#pragma unroll
            for (int i = 0; i < 16; ++i) acc[0][i] = 0.f;
            __builtin_amdgcn_sched_barrier(0);
#pragma unroll
            for (int i = 0; i < 16; ++i) {
                acc[i >> 3] = __builtin_amdgcn_mfma_f32_32x32x16_bf16(ring[i % 6], SB_FRAG(i & 7), acc[i >> 3], 0, 0, 0);
                ring[i % 6] = SCAN_FRAG(i + 6);
                if (i < 4) SB_PACK_QUARTER(3, i);
                __builtin_amdgcn_sched_barrier(0);
            }
#pragma unroll
            for (int q = 0; q < 4; ++q) { acc[0][4 * q] += un[q][0]; acc[0][4 * q + 1] += un[q][1]; acc[0][4 * q + 2] += un[q][2]; acc[0][4 * q + 3] += un[q][3]; }
            bf16x8 Vb[4];
#pragma unroll
            for (int mt = 0; mt < 2; ++mt) { Vb[2 * mt] = pack_step(acc[mt], 0); Vb[2 * mt + 1] = pack_step(acc[mt], 1); }
#pragma unroll
            for (int ks = 0; ks < 4; ++ks) VST[(size_t)n * (4 * 4 * 64) + ks * 64] = __builtin_bit_cast(v4u, Vb[ks]);
#pragma unroll
            for (int ks = 0; ks < 8; ++ks) SST[(size_t)n * (4 * 8 * 64) + ks * 64] = (v4u){sbw[ks][0], sbw[ks][1], sbw[ks][2], sbw[ks][3]};
#pragma unroll
            for (int i = 0; i < 16; ++i) S[0][i] *= egl;
            __builtin_amdgcn_sched_barrier(0);
#pragma unroll
            for (int i = 16; i < 32; ++i) { const int t = (i - 16) >> 2, ks = (i - 16) & 3;
                S[t] = __builtin_amdgcn_mfma_f32_32x32x16_bf16(ring[i % 6], Vb[ks], S[t], 0, 0, 0);
                if (i + 6 < 32) ring[i % 6] = SCAN_FRAG(i + 6);
                if (t < 3) {
#pragma unroll
                    for (int e = 0; e < 4; ++e) S[t + 1][4 * ks + e] *= egl; }
                if (t >= 1) SB_PACK_QUARTER(t - 1, ks);
                __builtin_amdgcn_sched_barrier(0);
            }
#undef SCAN_FRAG
            SCAN_BAR();
        }
#undef SB_FRAG
#undef SB_PACK_QUARTER
    }
#undef SCAN_DMA
#undef SCAN_BAR
    VM_WAIT(); __syncthreads();
}

__device__ __forceinline__ void gdn_out_phase(Frame& F, const float* out_norm  ) {
    const bf16* PROJ = (const bf16*)(F.ws + WS_PROJ); bf16* Y = (bf16*)(F.ws + WS_Y);
    const int lane = F.lane, r = lane & 31, hh = lane >> 5;
    LAS float* ot = (LAS float*)(F.lds + F.wave * 16384);
    float gain[8];
    { const f32x4 a = *(const f32x4*)(out_norm + 8 * (lane & 15)), b = *(const f32x4*)(out_norm + 8 * (lane & 15) + 4);
        gain[0] = a[0]; gain[1] = a[1]; gain[2] = a[2]; gain[3] = a[3]; gain[4] = b[0]; gain[5] = b[1]; gain[6] = b[2]; gain[7] = b[3]; }
    for (int wu = F.gw; wu < 4096; wu += F.NGW) {
        const int ch = wu >> 1, mt = wu & 1, n = ch & 127, bh = ch >> 7, b = bh >> 3, h = bh & 7, m0 = b * SEQ + n * 64 + 32 * mt;
        const bf16* qd = (const bf16*)(F.ws + WS_QD) + (size_t)ch * 64 * 128 + (32 * mt + r) * 128 + 8 * hh;
        const bf16* at = (const bf16*)(F.ws + WS_ATTN) + (size_t)ch * 4096 + (32 * mt + r) * 64 + 8 * hh;
        const v4u* sst = (const v4u*)(F.ws + WS_SST) + (size_t)ch * (4 * 8 * 64) + lane;
        const v4u* vst = (const v4u*)(F.ws + WS_VST) + (size_t)ch * (4 * 4 * 64) + lane;
        bf16x8 qa[8], aa[4];
#pragma unroll
        for (int ks = 0; ks < 8; ++ks) qa[ks] = __builtin_bit_cast(bf16x8, *(const v4u*)(qd + 16 * ks));
#pragma unroll
        for (int ks = 0; ks < 4; ++ks) aa[ks] = __builtin_bit_cast(bf16x8, *(const v4u*)(at + 16 * ks));
        v4u bcur[12], bnxt[12];
#pragma unroll
        for (int ks = 0; ks < 8; ++ks) bcur[ks] = sst[ks * 64];
#pragma unroll
        for (int ks = 0; ks < 4; ++ks) bcur[8 + ks] = vst[ks * 64];
#pragma unroll
        for (int nt = 0; nt < 4; ++nt) {
            if (nt < 3) {
#pragma unroll
                for (int ks = 0; ks < 8; ++ks) bnxt[ks] = sst[(nt + 1) * (8 * 64) + ks * 64];
#pragma unroll
                for (int ks = 0; ks < 4; ++ks) bnxt[8 + ks] = vst[(nt + 1) * (4 * 64) + ks * 64];
            }
            __builtin_amdgcn_sched_barrier(0);
            f32x16 acc;
#pragma unroll
            for (int i = 0; i < 16; ++i) acc[i] = 0.f;
#pragma unroll
            for (int ks = 0; ks < 8; ++ks) acc = __builtin_amdgcn_mfma_f32_32x32x16_bf16(qa[ks], __builtin_bit_cast(bf16x8, bcur[ks]), acc, 0, 0, 0);
#pragma unroll
            for (int ks = 0; ks < 4; ++ks) acc = __builtin_amdgcn_mfma_f32_32x32x16_bf16(aa[ks], __builtin_bit_cast(bf16x8, bcur[8 + ks]), acc, 0, 0, 0);
#pragma unroll
            for (int i = 0; i < 16; ++i) ot[((i & 3) + 8 * (i >> 2) + 4 * hh) * 128 + 32 * nt + r] = acc[i];
#pragma unroll
            for (int q = 0; q < 12; ++q) bcur[q] = bnxt[q];
            __builtin_amdgcn_sched_barrier(0);
        }
        LDS_WAIT();
#pragma unroll 2
        for (int k = 0; k < 8; ++k) {
            const int row = 4 * k + (lane >> 4), chunk = lane & 15;
            const f32x4 o0 = *(const LAS f32x4*)(ot + row * 128 + 8 * chunk), o1 = *(const LAS f32x4*)(ot + row * 128 + 8 * chunk + 4);
            float zz[8]; unpack8(*(const v4u*)(PROJ + (size_t)(m0 + row) * NMIX + PC_Z + h * GD + 8 * chunk), zz);
            float ss = (o0[0] * o0[0] + o0[1] * o0[1]) + (o0[2] * o0[2] + o0[3] * o0[3]) + (o1[0] * o1[0] + o1[1] * o1[1]) + (o1[2] * o1[2] + o1[3] * o1[3]);
            ss += __shfl_xor(ss, 1); ss += __shfl_xor(ss, 2); ss += __shfl_xor(ss, 4); ss += __shfl_xor(ss, 8);
            const float rstd = pg8::rsq_f(ss * (1.0f / GD) + EPS);
            float y[8];
#pragma unroll
            for (int e = 0; e < 4; ++e) { y[e] = o0[e] * rstd * gain[e] * silu_f(zz[e]); y[4 + e] = o1[e] * rstd * gain[4 + e] * silu_f(zz[4 + e]); }
            v4u w; w.x = pkn(y[0], y[1]); w.y = pkn(y[2], y[3]); w.z = pkn(y[4], y[5]); w.w = pkn(y[6], y[7]);
            *(v4u*)(Y + (size_t)(m0 + row) * D + h * GD + 8 * chunk) = w;
        }
        LDS_WAIT();
    }
}

#ifndef GDN_REF
#define GDN_REF 0
#endif
#ifndef REPMASK
#define REPMASK 0u
#endif
__device__ __forceinline__ int nrep_opaque(int n) { asm volatile("" : "+s"(n)); return n; }
#define NREP(k) (((((REPMASK) >> (k)) & 1)) ? nrep_opaque(2) : 1)
#ifndef PHMASK
#define PHMASK 0xFFFFFFFFu
#endif
#ifndef WGM_BIG
#define WGM_BIG 4
#endif
#ifndef WGM_RES
#define WGM_RES 4
#endif
#ifndef WGM_ATT
#define WGM_ATT 4
#endif
#ifndef WGM_DOWN
#define WGM_DOWN 4
#endif
constexpr int PRENORM_SPLIT = 9216;
struct Args { const float* in[21]; float* out; unsigned char* ws; int pro_lo, pro_hi, l_lo, l_hi, ph_lo, ph_hi, one, fin; };
enum { PH_MIXIN = 3, PH_GDNPRE, PH_GDNSCAN, PH_OUTGATE, PH_MIXOUT, PH_SCORES, PH_ATTOUT, PH_UP, PH_SWIGLU, PH_DOWN, PH_END };

typedef const __attribute__((address_space(4))) Args* KArgP;
__device__ __forceinline__ KArgP kargs() { KArgP ap = (KArgP)__builtin_amdgcn_kernarg_segment_ptr(); asm volatile("" : "+s"(ap)); return ap; }
__device__ __forceinline__ int lane_id() { int l; asm volatile("v_mbcnt_lo_u32_b32 %0, -1, 0\n\tv_mbcnt_hi_u32_b32 %0, -1, %0" : "=v"(l)); return l; }
__device__ __forceinline__ Frame mkframe(KArgP ap, LAS unsigned char* lds, int wave_s) {
    Frame F; int t = (wave_s << 6) | lane_id(); asm volatile("" : "+v"(t));
    F.lds = lds; F.tid = t; F.lane = t & 63; F.wave = __builtin_amdgcn_readfirstlane(t >> 6);
    int bx = blockIdx.x; asm volatile("" : "+s"(bx));
    F.bx = bx; F.G = gridDim.x; F.gw = bx * NWAVES + F.wave; F.NGW = F.G * NWAVES; F.ws = ap->ws;
    return F;
}
#ifndef SKEW_TICKS
#define SKEW_TICKS 250
#endif
__device__ __forceinline__ void phase_skew(int slot, int ticks) { const unsigned long long t0 = __builtin_amdgcn_s_memrealtime(); const unsigned long long d = (unsigned long long)slot * ticks;
    while (__builtin_amdgcn_s_memrealtime() - t0 < d) __builtin_amdgcn_s_sleep(8); }
__global__ void __launch_bounds__(NTHREADS, 2) trunk_fwd(Args args) {
    extern __shared__ __attribute__((aligned(16))) unsigned char lds_raw[];
    LAS unsigned char* const lds = (LAS unsigned char*)lds_raw;
    for (int u = threadIdx.x; u < (LDS_BYTES - LDSCTL_OFF) / 4; u += NTHREADS) ((LAS unsigned*)(lds + LDSCTL_OFF))[u] = 0u;
    __syncthreads();
    const int wave_s = __builtin_amdgcn_readfirstlane((int)threadIdx.x >> 6);
    XcdBarrier bar; bar.bar = (unsigned*)(args.ws + WS_CTL) + CW_BAR; bar.x = 0; bar.st = nullptr;
    const bool one = args.one != 0;
    if (one) bar = xcd_barrier_post((unsigned*)(args.ws + WS_CTL) + CW_BAR, (volatile LAS unsigned*)(lds + MISC_OFF) + 8);
#define SEAM() do { if (kargs()->one != 0) xcd_barrier(bar, wave_s == 0 && lane_id() == 0); } while (0)
#define PHASE_BEGIN() KArgP ap = kargs(); Frame F = mkframe(ap, lds, wave_s); PG8_LAS unsigned char* ring = (PG8_LAS unsigned char*)(lds + RING_OFF); (void)ring; \
    bf16* const HA = (bf16*)(F.ws + WS_H); (void)HA; bf16* const HB = (bf16*)(F.ws + WS_HB); (void)HB; unsigned char* const XQ = F.ws + WS_XQ; (void)XQ; float* const SSQ = (float*)(F.ws + WS_SSQ); (void)SSQ
#define PRO(k) ((((PHMASK) >> (k)) & 1) && args.pro_lo <= (k) && (k) < args.pro_hi)

    if (PRO(0)) {
        PHASE_BEGIN();
        p0_weights_x(F, 0, 0, DEPTH, F.gw, F.NGW, ap->in[IN_W_XQ], ap->in[IN_W_XK], ap->in[IN_W_XV], ap->in[IN_W_XO], ap->in[IN_XATTN_NORM]);
        p0_weights_x(F, 1, 0, 1, F.gw, F.NGW, ap->in[IN_W_XQ], ap->in[IN_W_XK], ap->in[IN_W_XV], ap->in[IN_W_XO], ap->in[IN_XATTN_NORM]);
        p0_memn(F, ap->in[IN_MEM], ap->in[IN_MEM_NORM]);
        SEAM();
    }
    if (PRO(1)) {
        PHASE_BEGIN();
        if (F.bx < 128) {
            KvOrder S{128, F.bx, (const bf16*)(F.ws + WS_MEMN), (const bf16*)(F.ws + WS_WXK), (const bf16*)(F.ws + WS_WXV)};
            pg8::Gemm g{nullptr, nullptr, D, D, D};
            pg8::EpiBf16<LocKv, false> E{LocKv{(bf16*)(F.ws + WS_KX), (bf16*)(F.ws + WS_VX)}, 1.0f, nullptr};
            pg8::gemm_phase<pg8::EpiBf16<LocKv, false>, KvOrder, true>(ring, g, S, E, F.tid);
            prenorm_phase(F, ap->in[IN_X], HB, XQ, SSQ, F.gw, 128 * NWAVES, PRENORM_SPLIT, M);
        } else {
            p0_weights_main(F, 0, F.gw - 128 * NWAVES, F.NGW - 128 * NWAVES, ap->in[IN_W_MIX_IN], ap->in[IN_W_MIX_OUT], ap->in[IN_W_UP], ap->in[IN_W_DOWN], ap->in[IN_MIX_NORM], ap->in[IN_FFN_NORM]);
            prenorm_phase(F, ap->in[IN_X], HB, XQ, SSQ, F.gw - 128 * NWAVES, F.NGW - 128 * NWAVES, 0, PRENORM_SPLIT); }
        SEAM();
    }
    const int lo = args.ph_lo, hi = args.ph_hi;
#define IN(k) ((((PHMASK) >> (k)) & 1) && lo <= (k) && (k) < hi)
    for (int l = args.l_lo; l < args.l_hi; ++l) {
        if (IN(PH_MIXIN)) {
            PHASE_BEGIN();
            ba_phase(F, HB, SSQ + (size_t)(3 * l) * M, (const bf16*)(F.ws + WS_WBA) + (size_t)l * 16 * D, ap->in[IN_A_LOG] + l * GH, ap->in[IN_DT_BIAS] + l * GH);
            pg8::Gemm g{HB, (const bf16*)(F.ws + WS_WMIX) + (size_t)l * NMIX * D, D, D, D}; pg8::StaticOrder S; S.init(M, NMIX, F.G, F.bx, WGM_BIG);
            pg8::EpiBf16<pg8::LocPlain, true> E{pg8::LocPlain{(bf16*)(F.ws + WS_PROJ), NMIX}, 1.0f, SSQ + (size_t)(3 * l) * M};
#ifndef PROBE_K
#define PROBE_K 2048
#endif
            for (int rep = 0; rep < NREP(3); ++rep) { if (rep) SEAM(); g.K = (NREP(3) > 1 && rep == 0) ? PROBE_K : D;
            pg8::gemm_phase<pg8::EpiBf16<pg8::LocPlain, true>, pg8::StaticOrder, true>(ring, g, S, E, F.tid); }
            SEAM();
        }
        if (IN(PH_GDNPRE)) { PHASE_BEGIN(); for (int rep = 0; rep < NREP(4); ++rep) { if (rep) SEAM(); gdn_prep_phase(F, ap->in[IN_GDN_CONV] + (size_t)l * 4 * 3 * GW); } SEAM(); }
        if (IN(PH_GDNSCAN)) {
            PHASE_BEGIN();
            if (F.bx < 64 || F.G <= 64) gdn_scan_phase(F);
            if (F.bx >= 64 && F.bx < 192) {
                PreOrder S{l, F.bx - 64, (const bf16*)(F.ws + WS_KX), (const bf16*)(F.ws + WS_VX), (const bf16*)(F.ws + WS_WXQ), (const bf16*)(F.ws + WS_WXO)};
                pg8::Gemm g{nullptr, nullptr, D, D, XD};
                pg8::EpiBf16<LocPre, false> E{LocPre{(bf16*)(F.ws + WS_WQK), (bf16*)(F.ws + WS_VWO)}, 1.0f, nullptr};
                pg8::gemm_phase<pg8::EpiBf16<LocPre, false>, PreOrder, true>(ring, g, S, E, F.tid);
            }
            if (F.G <= 64) shortconv_phase(F, ap->in[IN_SC_CONV] + (size_t)l * 3 * SCW, F.gw, F.NGW);
            else if (F.bx >= 64) shortconv_phase(F, ap->in[IN_SC_CONV] + (size_t)l * 3 * SCW, F.gw - 64 * NWAVES, F.NGW - 64 * NWAVES);
            if (l + 1 < DEPTH) { if (F.G <= 64) p0_weights_main(F, l + 1, F.gw, F.NGW, ap->in[IN_W_MIX_IN], ap->in[IN_W_MIX_OUT], ap->in[IN_W_UP], ap->in[IN_W_DOWN], ap->in[IN_MIX_NORM] + (l + 1) * D, ap->in[IN_FFN_NORM] + (l + 1) * D);
                else if (F.bx >= 64) {
                    const int nsl = F.bx < 192 ? 3 : 4, sb = F.bx < 192 ? 3 * (F.bx - 64) : 384 + 4 * (F.bx - 192);
                    for (int s = 0; s < nsl; ++s) {
                        p0_weights_main(F, l + 1, (sb + s) * NWAVES + F.wave, 640 * NWAVES, ap->in[IN_W_MIX_IN], ap->in[IN_W_MIX_OUT], ap->in[IN_W_UP], ap->in[IN_W_DOWN], ap->in[IN_MIX_NORM] + (l + 1) * D, ap->in[IN_FFN_NORM] + (l + 1) * D);
                        p0_weights_x(F, 1, l + 1, l + 2, (sb + s) * NWAVES + F.wave, 640 * NWAVES, ap->in[IN_W_XQ], ap->in[IN_W_XK], ap->in[IN_W_XV], ap->in[IN_W_XO], ap->in[IN_XATTN_NORM]); } } }
            SEAM(); }
        if (IN(PH_OUTGATE)) { PHASE_BEGIN(); for (int rep = 0; rep < NREP(6); ++rep) { if (rep) SEAM(); gdn_out_phase(F, ap->in[IN_OUT_NORM] + (size_t)l * GD); } SEAM(); }
        if (IN(PH_MIXOUT)) {
            PHASE_BEGIN();
            pg8::Gemm g{(const bf16*)(F.ws + WS_Y), (const bf16*)(F.ws + WS_WOUT) + (size_t)l * D * D, D, D, D}; pg8::StaticOrder S; S.init(M, D, F.G, F.bx, WGM_RES);
            pg8::EpiResNorm E{HB, XQ, HA, XQ, D, SSQ + (size_t)(3 * l + 1) * M};
            pg8::gemm_phase<pg8::EpiResNorm, pg8::StaticOrder, true>(ring, g, S, E, F.tid);
            SEAM();
        }
        if (IN(PH_SCORES)) {
            PHASE_BEGIN();
            pg8::Gemm g{HA, (const bf16*)(F.ws + WS_WQK) + (size_t)l * 2 * (XH * NMEM) * D, D, D, D}; SOrder S{F.G, F.bx};
            pg8::EpiSoftmax E{(bf16*)(F.ws + WS_PB), XH * NMEM, 0.044194173824159216f * 1.4426950408889634f, SSQ + (size_t)(3 * l + 1) * M};
            for (int rep = 0; rep < NREP(8); ++rep) { if (rep) SEAM();
            pg8::gemm_phase<pg8::EpiSoftmax, SOrder, false>(ring, g, S, E, F.tid); }
            SEAM();
        }
        if (IN(PH_ATTOUT)) {
            PHASE_BEGIN();
            pg8::Gemm g{(const bf16*)(F.ws + WS_PB), (const bf16*)(F.ws + WS_VWO) + (size_t)l * 2 * D * (XH * NMEM), XH * NMEM, XH * NMEM, XH * NMEM};
            BatchOrder S; S.init(M, D, F.G, F.bx, WGM_ATT); S.bstride = (size_t)D * (XH * NMEM);
            pg8::EpiResNorm E{HA, XQ, HA, XQ, D, SSQ + (size_t)(3 * l + 2) * M};
            pg8::gemm_phase<pg8::EpiResNorm, BatchOrder, true>(ring, g, S, E, F.tid);
            SEAM();
        }
        if (IN(PH_UP)) {
            PHASE_BEGIN();
            pg8::Gemm g{HA, (const bf16*)(F.ws + WS_WUP) + (size_t)l * 2 * DFF * D, D, D, D}; pg8::StaticOrder S; S.init(M, 2 * DFF, F.G, F.bx, WGM_BIG);
            pg8::EpiSwiglu E{(bf16*)(F.ws + WS_ACT), (float*)(F.ws + WS_PART), (float*)(F.ws + WS_HALO), ap->in[IN_FFN_CONV] + (size_t)l * 3 * 2 * DFF, SSQ + (size_t)(3 * l + 2) * M, (PG8_LAS float*)(lds + XB_OFF), DFF};
            for (int rep = 0; rep < NREP(10); ++rep) { if (rep) SEAM();
            pg8::gemm_phase<pg8::EpiSwiglu, pg8::StaticOrder, true>(ring, g, S, E, F.tid); }
            SEAM();
        }
        if (IN(PH_DOWN)) {
            PHASE_BEGIN();
            pg8::Gemm g{(const bf16*)(F.ws + WS_ACT), (const bf16*)(F.ws + WS_WDN) + (size_t)l * D * DFF, DFF, DFF, DFF}; pg8::StaticOrder S; S.init(M, D, F.G, F.bx, WGM_DOWN);
            { pg8::Unit fu; for (int i = 0; S.next(i, fu); ++i) swiglu_fix_phase(F, ap->in[IN_FFN_CONV] + (size_t)l * 3 * 2 * DFF, fu.pm); }
            VM_WAIT(); __syncthreads();
            pg8::EpiResNorm E{HA, XQ, HB, XQ, D, SSQ + (size_t)(3 * (l + 1)) * M};
            pg8::gemm_phase<pg8::EpiResNorm, pg8::StaticOrder, true>(ring, g, S, E, F.tid);
            SEAM();
        }
    }
    if ((((PHMASK) >> 30) & 1) && args.fin) { PHASE_BEGIN(); final_norm_phase(F, HB, XQ, ap->in[IN_FINAL_NORM], ap->out); }
#undef IN
#undef PRO
#undef SEAM
#undef PHASE_BEGIN
}

extern "C" void kernel_launch(void* const* d_in, const int* in_sizes, int n_in, void* d_out, int out_size, void* d_ws, size_t ws_size, hipStream_t stream) {
    static int grid = 0;
    if (grid == 0) {
        if (n_in != 21 || in_sizes[0] != M * D || out_size != M * D || ws_size < WS_END) { fprintf(stderr, "kernel_launch: unexpected shapes / workspace (n_in %d, in0 %d, out %d, ws %zu < %zu); nothing launched\n", n_in, n_in > 0 ? in_sizes[0] : -1, out_size, ws_size, (size_t)WS_END); grid = -1; return; }
        int dev = 0, cus = 0, per_cu = 0;
        if (hipGetDevice(&dev) != hipSuccess || hipDeviceGetAttribute(&cus, hipDeviceAttributeMultiprocessorCount, dev) != hipSuccess) { fprintf(stderr, "kernel_launch: device query failed\n"); grid = -1; return; }
        if (hipFuncSetAttribute((const void*)trunk_fwd, hipFuncAttributeMaxDynamicSharedMemorySize, LDS_BYTES) != hipSuccess) { fprintf(stderr, "kernel_launch: hipFuncSetAttribute failed\n"); grid = -1; return; }
        if (hipOccupancyMaxActiveBlocksPerMultiprocessor(&per_cu, (const void*)trunk_fwd, NTHREADS, LDS_BYTES) != hipSuccess || per_cu < 1)
            fprintf(stderr, "kernel_launch: note: occupancy query reports %d workgroups per CU\n", per_cu);
        (void)hipGetLastError();
        if (cus != 256) { fprintf(stderr, "kernel_launch: built for 256 CUs, device has %d; nothing launched\n", cus); grid = -1; return; }
        grid = cus;
    }
    if (grid < 0) return;
    if (hipMemsetAsync((char*)d_ws + WS_CTL, 0, CTL_ZERO_BYTES, stream) != hipSuccess) { fprintf(stderr, "kernel_launch: memset failed\n"); return; }
    Args a{};
    for (int i = 0; i < 21; ++i) a.in[i] = (const float*)d_in[i];
    a.out = (float*)d_out; a.ws = (unsigned char*)d_ws;
#if MK_ONE_LAUNCH
    a.pro_lo = 0; a.pro_hi = 2; a.l_lo = 0; a.l_hi = DEPTH; a.ph_lo = PH_MIXIN; a.ph_hi = PH_END; a.one = 1; a.fin = 1;
    hipLaunchKernelGGL(trunk_fwd, dim3(grid), dim3(NTHREADS), LDS_BYTES, stream, a);
#else
    a.one = 0; a.fin = 0; a.l_lo = 0; a.l_hi = 0; a.ph_lo = 0; a.ph_hi = 0;
    for (int p = 0; p < 2; ++p) { a.pro_lo = p; a.pro_hi = p + 1; hipLaunchKernelGGL(trunk_fwd, dim3(grid), dim3(NTHREADS), LDS_BYTES, stream, a); }
    a.pro_lo = 0; a.pro_hi = 0;
    for (int l = 0; l < DEPTH; ++l)
        for (int p = PH_MIXIN; p < PH_END; ++p) { a.l_lo = l; a.l_hi = l + 1; a.ph_lo = p; a.ph_hi = p + 1;
            hipLaunchKernelGGL(trunk_fwd, dim3(grid), dim3(NTHREADS), LDS_BYTES, stream, a); }
    a.l_lo = 0; a.l_hi = 0; a.fin = 1;
    hipLaunchKernelGGL(trunk_fwd, dim3(grid), dim3(NTHREADS), LDS_BYTES, stream, a);
#endif
    const hipError_t le = hipPeekAtLastError();
    if (le != hipSuccess) fprintf(stderr, "kernel_launch: launch failed: %s\n", hipGetErrorName(le));
}
```
